# Optimizing an MI355X kernel written in HIP

```python
import math
import jax, jax.numpy as jnp
from jax import lax
import numpy as np

D_MODEL = 2048
BATCH = 2
SEQ = 8192
DEPTH = 1


GRID_W = 64
N_Q_HEADS = 8
N_KV_HEADS = 2
HEAD_DIM = 128
ATTN_WIDTH = N_Q_HEADS * HEAD_DIM
KV_WIDTH = N_KV_HEADS * HEAD_DIM
ROPE_THETA = 10000.0
Q_BLOCK = 128
QK_EPS = 1e-6
HYENA_WIDTH = D_MODEL // 2
HYENA_GROUPS = 8
SHORT_CONV = 3
FILTER_BANDS = 16
FILTER_EMB = 1 + 2 * FILTER_BANDS
FILTER_HIDDEN = 64
DECAY_TARGET = 1e-2
FAST_DECAY_PCT = 0.3
SLOW_DECAY_PCT = 1.5
FILTER_EPS = 1e-6
N_BRANCH = 2
IN_WIDTH = ATTN_WIDTH + 2 * KV_WIDTH + 3 * HYENA_WIDTH + N_BRANCH * D_MODEL
N_GROUPS = 4
EXPERTS_PER_GROUP = 8
N_EXPERTS = N_GROUPS * EXPERTS_PER_GROUP
TOP_K = 2
D_EXPERT = D_MODEL // 2
MOE_BLOCK = 128
DEEPNORM_ALPHA = (2 * DEPTH) ** 0.25
DEEPNORM_BETA = (8 * DEPTH) ** -0.25
LN_EPS = 1e-5

kernel_name = 'hybrid_gqa_hyena_hmoe_deepnorm_encoder'


def layer_norm(x, g, b):
    xf = x.astype(jnp.float32)
    mu = jnp.mean(xf, axis=-1, keepdims=True)
    var = jnp.mean(jnp.square(xf - mu), axis=-1, keepdims=True)
    return ((xf - mu) * lax.rsqrt(var + LN_EPS) * g.astype(jnp.float32) + b.astype(jnp.float32)).astype(x.dtype)


def rms_norm_heads(x, g):
    xf = x.astype(jnp.float32)
    xf = xf * lax.rsqrt(jnp.mean(jnp.square(xf), axis=-1, keepdims=True) + QK_EPS)
    return (xf * g.astype(jnp.float32)).astype(x.dtype)


def axial_rope_tables(seq_len):
    rows = seq_len // GRID_W
    row_idx = jnp.repeat(jnp.arange(rows, dtype=jnp.int32), GRID_W).astype(jnp.float32)
    col_idx = jnp.tile(jnp.arange(GRID_W, dtype=jnp.int32), rows).astype(jnp.float32)
    half = HEAD_DIM // 2
    inv_freq = ROPE_THETA ** (-jnp.arange(0, half, 2, dtype=jnp.float32) / half)
    ang_r = row_idx[:, None] * inv_freq[None, :]
    ang_c = col_idx[:, None] * inv_freq[None, :]
    return jnp.cos(ang_r), jnp.sin(ang_r), jnp.cos(ang_c), jnp.sin(ang_c)


def rotate_half(x, cos, sin):
    d2 = x.shape[-1] // 2
    x1, x2 = x[..., :d2], x[..., d2:]
    c = cos[None, :, None, :]
    s = sin[None, :, None, :]
    return jnp.concatenate([x1 * c - x2 * s, x2 * c + x1 * s], axis=-1)


def apply_axial_rope(x, tables):
    cr, sr, cc, sc = tables
    xf = x.astype(jnp.float32)
    half = HEAD_DIM // 2
    out = jnp.concatenate([rotate_half(xf[..., :half], cr, sr),
                           rotate_half(xf[..., half:], cc, sc)], axis=-1)
    return out.astype(x.dtype)


def block_attention(q, k, v):
    b, s, _, _ = q.shape
    n_blk = s // Q_BLOCK
    grp = N_Q_HEADS // N_KV_HEADS
    qb = q.reshape(b, n_blk, Q_BLOCK, N_KV_HEADS, grp, HEAD_DIM).transpose(1, 0, 2, 3, 4, 5)
    scale = HEAD_DIM ** -0.5

    def one_block(q_blk):
        sc = jnp.einsum('bqkgd,bskd->bkgqs', q_blk, k).astype(jnp.float32) * scale
        p = jax.nn.softmax(sc, axis=-1).astype(v.dtype)
        return jnp.einsum('bkgqs,bskd->bqkgd', p, v)

    o = lax.map(one_block, qb)
    return o.transpose(1, 0, 2, 3, 4, 5).reshape(b, s, ATTN_WIDTH)


def short_conv(x, w, bias):
    s = x.shape[1]
    pad = SHORT_CONV // 2
    xp = jnp.pad(x, ((0, 0), (pad, pad), (0, 0)))
    out = bias
    for i in range(SHORT_CONV):
        out = out + xp[:, i:i + s] * w[i]
    return out


def hyena_filters(seq_len, w1, b1, f1, w2, b2, f2, w3):
    f32 = jnp.float32
    t = jnp.linspace(0.0, 1.0, seq_len, dtype=f32)[:, None]
    w = 2.0 * math.pi * jnp.arange(seq_len, dtype=f32)[:, None] / seq_len
    bands = jnp.linspace(1e-4, FILTER_BANDS - 1, FILTER_BANDS, dtype=f32)[None, :]
    feats = jnp.concatenate([t, jnp.cos(bands * w), -jnp.sin(bands * w)], axis=-1)
    h = jnp.sin(f1.astype(f32) * (feats @ w1.astype(f32) + b1.astype(f32)))
    h = jnp.sin(f2.astype(f32) * (h @ w2.astype(f32) + b2.astype(f32)))
    filt = h @ w3.astype(f32)
    min_decay = math.log(DECAY_TARGET) / SLOW_DECAY_PCT
    max_decay = math.log(DECAY_TARGET) / FAST_DECAY_PCT
    deltas = jnp.linspace(min_decay, max_decay, HYENA_WIDTH, dtype=f32)
    decay = jnp.exp(-t * jnp.abs(deltas)[None, :])
    h_fwd = filt[:, :HYENA_WIDTH] * decay
    h_bwd = filt[:, HYENA_WIDTH:] * decay
    two_sided = jnp.concatenate([h_fwd, jnp.zeros((1, HYENA_WIDTH), f32), h_bwd[:0:-1]], axis=0)
    two_sided = two_sided * lax.rsqrt(jnp.sum(jnp.square(two_sided), axis=0, keepdims=True) + FILTER_EPS)
    return jnp.fft.rfft(two_sided, axis=0)


def long_conv(z, filt_hat, d_bias):
    s = z.shape[1]
    zf = z.astype(jnp.float32)
    z_hat = jnp.fft.rfft(zf, n=2 * s, axis=1)
    y = jnp.fft.irfft(z_hat * filt_hat[None], n=2 * s, axis=1)[:, :s]
    return (y + zf * d_bias.astype(jnp.float32)).astype(z.dtype)


def hier_moe(x, w_rg, b_rg, w_re, b_re, w_gate, w_up, w_down):
    b, s, d = x.shape
    n_tok = b * s
    xt = x.reshape(n_tok, d)
    coarse = (xt @ w_rg + b_rg).astype(jnp.float32)
    p_grp, grp = lax.top_k(jax.nn.softmax(coarse, axis=-1), 1)
    fine = (xt @ w_re + b_re).astype(jnp.float32).reshape(n_tok, N_GROUPS, EXPERTS_PER_GROUP)
    fine_sel = fine[jnp.arange(n_tok), grp[:, 0]]
    top_p, top_i = lax.top_k(jax.nn.softmax(fine_sel, axis=-1), TOP_K)
    gate = p_grp * top_p / jnp.sum(top_p, axis=-1, keepdims=True)
    expert = grp * EXPERTS_PER_GROUP + top_i

    n_assign = n_tok * TOP_K
    e_flat = expert.reshape(-1).astype(jnp.int32)
    tok_flat = jnp.repeat(jnp.arange(n_tok, dtype=jnp.int32), TOP_K)
    w_flat = gate.reshape(-1)
    order = jnp.argsort(e_flat)
    se, st, sw = e_flat[order], tok_flat[order], w_flat[order]
    counts = jnp.bincount(e_flat, length=N_EXPERTS)
    padded = (counts + MOE_BLOCK - 1) // MOE_BLOCK * MOE_BLOCK
    pad_end = jnp.cumsum(padded)
    pad_start = pad_end - padded
    start = jnp.cumsum(counts) - counts
    dest = pad_start[se] + jnp.arange(n_assign, dtype=jnp.int32) - start[se]
    n_rows = n_assign + N_EXPERTS * MOE_BLOCK
    n_blk = n_rows // MOE_BLOCK
    row_tok = jnp.zeros((n_rows,), jnp.int32).at[dest].set(st)
    row_w = jnp.zeros((n_rows,), jnp.float32).at[dest].set(sw)
    blk_start = jnp.arange(n_blk, dtype=jnp.int32) * MOE_BLOCK
    blk_expert = jnp.minimum(jnp.searchsorted(pad_end, blk_start, side='right'), N_EXPERTS - 1)
    xs = xt[row_tok].reshape(n_blk, MOE_BLOCK, d)

    def expert_block(args):
        xb, e = args
        hdn = jax.nn.silu(xb @ w_gate[e]) * (xb @ w_up[e])
        return hdn @ w_down[e]

    ys = lax.map(expert_block, (xs, blk_expert)).reshape(n_rows, d)
    out = jnp.zeros((n_tok, d), jnp.float32).at[row_tok].add(ys.astype(jnp.float32) * row_w[:, None])
    return out.astype(x.dtype).reshape(b, s, d)


def setup_inputs(seed: int = 0) -> dict:
    key = jax.random.key(seed)
    ks = iter(jax.random.split(key, 40))
    f32 = jnp.float32

    def nrm(shape, scale):
        return jax.random.normal(next(ks), shape, f32) * scale

    def gain(shape):
        return jnp.ones(shape, f32) + nrm(shape, 0.02)

    L_, D_, C_ = DEPTH, D_MODEL, HYENA_WIDTH
    return {
        'x': nrm((BATCH, SEQ, D_), 1.0),
        'ln_in_g': gain((D_,)),
        'ln_in_b': nrm((D_,), 0.02),
        'w_in': nrm((L_, D_, IN_WIDTH), D_ ** -0.5),
        'b_gate': nrm((L_, N_BRANCH * D_), 0.02),
        'q_norm_g': gain((L_, HEAD_DIM)),
        'k_norm_g': gain((L_, HEAD_DIM)),
        'hy_conv_w': nrm((L_, SHORT_CONV, 3 * C_), SHORT_CONV ** -0.5),
        'hy_conv_b': nrm((L_, 3 * C_), 0.02),
        'filt_w1': nrm((L_, FILTER_EMB, FILTER_HIDDEN), FILTER_EMB ** -0.5),
        'filt_b1': nrm((L_, FILTER_HIDDEN), 0.02),
        'filt_f1': gain((L_, FILTER_HIDDEN)),
        'filt_w2': nrm((L_, FILTER_HIDDEN, FILTER_HIDDEN), FILTER_HIDDEN ** -0.5),
        'filt_b2': nrm((L_, FILTER_HIDDEN), 0.02),
        'filt_f2': gain((L_, FILTER_HIDDEN)),
        'filt_w3': nrm((L_, FILTER_HIDDEN, 2 * C_), FILTER_HIDDEN ** -0.5),
        'hy_bias_d': nrm((L_, C_), 0.5),
        'w_attn_o': nrm((L_, ATTN_WIDTH, D_), ATTN_WIDTH ** -0.5),
        'w_hy_o': nrm((L_, C_, D_), C_ ** -0.5),
        'w_out': nrm((L_, D_, D_), D_ ** -0.5 * DEEPNORM_BETA),
        'ln1_g': gain((L_, D_)),
        'ln1_b': nrm((L_, D_), 0.02),
        'w_route_grp': nrm((L_, D_, N_GROUPS), D_ ** -0.5),
        'b_route_grp': nrm((L_, N_GROUPS), 0.01),
        'w_route_exp': nrm((L_, D_, N_EXPERTS), D_ ** -0.5),
        'b_route_exp': nrm((L_, N_EXPERTS), 0.01),
        'w_exp_gate': nrm((L_, N_EXPERTS, D_, D_EXPERT), D_ ** -0.5),
        'w_exp_up': nrm((L_, N_EXPERTS, D_, D_EXPERT), D_ ** -0.5),
        'w_exp_down': nrm((L_, N_EXPERTS, D_EXPERT, D_), D_EXPERT ** -0.5 * DEEPNORM_BETA),
        'ln2_g': gain((L_, D_)),
        'ln2_b': nrm((L_, D_), 0.02),
    }


def reference(x, ln_in_g, ln_in_b, w_in, b_gate, q_norm_g, k_norm_g, hy_conv_w, hy_conv_b,
              filt_w1, filt_b1, filt_f1, filt_w2, filt_b2, filt_f2, filt_w3, hy_bias_d,
              w_attn_o, w_hy_o, w_out, ln1_g, ln1_b, w_route_grp, b_route_grp, w_route_exp,
              b_route_exp, w_exp_gate, w_exp_up, w_exp_down, ln2_g, ln2_b):
    b, s, _ = x.shape
    rope = axial_rope_tables(s)
    split_at = [ATTN_WIDTH, ATTN_WIDTH + KV_WIDTH, ATTN_WIDTH + 2 * KV_WIDTH,
                ATTN_WIDTH + 2 * KV_WIDTH + 3 * HYENA_WIDTH]
    h = layer_norm(x, ln_in_g, ln_in_b)
    for l in range(DEPTH):
        proj = h @ w_in[l]
        q, k, v, hy, gates = jnp.split(proj, split_at, axis=-1)
        q = apply_axial_rope(rms_norm_heads(q.reshape(b, s, N_Q_HEADS, HEAD_DIM), q_norm_g[l]), rope)
        k = apply_axial_rope(rms_norm_heads(k.reshape(b, s, N_KV_HEADS, HEAD_DIM), k_norm_g[l]), rope)
        v = v.reshape(b, s, N_KV_HEADS, HEAD_DIM)
        y_attn = block_attention(q, k, v) @ w_attn_o[l]

        hy = short_conv(hy, hy_conv_w[l], hy_conv_b[l])
        x0, x1, hv = jnp.split(hy, 3, axis=-1)
        filt_hat = hyena_filters(s, filt_w1[l], filt_b1[l], filt_f1[l], filt_w2[l], filt_b2[l],
                                 filt_f2[l], filt_w3[l])
        y_hy = (x0 * long_conv(hv * x1, filt_hat, hy_bias_d[l])) @ w_hy_o[l]

        g_attn, g_hy = jnp.split(jax.nn.sigmoid(gates + b_gate[l]), N_BRANCH, axis=-1)
        mixed = (g_attn * y_attn + g_hy * y_hy) @ w_out[l]
        h = layer_norm(DEEPNORM_ALPHA * h + mixed, ln1_g[l], ln1_b[l])

        moe = hier_moe(h, w_route_grp[l], b_route_grp[l], w_route_exp[l], b_route_exp[l],
                       w_exp_gate[l], w_exp_up[l], w_exp_down[l])
        h = layer_norm(DEEPNORM_ALPHA * h + moe, ln2_g[l], ln2_b[l])
    return h
```

```cpp
#include <hip/hip_runtime.h>
#include <hip/hip_bf16.h>
#include <cstdio>
#include <cstdint>
#include <cmath>
namespace pg8 {
#define PG8_LAS __attribute__((address_space(3)))
typedef unsigned short bf16_t;
typedef short bf16x8 __attribute__((ext_vector_type(8)));
typedef float f32x4 __attribute__((ext_vector_type(4)));
typedef unsigned u32x4 __attribute__((ext_vector_type(4)));
constexpr int BM = 256, BK = 64, HALF = 128, HTB = HALF * BK * 2  , STAGE_BYTES = 8 * HTB, NXCD = 8, WGM = 8;

__host__ __device__ __forceinline__ int lds_byte(int r, int c) { const int st = (r >> 4) * 2 + (c >> 5), rr = r & 15, cc = c & 31, ob = rr * 64 + cc * 2; return st * 1024 + (ob ^ (((ob >> 9) & 1) << 5)); }
__host__ __device__ __forceinline__ void stage_rc(int b, int& R, int& C) { const int st = b / 1024, sb = b % 1024, swz = sb ^ (((sb >> 9) & 1) << 5); R = (st >> 1) * 16 + swz / 64; C = (st & 1) * 32 + (swz % 64) / 2; }
__host__ __device__ __forceinline__ int perm32(int rho) { const int n = rho >> 4, i = rho & 15; return 8 * (i >> 2) + 4 * n + (i & 3); }

struct Unit { int pm, pn; };
struct Gemm { const bf16_t* A; const bf16_t* Bt; int M, N, K; };

struct StaticOrder {
    int nM, nN, nwg, G, c;
    __host__ __device__ void init(int M, int N, int G_, int c_) { nM = M / BM; nN = N / BM; nwg = nM * nN; G = G_; c = c_; }
    __host__ __device__ bool next(int i, Unit& u) const {
        const long L = (long)i * G + c; if (L >= nwg) return false;
        int wgid = (int)L; { const int q = nwg / NXCD, r = nwg % NXCD, xcd = wgid % NXCD, off = wgid / NXCD; wgid = (xcd < r ? xcd * (q + 1) : r * (q + 1) + (xcd - r) * q) + off; }
        const int nig = WGM * nN, gid = wgid / nig, fm = gid * WGM, gsz = (nM - fm) < WGM ? (nM - fm) : WGM;
        u.pm = fm + ((wgid % nig) % gsz); u.pn = (wgid % nig) / gsz; return true;
    }
    __device__ __forceinline__ void a_ready(const Unit&) const {}
    __device__ __forceinline__ void done(const Unit&) const {}
};

__device__ __forceinline__ unsigned cvt_pk_bf16(float lo, float hi) { unsigned r; asm volatile("v_cvt_pk_bf16_f32 %0, %1, %2" : "=v"(r) : "v"(lo), "v"(hi)); return r; }
__device__ __forceinline__ float bflo(unsigned w) { return __uint_as_float(w << 16); }
__device__ __forceinline__ float bfhi(unsigned w) { return __uint_as_float(w & 0xffff0000u); }
__device__ __forceinline__ float sigm(float x) { return 1.f / (1.f + __expf(-x)); }
__device__ __forceinline__ u32x4 pack8(const f32x4 v0, const f32x4 v1) { u32x4 w; w.x = cvt_pk_bf16(v0[0], v0[1]); w.y = cvt_pk_bf16(v0[2], v0[3]); w.z = cvt_pk_bf16(v1[0], v1[1]); w.w = cvt_pk_bf16(v1[2], v1[3]); return w; }
__device__ __forceinline__ void unpack8(const u32x4 w, f32x4& v0, f32x4& v1) { v0 = (f32x4){bflo(w.x), bfhi(w.x), bflo(w.y), bfhi(w.y)}; v1 = (f32x4){bflo(w.z), bfhi(w.z), bflo(w.w), bfhi(w.w)}; }

struct EpiProj {
    static constexpr bool PERM = true, AFTER_DRAIN = false;
    bf16_t* O; int ldc; const float* bgate; int gate_pn0;
    __device__ __forceinline__ void operator()(const f32x4 (&acc)[2][2][4][2], const Unit& u, int wr, int wc, int fr, int fq) const {
        const int row0 = u.pm * BM + wr * 64 + fr, col0 = u.pn * BM + wc * 32 + 8 * fq;
        const bool gate = u.pn >= gate_pn0;
        f32x4 bv[2][2];
#pragma unroll
        for (int bj = 0; bj < 2; ++bj)
#pragma unroll
            for (int n = 0; n < 2; ++n) bv[bj][n] = gate ? *(const f32x4*)(bgate + (col0 - gate_pn0 * BM) + bj * HALF + 4 * n) : (f32x4){0.f, 0.f, 0.f, 0.f};
#pragma unroll
        for (int ai = 0; ai < 2; ++ai)
#pragma unroll
            for (int m = 0; m < 4; ++m) { bf16_t* rowp = O + (size_t)(row0 + ai * HALF + m * 16) * ldc + col0;
#pragma unroll
                for (int bj = 0; bj < 2; ++bj) { f32x4 v0 = acc[ai][bj][m][0] + bv[bj][0], v1 = acc[ai][bj][m][1] + bv[bj][1];
                    if (gate) {
#pragma unroll
                        for (int e = 0; e < 4; ++e) { v0[e] = sigm(v0[e]); v1[e] = sigm(v1[e]); } }
                    *(u32x4*)(rowp + bj * HALF) = pack8(v0, v1); } }
    }
};
struct EpiGate1 {
    static constexpr bool PERM = true, AFTER_DRAIN = false;
    const bf16_t* G; int ldg; bf16_t* O; int ldc;
    __device__ __forceinline__ void operator()(const f32x4 (&acc)[2][2][4][2], const Unit& u, int wr, int wc, int fr, int fq) const {
        const int row0 = u.pm * BM + wr * 64 + fr, col0 = u.pn * BM + wc * 32 + 8 * fq;
#pragma unroll
        for (int ai = 0; ai < 2; ++ai)
#pragma unroll
            for (int m = 0; m < 4; ++m) { const size_t r = (size_t)(row0 + ai * HALF + m * 16);
#pragma unroll
                for (int bj = 0; bj < 2; ++bj) { const u32x4 gw = *(const u32x4*)(G + r * ldg + col0 + bj * HALF); f32x4 g0, g1; unpack8(gw, g0, g1);
                    *(u32x4*)(O + r * ldc + col0 + bj * HALF) = pack8(acc[ai][bj][m][0] * g0, acc[ai][bj][m][1] * g1); } }
    }
};
struct EpiGate2 {
    static constexpr bool PERM = true, AFTER_DRAIN = false;
    const bf16_t* G; int ldg; bf16_t* O; int ldc;
    __device__ __forceinline__ void operator()(const f32x4 (&acc)[2][2][4][2], const Unit& u, int wr, int wc, int fr, int fq) const {
        const int row0 = u.pm * BM + wr * 64 + fr, col0 = u.pn * BM + wc * 32 + 8 * fq;
#pragma unroll
        for (int ai = 0; ai < 2; ++ai)
#pragma unroll
            for (int m = 0; m < 4; ++m) { const size_t r = (size_t)(row0 + ai * HALF + m * 16);
#pragma unroll
                for (int bj = 0; bj < 2; ++bj) { const u32x4 gw = *(const u32x4*)(G + r * ldg + col0 + bj * HALF); f32x4 g0, g1; unpack8(gw, g0, g1);
                    const u32x4 ow = *(const u32x4*)(O + r * ldc + col0 + bj * HALF); f32x4 o0, o1; unpack8(ow, o0, o1);
                    *(u32x4*)(O + r * ldc + col0 + bj * HALF) = pack8(o0 + acc[ai][bj][m][0] * g0, o1 + acc[ai][bj][m][1] * g1); } }
    }
};
struct EpiPre1 {
    static constexpr bool PERM = false, AFTER_DRAIN = false;
    const float* X; const float* stats; const float* g; const float* b; float* O; int ldc; float alpha;
    __device__ __forceinline__ void operator()(const f32x4 (&acc)[2][2][4][2], const Unit& u, int wr, int wc, int fr, int fq) const {
        const int col0 = u.pn * BM + wc * 32 + 4 * fq;
        f32x4 gv[2][2], bv[2][2];
#pragma unroll
        for (int bj = 0; bj < 2; ++bj)
#pragma unroll
            for (int n = 0; n < 2; ++n) { gv[bj][n] = *(const f32x4*)(g + col0 + bj * HALF + n * 16) * alpha; bv[bj][n] = *(const f32x4*)(b + col0 + bj * HALF + n * 16) * alpha; }
#pragma unroll
        for (int ai = 0; ai < 2; ++ai)
#pragma unroll
            for (int m = 0; m < 4; ++m) { const size_t r = (size_t)(u.pm * BM + ai * HALF + wr * 64 + m * 16 + fr); const float mu = stats[2 * r], rs = stats[2 * r + 1];
#pragma unroll
                for (int bj = 0; bj < 2; ++bj)
#pragma unroll
                    for (int n = 0; n < 2; ++n) { const size_t off = r * ldc + col0 + bj * HALF + n * 16; const f32x4 xv = *(const f32x4*)(X + off);
                        *(f32x4*)(O + off) = ((xv - mu) * rs) * gv[bj][n] + bv[bj][n] + acc[ai][bj][m][n]; } }
    }
};
struct EpiSwiglu {
    static constexpr bool PERM = true, AFTER_DRAIN = false;
    bf16_t* O; int ldc;
    __device__ __forceinline__ void operator()(const f32x4 (&acc)[2][2][4][2], const Unit& u, int wr, int wc, int fr, int fq) const {
        const int row0 = u.pm * BM + wr * 64 + fr, col0 = (u.pn & 7) * HALF + wc * 32 + 8 * fq;
#pragma unroll
        for (int ai = 0; ai < 2; ++ai)
#pragma unroll
            for (int m = 0; m < 4; ++m) { f32x4 h[2];
#pragma unroll
                for (int n = 0; n < 2; ++n)
#pragma unroll
                    for (int e = 0; e < 4; ++e) { const float gg = acc[ai][0][m][n][e]; h[n][e] = gg * sigm(gg) * acc[ai][1][m][n][e]; }
                *(u32x4*)(O + (size_t)(row0 + ai * HALF + m * 16) * ldc + col0) = pack8(h[0], h[1]); }
    }
};
struct EpiDown {
    static constexpr bool PERM = true, AFTER_DRAIN = false;
    const int* meta; bf16_t* Y; int ldc; int ntok;
    __device__ __forceinline__ void operator()(const f32x4 (&acc)[2][2][4][2], const Unit& u, int wr, int wc, int fr, int fq) const {
        const int row0 = u.pm * BM + wr * 64 + fr, col0 = (u.pn & 7) * BM + wc * 32 + 8 * fq;
#pragma unroll
        for (int ai = 0; ai < 2; ++ai)
#pragma unroll
            for (int m = 0; m < 4; ++m) { const int r = row0 + ai * HALF + m * 16; const int ts = meta[2 * r]; const float w = __int_as_float(meta[2 * r + 1]);
                if (ts >= 0) { bf16_t* yp = Y + ((size_t)(ts & 1) * ntok + (size_t)(ts >> 1)) * ldc + col0;
#pragma unroll
                    for (int bj = 0; bj < 2; ++bj) *(u32x4*)(yp + bj * HALF) = pack8(acc[ai][bj][m][0] * w, acc[ai][bj][m][1] * w); } }
    }
};
struct ExpertOrder {
    const PG8_LAS int* rbx; int nrb, G, c;
    __device__ __forceinline__ bool next(int i, Unit& u) const {
        const int L = i * G + c; if (L >= nrb * 8) return false;
        const int rb = L >> 3; u.pm = rb; u.pn = rbx[rb] * 8 + (L & 7); return true;
    }
    __device__ __forceinline__ void a_ready(const Unit&) const {}
    __device__ __forceinline__ void done(const Unit&) const {}
};
template <class Epi, class Sched, bool ALIGN_EPI = false, bool SP2 = false>
__device__ __forceinline__ void gemm_phase(PG8_LAS unsigned char* lds, const Gemm g, const Sched& S, const Epi& E) {
    const int tid = threadIdx.x, wid = __builtin_amdgcn_readfirstlane(tid >> 6), lane = tid & 63, wr = wid >> 2, wc = wid & 3, fr = lane & 15, fq = lane >> 4;
    const int K = g.K, nt = K / BK;
    unsigned voffA[2], voffB[2];
#pragma unroll
    for (int i = 0; i < 2; ++i) { int R, C; stage_rc(tid * 16 + i * 8192, R, C); const int Rb = Epi::PERM ? ((R & ~31) + perm32(R & 31)) : R;
        voffA[i] = (unsigned)(R * K + C) * 2u; voffB[i] = (unsigned)(Rb * K + C) * 2u; }
    const size_t kstep = (size_t)(BK * 2);
    const size_t hstep = (size_t)HALF * K * 2;
    const size_t tstep = 2 * hstep;
    const unsigned ldsw = (unsigned)wid * 1024u;
    const int aoff = lds_byte(wr * 64 + fr, fq * 8), boff = lds_byte(wc * 32 + fr, fq * 8);
#define PG8_SA(b, h) (((b) * 2 + (h)) * HTB)
#define PG8_SB(b, h) ((4 + (b) * 2 + (h)) * HTB)
#define PG8_STAGE(bufoff, gbase, voff) do { _Pragma("unroll") for (int _i = 0; _i < 2; ++_i) \
        __builtin_amdgcn_global_load_lds((const unsigned*)((const char*)(gbase) + (voff)[_i]), (PG8_LAS unsigned*)(lds + (bufoff) + ldsw + _i * 8192), 16, 0, 0); } while (0)
#define PG8_LDA(dst, b, h) do { _Pragma("unroll") for (int m = 0; m < 4; ++m) _Pragma("unroll") for (int k = 0; k < 2; ++k) dst[m][k] = *(const PG8_LAS bf16x8*)(lds + PG8_SA(b, h) + aoff + m * 2048 + k * 1024); } while (0)
#define PG8_LDB(dst, b, h) do { _Pragma("unroll") for (int n = 0; n < 2; ++n) _Pragma("unroll") for (int k = 0; k < 2; ++k) dst[n][k] = *(const PG8_LAS bf16x8*)(lds + PG8_SB(b, h) + boff + n * 2048 + k * 1024); } while (0)
#define PG8_MMA(ai, bj, At, Bt) do { __builtin_amdgcn_s_setprio(1); _Pragma("unroll") for (int m = 0; m < 4; ++m) _Pragma("unroll") for (int n = 0; n < 2; ++n) _Pragma("unroll") for (int k = 0; k < 2; ++k) \
        acc[ai][bj][m][n] = __builtin_amdgcn_mfma_f32_16x16x32_bf16(Bt[n][k], At[m][k], acc[ai][bj][m][n], 0, 0, 0); __builtin_amdgcn_s_setprio(0); } while (0)
#define PG8_WAIT_V(n) asm volatile("s_waitcnt vmcnt(" #n ")" ::: "memory")
#define PG8_WAIT_L(n) asm volatile("s_waitcnt lgkmcnt(" #n ")" ::: "memory")
#define PG8_BAR __builtin_amdgcn_s_barrier()
#define PG8_SCHED __builtin_amdgcn_sched_barrier(0)
    Unit cur, nxt; int ui = 0;
    if (!S.next(0, cur)) return;
    f32x4 acc[2][2][4][2];
#pragma unroll
    for (int a = 0; a < 2; ++a)
#pragma unroll
        for (int b = 0; b < 2; ++b)
#pragma unroll
            for (int m = 0; m < 4; ++m)
#pragma unroll
                for (int n = 0; n < 2; ++n) acc[a][b][m][n] = (f32x4){0.f, 0.f, 0.f, 0.f};
    bf16x8 At[4][2], B0[2][2], B1[2][2];
    const char* cA = (const char*)g.A + (size_t)cur.pm * tstep; const char* cB = (const char*)g.Bt + (size_t)cur.pn * tstep;
    S.a_ready(cur);
    if constexpr (SP2) {
        PG8_STAGE(PG8_SB(0, 0), cB, voffB); PG8_STAGE(PG8_SB(0, 1), cB + hstep, voffB); PG8_STAGE(PG8_SA(0, 0), cA, voffA); PG8_STAGE(PG8_SA(0, 1), cA + hstep, voffA);
        if (wr == 1) PG8_BAR;
        PG8_WAIT_V(2); PG8_BAR;
        PG8_STAGE(PG8_SB(1, 0), cB + kstep, voffB); PG8_STAGE(PG8_SA(1, 0), cA + kstep, voffA); PG8_STAGE(PG8_SB(1, 1), cB + hstep + kstep, voffB);
        PG8_WAIT_V(6); PG8_BAR;
    } else {
        PG8_STAGE(PG8_SB(0, 0), cB, voffB); PG8_STAGE(PG8_SA(0, 0), cA, voffA); PG8_STAGE(PG8_SB(0, 1), cB + hstep, voffB); PG8_STAGE(PG8_SA(0, 1), cA + hstep, voffA);
        if (wr == 1) PG8_BAR;
        PG8_WAIT_V(4); PG8_BAR;
        PG8_STAGE(PG8_SB(1, 0), cB + kstep, voffB); PG8_STAGE(PG8_SA(1, 0), cA + kstep, voffA); PG8_STAGE(PG8_SB(1, 1), cB + hstep + kstep, voffB);
        PG8_WAIT_V(6); PG8_BAR;
    }
    for (;;) {
        const bool has_next = S.next(ui + 1, nxt);
        const char* nA = has_next ? (const char*)g.A + (size_t)nxt.pm * tstep : cA; const char* nB = has_next ? (const char*)g.Bt + (size_t)nxt.pn * tstep : cB;
        for (int t = 0; t < nt; t += 2) {
            const bool last = (t == nt - 2);
            const char* a1 = cA + (size_t)(t + 1) * kstep;
            const char* a2 = last ? nA : cA + (size_t)(t + 2) * kstep; const char* b2 = last ? nB : cB + (size_t)(t + 2) * kstep;
            const char* a3 = a2 + kstep; const char* b3 = b2 + kstep;
            if (last && has_next) S.a_ready(nxt);
            if constexpr (SP2) {
            PG8_LDB(B0, 0, 0); PG8_LDB(B1, 0, 1); PG8_SCHED; PG8_LDA(At, 0, 0); PG8_STAGE(PG8_SA(1, 1), a1 + hstep, voffA);
            PG8_WAIT_V(8); PG8_WAIT_L(0); PG8_BAR; PG8_MMA(0, 0, At, B0); PG8_MMA(0, 1, At, B1); PG8_BAR; PG8_SCHED;
            PG8_LDA(At, 0, 1); PG8_STAGE(PG8_SB(0, 0), b2, voffB); PG8_STAGE(PG8_SB(0, 1), b2 + hstep, voffB); PG8_STAGE(PG8_SA(0, 0), a2, voffA);
            PG8_WAIT_V(8); PG8_WAIT_L(0); PG8_BAR; PG8_MMA(1, 0, At, B0); PG8_MMA(1, 1, At, B1); PG8_BAR; PG8_SCHED;
            PG8_LDB(B0, 1, 0); PG8_LDB(B1, 1, 1); PG8_SCHED; PG8_LDA(At, 1, 0); PG8_STAGE(PG8_SA(0, 1), a2 + hstep, voffA);
            PG8_WAIT_V(8); PG8_WAIT_L(0); PG8_BAR; PG8_MMA(0, 0, At, B0); PG8_MMA(0, 1, At, B1); PG8_BAR; PG8_SCHED;
            PG8_LDA(At, 1, 1); PG8_STAGE(PG8_SB(1, 0), b3, voffB); PG8_STAGE(PG8_SB(1, 1), b3 + hstep, voffB); PG8_STAGE(PG8_SA(1, 0), a3, voffA);
            PG8_WAIT_V(8); PG8_WAIT_L(0); PG8_BAR; PG8_MMA(1, 0, At, B0); PG8_MMA(1, 1, At, B1); PG8_BAR; PG8_SCHED;
            } else {
            PG8_LDB(B0, 0, 0); PG8_SCHED; PG8_LDA(At, 0, 0); PG8_STAGE(PG8_SA(1, 1), a1 + hstep, voffA);
            PG8_WAIT_L(8); PG8_BAR; PG8_WAIT_L(0); PG8_MMA(0, 0, At, B0); PG8_BAR; PG8_SCHED;
            PG8_LDB(B1, 0, 1); PG8_STAGE(PG8_SB(0, 0), b2, voffB);
            PG8_BAR; PG8_WAIT_L(0); PG8_MMA(0, 1, At, B1); PG8_BAR;
            PG8_LDA(At, 0, 1); PG8_STAGE(PG8_SA(0, 0), a2, voffA);
            PG8_BAR; PG8_WAIT_L(0); PG8_MMA(1, 0, At, B0); PG8_BAR; PG8_SCHED;
            PG8_STAGE(PG8_SB(0, 1), b2 + hstep, voffB);
            PG8_WAIT_V(6); PG8_BAR; PG8_MMA(1, 1, At, B1); PG8_BAR;
            PG8_LDB(B0, 1, 0); PG8_SCHED; PG8_LDA(At, 1, 0); PG8_STAGE(PG8_SA(0, 1), a2 + hstep, voffA);
            PG8_WAIT_L(8); PG8_BAR; PG8_WAIT_L(0); PG8_MMA(0, 0, At, B0); PG8_BAR; PG8_SCHED;
            PG8_LDB(B1, 1, 1); PG8_STAGE(PG8_SB(1, 0), b3, voffB);
            PG8_BAR; PG8_WAIT_L(0); PG8_MMA(0, 1, At, B1); PG8_BAR;
            PG8_LDA(At, 1, 1); PG8_STAGE(PG8_SA(1, 0), a3, voffA);
            PG8_BAR; PG8_WAIT_L(0); PG8_MMA(1, 0, At, B0); PG8_BAR; PG8_SCHED;
            PG8_STAGE(PG8_SB(1, 1), b3 + hstep, voffB);
            PG8_WAIT_V(6); PG8_BAR; PG8_MMA(1, 1, At, B1); PG8_BAR;
            }
        }
        if constexpr (ALIGN_EPI) { if (wr == 0) PG8_BAR; }
        if constexpr (!Epi::AFTER_DRAIN) { E(acc, cur, wr, wc, fr, fq); S.done(cur); }
        if (!has_next) break;
#pragma unroll
        for (int a = 0; a < 2; ++a)
#pragma unroll
            for (int b = 0; b < 2; ++b)
#pragma unroll
                for (int m = 0; m < 4; ++m)
#pragma unroll
                    for (int n = 0; n < 2; ++n) acc[a][b][m][n] = (f32x4){0.f, 0.f, 0.f, 0.f};
        cur = nxt; cA = nA; cB = nB; ++ui;
        if constexpr (ALIGN_EPI) { if (wr == 1) PG8_BAR; }
    }
    PG8_WAIT_V(0);
    if constexpr (!ALIGN_EPI) { if (wr == 0) PG8_BAR; }
    PG8_BAR;
    if constexpr (Epi::AFTER_DRAIN) { E.fused(acc, cur, wr, wc, fr, fq, lds, wid, lane); S.done(cur); }
#undef PG8_SA
#undef PG8_SB
#undef PG8_STAGE
#undef PG8_LDA
#undef PG8_LDB
#undef PG8_MMA
#undef PG8_WAIT_V
#undef PG8_WAIT_L
#undef PG8_BAR
#undef PG8_SCHED
}
}
namespace attn {
using bf16 = unsigned short;
constexpr int   D = 128, NW = 8, QBLK = 32, KVBLK = 64;
constexpr float SCALE = 0.088388347648318440f;
constexpr float THR = 8.f;
constexpr int SDEPTH = 2;
constexpr int LDQ = 8704, LDK = 8704, LDO = 1024;
constexpr size_t SHM_V = KVBLK * D * 2, SHM_K = KVBLK * D * 2, SHM_ATTN = 2 * SHM_V + 2 * SHM_K + NW * 64 * 4;
using bf16x8 = __attribute__((ext_vector_type(8))) short;
using s16x4  = __attribute__((ext_vector_type(4))) short;
using f32x16 = __attribute__((ext_vector_type(16))) float;
using f32x8  = __attribute__((ext_vector_type(8))) float;
using u32x4  = __attribute__((ext_vector_type(4))) unsigned;
#define KSWZ(row, colB) ((row) * 256 + ((colB) ^ (((row) & 7) << 4)))
#define SBAR() __builtin_amdgcn_sched_barrier(0)
__device__ __forceinline__ int crow(int r, int hi) { return (r & 3) + 8 * (r >> 2) + 4 * hi; }
__device__ __forceinline__ unsigned cvtpk(float lo, float hi) {
  unsigned r; asm volatile("v_cvt_pk_bf16_f32 %0, %1, %2" : "=v"(r) : "v"(lo), "v"(hi)); return r;
}
struct StageB { using T = bf16x8;
  __device__ static __forceinline__ T ld8(const bf16* p) { return *reinterpret_cast<const bf16x8*>(p); }
  __device__ static __forceinline__ bf16x8 tobf(T x) { return x; } };
__device__ __forceinline__ void partialSM(f32x16& p0, f32x16& p1, float& m_reg, float& mn, float& alpha) {
  constexpr float C = SCALE * 1.4426950408889634f;
  float pmax = p0[0]; for (int r = 1; r < 16; ++r) pmax = fmaxf(pmax, p0[r]); for (int r = 0; r < 16; ++r) pmax = fmaxf(pmax, p1[r]);
  { auto rr = __builtin_amdgcn_permlane32_swap(__float_as_uint(pmax), __float_as_uint(pmax), false, false);
    pmax = fmaxf(__uint_as_float(rr[0]), __uint_as_float(rr[1])); }
  if (__builtin_expect(__all(pmax - m_reg <= THR / SCALE), 1)) { mn = m_reg; alpha = 1.f; }
  else { mn = fmaxf(m_reg, pmax); alpha = __builtin_amdgcn_exp2f((m_reg - mn) * C); m_reg = mn; }
  float mnC = -mn * C;
  for (int r = 0; r < 16; ++r) p0[r] = fmaf(p0[r], C, mnC); for (int r = 0; r < 16; ++r) p1[r] = fmaf(p1[r], C, mnC);
  for (int r = 0; r < 16; ++r) p0[r] = __builtin_amdgcn_exp2f(p0[r]);
}
__device__ __forceinline__ void finishSM(f32x16& p0, f32x16& p1, float alpha, float& l_reg, bf16x8& pa0, bf16x8& pa1, bf16x8& pa2, bf16x8& pa3) {
  for (int r = 0; r < 16; ++r) p1[r] = __builtin_amdgcn_exp2f(p1[r]);
  float ps = 0; for (int r = 0; r < 16; ++r) ps += p0[r]; for (int r = 0; r < 16; ++r) ps += p1[r];
  { auto rr = __builtin_amdgcn_permlane32_swap(__float_as_uint(ps), __float_as_uint(ps), false, false);
    ps = __uint_as_float(rr[0]) + __uint_as_float(rr[1]); }
  l_reg = l_reg * alpha + ps;
#define PK4(P, BASE, OUT) do { unsigned a0 = cvtpk(P[BASE + 0], P[BASE + 1]), a1 = cvtpk(P[BASE + 2], P[BASE + 3]);   \
    unsigned b0 = cvtpk(P[BASE + 4], P[BASE + 5]), b1 = cvtpk(P[BASE + 6], P[BASE + 7]);                              \
    auto r0 = __builtin_amdgcn_permlane32_swap(a0, b0, false, false); auto r1 = __builtin_amdgcn_permlane32_swap(a1, b1, false, false); \
    u32x4 w = {r0[0], r1[0], r0[1], r1[1]}; OUT = *reinterpret_cast<bf16x8*>(&w); } while (0)
  PK4(p0, 0, pa0); PK4(p0, 8, pa1); PK4(p1, 0, pa2); PK4(p1, 8, pa3);
#undef PK4
}
__device__ __forceinline__ void qkt(f32x16& p0, f32x16& p1, const bf16* Ks, const bf16x8* qr, int r32, int hi) {
  p0 = f32x16{}; p1 = f32x16{};
  for (int d0 = 0; d0 < 8; ++d0) { int cb = (d0 * 16 + hi * 8) * 2;
    bf16x8 b0 = *reinterpret_cast<const bf16x8*>((const char*)Ks + KSWZ(r32, cb));
    bf16x8 b1 = *reinterpret_cast<const bf16x8*>((const char*)Ks + KSWZ(32 + r32, cb));
    p0 = __builtin_amdgcn_mfma_f32_32x32x16_bf16(b0, qr[d0], p0, 0, 0, 0);
    p1 = __builtin_amdgcn_mfma_f32_32x32x16_bf16(b1, qr[d0], p1, 0, 0, 0); }
}
__device__ __forceinline__ int v_st(int k, int c) { const int kk = (k & ~0xC) | ((k & 4) << 1) | ((k & 8) >> 1); return ((kk >> 3) * 4 + (c >> 5)) * 512 + ((kk & 7) * 32 + (c & 31)) * 2; }
__device__ __forceinline__ int v_rd_base(int lane) { return ((lane & 3) << 3) | (((lane >> 2) & 3) << 6) | (((lane >> 4) & 1) << 5) | (((lane >> 5) & 1) << 8); }
constexpr int v_rd_off(int d0, int ks, int half) { return d0 * 512 + ks * 4096 + half * 2048; }
template <int OFF> __device__ __forceinline__ s16x4 tr_read(int vb) {
  s16x4 r; asm volatile("ds_read_b64_tr_b16 %0, %1 offset:%2" : "=&v"(r) : "v"(vb), "i"(OFF) : "memory"); return r;
}
template <int D0> __device__ __forceinline__ void pv_one(f32x16& od, int vb, bf16x8 pa0, bf16x8 pa1, bf16x8 pa2, bf16x8 pa3) {
  const s16x4 l0 = tr_read<v_rd_off(D0, 0, 0)>(vb), h0 = tr_read<v_rd_off(D0, 0, 1)>(vb), l1 = tr_read<v_rd_off(D0, 1, 0)>(vb), h1 = tr_read<v_rd_off(D0, 1, 1)>(vb);
  const s16x4 l2 = tr_read<v_rd_off(D0, 2, 0)>(vb), h2 = tr_read<v_rd_off(D0, 2, 1)>(vb), l3 = tr_read<v_rd_off(D0, 3, 0)>(vb), h3 = tr_read<v_rd_off(D0, 3, 1)>(vb);
  asm volatile("s_waitcnt lgkmcnt(0)" ::: "memory"); SBAR();
#define PK(L, H) (bf16x8){L[0], L[1], L[2], L[3], H[0], H[1], H[2], H[3]}
  od = __builtin_amdgcn_mfma_f32_32x32x16_bf16(pa0, PK(l0, h0), od, 0, 0, 0);
  od = __builtin_amdgcn_mfma_f32_32x32x16_bf16(pa1, PK(l1, h1), od, 0, 0, 0);
  od = __builtin_amdgcn_mfma_f32_32x32x16_bf16(pa2, PK(l2, h2), od, 0, 0, 0);
  od = __builtin_amdgcn_mfma_f32_32x32x16_bf16(pa3, PK(l3, h3), od, 0, 0, 0);
#undef PK
}
__device__ __forceinline__ void pv_d0(f32x16* o, int vb, bf16x8 pa0, bf16x8 pa1, bf16x8 pa2, bf16x8 pa3) {
  pv_one<0>(o[0], vb, pa0, pa1, pa2, pa3); pv_one<1>(o[1], vb, pa0, pa1, pa2, pa3); pv_one<2>(o[2], vb, pa0, pa1, pa2, pa3); pv_one<3>(o[3], vb, pa0, pa1, pa2, pa3);
}

__device__ __forceinline__ void attn_dense_body(const bf16* __restrict__ Qb, const bf16* __restrict__ Kh, const bf16* __restrict__ Vh,
                                                bf16* __restrict__ Ob, int seq, char* lds) {
  using St = StageB; using SQ = StageB;
  const int tid = threadIdx.x, wid = tid >> 6, lane = tid & 63, r32 = lane & 31, hi = lane >> 5;
  bf16* V_lds = (bf16*)lds; bf16* K_lds = (bf16*)(lds + 2 * SHM_V);
  float* ws = (float*)(lds + 2 * SHM_V + 2 * SHM_K) + wid * 64; float* li_l = ws; float* al_l = ws + 32;
  float m_reg = -1e30f, l_reg = 0; f32x16 o[4] = {}; bf16x8 qr[8];
  const bf16* Qw = Qb + (long)(wid * QBLK + r32) * LDQ + hi * 8;
#pragma unroll
  for (int d0 = 0; d0 < 8; ++d0) qr[d0] = SQ::tobf(SQ::ld8(Qw + d0 * 16));
  const int sr = tid >> 4, sc = (tid & 15) * 8, vst0 = v_st(sr, sc), vst1 = v_st(32 + sr, sc);
  const int vb0 = (int)(uintptr_t)V_lds + v_rd_base(lane);
  struct { typename St::T vs0, vs1, ks0, ks1; } sr_[SDEPTH];
#define SLOAD(i, k0) do { sr_[i].vs0 = St::ld8(&Vh[(long)((k0) + sr) * LDK + sc]); sr_[i].vs1 = St::ld8(&Vh[(long)((k0) + 32 + sr) * LDK + sc]); \
    sr_[i].ks0 = St::ld8(&Kh[(long)((k0) + sr) * LDK + sc]); sr_[i].ks1 = St::ld8(&Kh[(long)((k0) + 32 + sr) * LDK + sc]); } while (0)
#define SWRITE(b, i) do { *(bf16x8*)((char*)V_lds + (b) * SHM_V + vst0) = St::tobf(sr_[i].vs0);          \
    *(bf16x8*)((char*)V_lds + (b) * SHM_V + vst1) = St::tobf(sr_[i].vs1); int kc = sc * 2;               \
    *(bf16x8*)((char*)K_lds + (b) * SHM_K + KSWZ(sr, kc)) = St::tobf(sr_[i].ks0);                       \
    *(bf16x8*)((char*)K_lds + (b) * SHM_K + KSWZ(32 + sr, kc)) = St::tobf(sr_[i].ks1); } while (0)
#define SWAIT() do { if constexpr (SDEPTH == 2) asm volatile("s_waitcnt vmcnt(4)" ::: "memory"); else asm volatile("s_waitcnt vmcnt(0)" ::: "memory"); } while (0)
#define RESC(a) do { if (__any((a) < 1.f)) { if (hi == 0) al_l[r32] = (a); asm volatile("s_waitcnt lgkmcnt(0)" ::: "memory"); \
    for (int d = 0; d < 4; ++d) for (int r = 0; r < 16; ++r) o[d][r] *= al_l[crow(r, hi)]; } } while (0)
  f32x16 pA0, pA1, pB0, pB1; float mnA, mnB, alA, alB; bf16x8 pa0, pa1, pa2, pa3; const int NT = seq / KVBLK;
  constexpr int SE = 0, SO = SDEPTH - 1;
  SLOAD(SE, 0); asm volatile("s_waitcnt vmcnt(0)" ::: "memory"); SWRITE(0, SE); __syncthreads();
  qkt(pA0, pA1, K_lds, qr, r32, hi); partialSM(pA0, pA1, m_reg, mnA, alA);
  SLOAD(SO, KVBLK); if constexpr (SDEPTH == 2) { if (2 < NT) SLOAD(SE, 2 * KVBLK); }
  SWAIT(); SWRITE(1, SO); __syncthreads();
  for (int j = 1; j + 1 < NT; j += 2) {
    SBAR(); qkt(pB0, pB1, (bf16*)((char*)K_lds + SHM_K), qr, r32, hi);
    finishSM(pA0, pA1, alA, l_reg, pa0, pa1, pa2, pa3); SBAR();
    SLOAD(SO, (j + SDEPTH) * KVBLK); SBAR();
    pv_d0(o, vb0, pa0, pa1, pa2, pa3); partialSM(pB0, pB1, m_reg, mnB, alB);
    __syncthreads(); SWAIT(); SWRITE(0, SE);
    RESC(alB); __syncthreads();
    SBAR(); qkt(pA0, pA1, K_lds, qr, r32, hi);
    finishSM(pB0, pB1, alB, l_reg, pa0, pa1, pa2, pa3); SBAR();
    if (SDEPTH == 1 || j + 3 < NT) SLOAD(SE, (j + 1 + SDEPTH) * KVBLK); SBAR();
    pv_d0(o, vb0 + (int)SHM_V, pa0, pa1, pa2, pa3); partialSM(pA0, pA1, m_reg, mnA, alA);
    __syncthreads(); SWAIT(); SWRITE(1, SO);
    RESC(alA); __syncthreads();
  }
  SBAR(); qkt(pB0, pB1, (bf16*)((char*)K_lds + SHM_K), qr, r32, hi);
  finishSM(pA0, pA1, alA, l_reg, pa0, pa1, pa2, pa3); SBAR();
  pv_d0(o, vb0, pa0, pa1, pa2, pa3); partialSM(pB0, pB1, m_reg, mnB, alB);
  __syncthreads(); RESC(alB);
  finishSM(pB0, pB1, alB, l_reg, pa0, pa1, pa2, pa3); SBAR();
  pv_d0(o, vb0 + (int)SHM_V, pa0, pa1, pa2, pa3);
  if (hi == 0) li_l[r32] = l_reg; asm volatile("s_waitcnt lgkmcnt(0)" ::: "memory");
  float rli[16];
#pragma unroll
  for (int r = 0; r < 16; ++r) rli[r] = __builtin_amdgcn_rcpf(li_l[crow(r, hi)]);
  bf16* Ow = Ob + (long)(wid * QBLK) * LDO;
#pragma unroll
  for (int r = 0; r < 16; ++r) { int orow = crow(r, hi);
    for (int d0 = 0; d0 < 4; ++d0) { const unsigned pk = cvtpk(o[d0][r] * rli[r], 0.f); Ow[(long)orow * LDO + d0 * 32 + r32] = (bf16)(pk & 0xffffu); } }
  __syncthreads();
#undef SLOAD
#undef SWRITE
#undef SWAIT
#undef RESC
}

}
#define GAS __attribute__((address_space(1)))
#define LAS __attribute__((address_space(3)))
typedef unsigned short bf16;
typedef unsigned v4u __attribute__((ext_vector_type(4)));
typedef float f32x4 __attribute__((ext_vector_type(4)));
typedef short bf16x8 __attribute__((ext_vector_type(8)));
typedef GAS unsigned gu32;
typedef GAS unsigned long long gu64;
#define RLX_AGENT __ATOMIC_RELAXED, __HIP_MEMORY_SCOPE_AGENT
#define LDS_WAIT() asm volatile("s_waitcnt lgkmcnt(0)" ::: "memory")
#define VM_WAIT() asm volatile("s_waitcnt vmcnt(0)" ::: "memory")
__device__ __forceinline__ unsigned long long rt() { return __builtin_amdgcn_s_memrealtime(); }
__device__ __forceinline__ unsigned f2bf(float f) { unsigned u = __builtin_bit_cast(unsigned, f); return (u + 0x7fffu + ((u >> 16) & 1u)) >> 16; }
__device__ __forceinline__ unsigned pk2(float lo, float hi) { return f2bf(lo) | (f2bf(hi) << 16); }

#define XB_TMO      128
#define XB_XCNT(j)  (256  + 64 * (j))
#define XB_XSUB(j)  (1280 + 64 * (j))
#define XB_XGEN(j)  (2304 + 64 * (j))
#define XB_TOP      3328
#define XB_TOPGEN   3392
#define XCD_BAR_WORDS 3456
#define XB_SPIN_CAP (1u << 18)

__device__ __forceinline__ unsigned xb_ld(unsigned* p)              { return __hip_atomic_load(p, __ATOMIC_RELAXED, __HIP_MEMORY_SCOPE_AGENT); }
__device__ __forceinline__ unsigned xb_add(unsigned* p, unsigned v) { return __hip_atomic_fetch_add(p, v, __ATOMIC_RELAXED, __HIP_MEMORY_SCOPE_AGENT); }
__device__ __forceinline__ unsigned xb_xcc_id() { return (unsigned)__builtin_amdgcn_s_getreg((3 << 11) | 20) & 0xFu; }
#define XB_SPIN(cond, bar) do { unsigned _sp = 0; while (cond) { __builtin_amdgcn_s_sleep(1); \
    if ((++_sp & 255u) == 0u) { if (xb_ld(&(bar)[XB_TMO])) break; if (_sp > XB_SPIN_CAP) { atomicAdd(&(bar)[XB_TMO], 1u); break; } } } } while (0)

struct XcdBarrier {
    unsigned* bar; unsigned x;
    volatile LAS unsigned* st;
};

__device__ __forceinline__ XcdBarrier xcd_barrier_post(unsigned* bar, volatile LAS unsigned* st) {
    XcdBarrier b; b.bar = bar; b.x = xb_xcc_id(); b.st = st;
    if (threadIdx.x == 0) (void)xb_add(&bar[XB_XCNT(b.x)], 1u);
    return b;
}
__device__ __forceinline__ void xcd_barrier_complete(unsigned* bar, unsigned x, unsigned& nloc, unsigned& nx) {
    const unsigned G = gridDim.x * gridDim.y * gridDim.z;
    unsigned sum, cnt, mine, sp = 0u;
    for (;;) {
        sum = 0u; cnt = 0u; mine = 0u;
#pragma unroll
        for (unsigned j = 0; j < 16; ++j) { const unsigned c = xb_ld(&bar[XB_XCNT(j)]); sum += c; cnt += (c > 0u) ? 1u : 0u; mine = (j == x) ? c : mine; }
        if (sum == G) break;
        __builtin_amdgcn_s_sleep(1);
        if ((++sp & 255u) == 0u) { if (xb_ld(&bar[XB_TMO])) break; if (sp > XB_SPIN_CAP) { atomicAdd(&bar[XB_TMO], 1u); break; } }
    }
    nloc = mine > 0u ? mine : 1u; nx = cnt > 0u ? cnt : 1u;
}

__device__ __forceinline__ void xcd_barrier(const XcdBarrier& b) {
    asm volatile("s_waitcnt vmcnt(0)" ::: "memory");
    __syncthreads();
    if (threadIdx.x == 0) {
        unsigned* bar = b.bar;
        __builtin_amdgcn_s_waitcnt(0);
        unsigned nloc = b.st[0], nx = b.st[1];
        if (nloc == 0u) { xcd_barrier_complete(bar, b.x, nloc, nx); b.st[0] = nloc; b.st[1] = nx; }
        const unsigned old = xb_add(&bar[XB_XSUB(b.x)], 1u);
        const unsigned gen = old / nloc;
        if (old + 1u == (gen + 1u) * nloc) {
            __builtin_amdgcn_fence(__ATOMIC_RELEASE, "agent");
            asm volatile("s_waitcnt vmcnt(0)" ::: "memory");
            const unsigned og = xb_add(&bar[XB_TOP], 1u);
            const unsigned tg = og / nx;
            if (og + 1u == (tg + 1u) * nx) xb_add(&bar[XB_TOPGEN], 1u);
            else XB_SPIN(xb_ld(&bar[XB_TOPGEN]) == tg, bar);
            __builtin_amdgcn_fence(__ATOMIC_ACQUIRE, "agent");
            xb_add(&bar[XB_XGEN(b.x)], 1u);
            asm volatile("s_waitcnt vmcnt(0)" ::: "memory");
        } else {
            XB_SPIN(xb_ld(&bar[XB_XGEN(b.x)]) == gen, bar);
            __builtin_amdgcn_fence(__ATOMIC_ACQUIRE, "agent");
            asm volatile("s_waitcnt vmcnt(0)" ::: "memory");
        }
    }
    __syncthreads();
}
constexpr int NWAVES = 8;
constexpr int BATCH = 2, SEQ = 8192, DM = 2048, NTOK = BATCH * SEQ;
constexpr int INW = 8704, COL_Q = 0, COL_K = 1024, COL_V = 1280, COL_HY = 1536, COL_G = 4608;
constexpr int HW = 1024;
constexpr int NEXP = 32, DEXP = 1024;
constexpr int FHID = 64;
constexpr float LN_EPS = 1e-5f, QK_EPS = 1e-6f, FILTER_EPS = 1e-6f;
constexpr float ALPHA = 1.189207115002721f;
constexpr int MAXROWS = 2 * NTOK + NEXP * 256;
constexpr int ELIST = NTOK;

constexpr size_t MiB = 1u << 20;
constexpr size_t WS_CTL = 0, CTL_ZERO_BYTES = 1 * MiB;
constexpr size_t WS_STATS = 1 * MiB;
constexpr size_t WS_ROPEC = 2 * MiB, WS_ROPES = 4 * MiB;
constexpr size_t WS_H2 = 6 * MiB;
constexpr size_t WS_WRT = 8 * MiB;
constexpr size_t WS_ETOK = 9 * MiB;
constexpr size_t WS_EW = 11 * MiB;
constexpr size_t WS_META = 13 * MiB;
constexpr size_t WS_WIN = 16 * MiB;
constexpr size_t WS_WAO = 50 * MiB;
constexpr size_t WS_WHY = 54 * MiB;
constexpr size_t WS_WOUT = 58 * MiB;
constexpr size_t WS_WGU = 66 * MiB;
constexpr size_t WS_WD = 322 * MiB;
constexpr size_t WS_XN = 450 * MiB;
constexpr size_t WS_O = 514 * MiB;
constexpr size_t WS_X0C = 546 * MiB;
constexpr size_t WS_Y = 450 * MiB;
constexpr size_t WS_ZT = 578 * MiB;
constexpr size_t WS_KT = 642 * MiB;
constexpr size_t WS_AH = 642 * MiB;
constexpr size_t WS_PROJ = 706 * MiB;
constexpr size_t WS_PRE1 = 706 * MiB;
constexpr size_t WS_XS = 706 * MiB;
constexpr size_t WS_HB = 866 * MiB;
constexpr size_t WS_END = 978 * MiB;
constexpr int CW_TMO = 0, CW_CODE = 1;
constexpr int CW_BAR = 4096;
constexpr int CW_ECNT = 16384;

constexpr int LDS_BYTES = 147456;
constexpr int LDSCTL_OFF = 145408;
constexpr int L_MISC = LDSCTL_OFF;
constexpr int L_CNT = LDSCTL_OFF + 128;
constexpr int L_OFF = LDSCTL_OFF + 256;
constexpr int L_RBX = LDSCTL_OFF + 512;
constexpr int L_LB = LDSCTL_OFF + 1280;

struct Args { const float* in[31]; float* out; unsigned char* ws; int ph_lo, ph_hi; };
typedef unsigned long long u64;
typedef float f32x2 __attribute__((ext_vector_type(2)));
typedef unsigned u32x2 __attribute__((ext_vector_type(2)));

__device__ __forceinline__ float wave_sum(float v) {
#pragma unroll
    for (int o = 1; o < 64; o <<= 1) v += __shfl_xor(v, o);
    return v;
}
__device__ __forceinline__ float bf_lo(unsigned w) { return __uint_as_float(w << 16); }
__device__ __forceinline__ float bf_hi(unsigned w) { return __uint_as_float(w & 0xffff0000u); }
__device__ __forceinline__ float bf_1(bf16 b) { return __uint_as_float((unsigned)b << 16); }

__device__ __forceinline__ void tr_item(const float* W, int N, int k0, int n0, bf16* dst, int K, LAS float* scr, int lane) {
#pragma unroll 8
    for (int i = 0; i < 32; ++i) { const int kk = 2 * i + (lane >> 5); scr[kk * 33 + (lane & 31)] = W[(size_t)(k0 + kk) * N + n0 + (lane & 31)]; }
    LDS_WAIT(); asm volatile("" ::: "memory");
    const int c = lane & 7;
#pragma unroll
    for (int j = 0; j < 4; ++j) { const int n = (lane >> 3) + 8 * j; const LAS float* s = scr + (8 * c) * 33 + n;
        v4u o; o.x = pk2(s[0 * 33], s[1 * 33]); o.y = pk2(s[2 * 33], s[3 * 33]); o.z = pk2(s[4 * 33], s[5 * 33]); o.w = pk2(s[6 * 33], s[7 * 33]);
        *(GAS v4u*)(dst + (size_t)n * K + k0 + 8 * c) = o; }
    LDS_WAIT(); asm volatile("" ::: "memory");
}
__device__ __forceinline__ void p0_prologue(const Args& a, LAS unsigned char* lds, int gw, int NGW, int wave, int lane) {
    unsigned char* ws = a.ws;
    LAS float* scr = (LAS float*)(lds + wave * 16384);
    constexpr int I_IN = 32 * 272, I_AO = 16 * 64, I_HY = 16 * 64, I_OUT = 32 * 64, I_G = 32 * 1024, I_U = 32 * 1024, I_D = 32 * 1024;
    constexpr int NITEMS = I_IN + I_AO + I_HY + I_OUT + I_G + I_U + I_D;
    for (int it = gw; it < NITEMS; it += NGW) {
        int r = it;
        if (r < I_IN) { const int kb = r / 272, nb = r % 272; tr_item(a.in[3], INW, kb * 64, nb * 32, (bf16*)(ws + WS_WIN) + (size_t)(nb * 32) * 2048, 2048, scr, lane); continue; } r -= I_IN;
        if (r < I_AO) { const int kb = r / 64, nb = r % 64; tr_item(a.in[17], 2048, kb * 64, nb * 32, (bf16*)(ws + WS_WAO) + (size_t)(nb * 32) * 1024, 1024, scr, lane); continue; } r -= I_AO;
        if (r < I_HY) { const int kb = r / 64, nb = r % 64; tr_item(a.in[18], 2048, kb * 64, nb * 32, (bf16*)(ws + WS_WHY) + (size_t)(nb * 32) * 1024, 1024, scr, lane); continue; } r -= I_HY;
        if (r < I_OUT) { const int kb = r / 64, nb = r % 64; tr_item(a.in[19], 2048, kb * 64, nb * 32, (bf16*)(ws + WS_WOUT) + (size_t)(nb * 32) * 2048, 2048, scr, lane); continue; } r -= I_OUT;
        if (r < I_G + I_U) { const int up = r >= I_G; if (up) r -= I_G; const int e = r >> 10, q = r & 1023, kb = q >> 5, nb = q & 31, n0 = nb * 32;
            const float* src = (up ? a.in[27] : a.in[26]) + (size_t)e * 2048 * 1024;
            tr_item(src, 1024, kb * 64, n0, (bf16*)(ws + WS_WGU) + (size_t)(e * 2048 + (n0 >> 7) * 256 + (n0 & 127) + (up ? 128 : 0)) * 2048, 2048, scr, lane); continue; } r -= I_G + I_U;
        { const int e = r >> 10, q = r & 1023, kb = q >> 6, nb = q & 63;
            tr_item(a.in[28] + (size_t)e * 1024 * 2048, 2048, kb * 64, nb * 32, (bf16*)(ws + WS_WD) + (size_t)(e * 2048 + nb * 32) * 1024, 1024, scr, lane); }
    }
    {
        const float* g = a.in[1]; const float* b = a.in[2]; float* stats = (float*)(ws + WS_STATS); bf16* XN = (bf16*)(ws + WS_XN);
        for (int m = gw; m < NTOK; m += NGW) {
            const GAS f32x4* xr = (const GAS f32x4*)(a.in[0] + (size_t)m * DM) + lane;
            f32x4 v[8]; float s = 0.f;
#pragma unroll
            for (int j = 0; j < 8; ++j) { v[j] = xr[64 * j]; s += (v[j].x + v[j].y) + (v[j].z + v[j].w); }
            const float mean = wave_sum(s) * (1.f / DM); float s2 = 0.f;
#pragma unroll
            for (int j = 0; j < 8; ++j) { v[j] = v[j] - mean; s2 += (v[j].x * v[j].x + v[j].y * v[j].y) + (v[j].z * v[j].z + v[j].w * v[j].w); }
            const float rstd = 1.f / sqrtf(wave_sum(s2) * (1.f / DM) + LN_EPS);
            if (lane == 0) { stats[2 * m] = mean; stats[2 * m + 1] = rstd; }
            GAS u64* o8 = (GAS u64*)(XN + (size_t)m * DM) + lane;
#pragma unroll
            for (int j = 0; j < 8; ++j) { const f32x4 gg = *(const f32x4*)(g + 4 * lane + 256 * j), bb = *(const f32x4*)(b + 4 * lane + 256 * j); const f32x4 y = v[j] * rstd * gg + bb;
                o8[64 * j] = (u64)pk2(y.x, y.y) | ((u64)pk2(y.z, y.w) << 32); }
        }
    }
    const int gt = gw * 64 + lane, NGT = NGW * 64;
    {
        float* WRT = (float*)(ws + WS_WRT);
        for (int i = gt; i < 48 * 2048; i += NGT) { const int col = i >> 11, k = i & 2047; float v = 0.f;
            if (col < 4) v = a.in[22][k * 4 + col]; else if (col < 36) v = a.in[24][k * 32 + (col - 4)];
            WRT[i] = v; }
    }
    {
        float* rc = (float*)(ws + WS_ROPEC); float* rs = (float*)(ws + WS_ROPES);
        for (int i = gt; i < SEQ * 64; i += NGT) { const int t = i >> 6, f = i & 63; const int pos = (f < 32) ? (t >> 6) : (t & 63); const int fi = f & 31;
            const float inv = (float)exp2(-(double)fi * (13.287712379549449 / 32.0));
            const float ang = (float)pos * inv; const double ad = (double)ang;
            rc[i] = (float)cos(ad); rs[i] = (float)sin(ad); }
    }
    {
        const float* w1 = a.in[9]; const float* b1 = a.in[10]; const float* f1 = a.in[11]; const float* w2 = a.in[12]; const float* b2 = a.in[13]; const float* f2 = a.in[14];
        float* H2 = (float*)(ws + WS_H2);
        LAS float* fe = (LAS float*)(lds + 8 * 16384); LAS float* h1s = fe + 8 * 33;
        const int tid = wave * 64 + lane, p = tid >> 6, m = tid & 63;
        for (int blk = gw / NWAVES; blk < SEQ / 8; blk += NGW / NWAVES) {
            __syncthreads();
            if (tid < 8 * 33) { const int pp = tid / 33, i = tid % 33, j = blk * 8 + pp; float v;
                if (i == 0) v = (float)j / (float)(SEQ - 1);
                else { const int bi = (i - 1) & 15; const double band = 1e-4 + (double)bi * ((15.0 - 1e-4) / 15.0); const double ar = band * (6.283185307179586 * (double)j / (double)SEQ);
                    v = (i <= 16) ? (float)cos(ar) : (float)(-sin(ar)); }
                fe[tid] = v; }
            __syncthreads();
            { float acc = b1[m];
#pragma unroll
              for (int i = 0; i < 33; ++i) acc += fe[p * 33 + i] * w1[i * 64 + m];
              h1s[p * 64 + m] = sinf(f1[m] * acc); }
            __syncthreads();
            { float acc = b2[m];
#pragma unroll 16
              for (int i = 0; i < 64; ++i) acc += h1s[p * 64 + i] * w2[i * 64 + m];
              H2[(size_t)(blk * 8 + p) * 64 + m] = sinf(f2[m] * acc); }
        }
    }
}

__device__ __forceinline__ void p2_qk(const Args& a, int gw, int NGW, int lane) {
    bf16* PROJ = (bf16*)(a.ws + WS_PROJ); const float* rc = (const float*)(a.ws + WS_ROPEC); const float* rs = (const float*)(a.ws + WS_ROPES);
    const float gq0 = a.in[5][2 * lane], gq1 = a.in[5][2 * lane + 1], gk0 = a.in[6][2 * lane], gk1 = a.in[6][2 * lane + 1];
    const int idx = (lane >> 5) * 32 + ((2 * lane) & 31); const float sgn = (lane & 16) ? 1.f : -1.f;
    for (int tok = gw; tok < NTOK; tok += NGW) {
        const int t = tok & (SEQ - 1);
        const float c0 = rc[t * 64 + idx], c1 = rc[t * 64 + idx + 1], s0 = rs[t * 64 + idx] * sgn, s1 = rs[t * 64 + idx + 1] * sgn;
        unsigned* row = (unsigned*)(PROJ + (size_t)tok * INW) + lane;
#pragma unroll
        for (int h = 0; h < 10; ++h) {
            const unsigned w = row[h * 64];
            float x0 = bf_lo(w), x1 = bf_hi(w);
            const float rn = rsqrtf(wave_sum(x0 * x0 + x1 * x1) * (1.f / 128.f) + QK_EPS);
            x0 *= rn * (h < 8 ? gq0 : gk0); x1 *= rn * (h < 8 ? gq1 : gk1);
            const float p0 = __shfl_xor(x0, 16), p1 = __shfl_xor(x1, 16);
            row[h * 64] = pk2(x0 * c0 + p0 * s0, x1 * c1 + p1 * s1);
        }
    }
}
__device__ __forceinline__ void p2_conv(const Args& a, LAS unsigned char* lds, int vcu, int G, int tid) {
    const bf16* PROJ = (const bf16*)(a.ws + WS_PROJ); bf16* X0C = (bf16*)(a.ws + WS_X0C); float* ZT = (float*)(a.ws + WS_ZT);
    const float* cw = a.in[7]; const float* cb = a.in[8];
    LAS float* zt = (LAS float*)lds;
    const int c = tid & 127, tr = tid >> 7;
    for (int it = vcu; it < 2048; it += G) {
        const int tokblk = it >> 3, chblk = it & 7, ch = chblk * 128 + c;
        const int T0 = tokblk * 64, tb = T0 + tr * 16, sb = tb & (SEQ - 1);
        float res[3][16];
#pragma unroll
        for (int p = 0; p < 3; ++p) {
            const int col = p * 1024 + ch; const float w0 = cw[col], w1 = cw[3072 + col], w2 = cw[6144 + col], bias = cb[col];
            const bf16* src = PROJ + (size_t)tb * INW + COL_HY + col;
            float in[18];
#pragma unroll
            for (int i = 0; i < 18; ++i) { const int s = sb + i - 1; in[i] = (s >= 0 && s < SEQ) ? bf_1(src[(long)(i - 1) * INW]) : 0.f; }
#pragma unroll
            for (int i = 0; i < 16; ++i) res[p][i] = bias + w0 * in[i] + w1 * in[i + 1] + w2 * in[i + 2];
        }
#pragma unroll
        for (int i = 0; i < 16; ++i) { X0C[(size_t)(tb + i) * HW + ch] = (bf16)f2bf(res[0][i]); zt[c * 65 + tr * 16 + i] = res[2][i] * res[1][i]; }
        __syncthreads();
        { const int c2 = tid >> 2, seg = tid & 3, b = T0 >> 13, s0 = T0 & (SEQ - 1);
          float* dst = ZT + ((size_t)(chblk * 128 + c2) * 2 + b) * SEQ + s0 + seg * 16;
#pragma unroll
          for (int k = 0; k < 4; ++k) { f32x4 v; v.x = zt[c2 * 65 + seg * 16 + 4 * k]; v.y = zt[c2 * 65 + seg * 16 + 4 * k + 1]; v.z = zt[c2 * 65 + seg * 16 + 4 * k + 2]; v.w = zt[c2 * 65 + seg * 16 + 4 * k + 3]; *(f32x4*)(dst + 4 * k) = v; } }
        __syncthreads();
    }
}
__device__ __forceinline__ void p2_filter(const Args& a, LAS unsigned char* lds, int vcu, int G, int tid) {
    const float* H2 = (const float*)(a.ws + WS_H2); const float* w3 = a.in[15]; float* KT = (float*)(a.ws + WS_KT);
    LAS float* tf = (LAS float*)lds; LAS float* tbk = tf + 128 * 65; LAS float* h2s = tbk + 128 * 65;
    const int c = tid & 127, jq = tid >> 7;
    const float min_decay = -3.0701134573253944f, max_decay = -15.350567286626972f;
    for (int it = vcu; it < 1024; it += G) {
        const int jblk = it >> 3, chblk = it & 7, ch = chblk * 128 + c, j0 = jblk * 64;
        for (int i = tid; i < 64 * 64; i += 512) h2s[i] = H2[(size_t)j0 * 64 + i];
        __syncthreads();
        const float delta = fabsf(min_decay + (max_decay - min_decay) * ((float)ch / 1023.f));
#pragma unroll 1
        for (int half = 0; half < 2; ++half) {
            float wv[64];
#pragma unroll
            for (int m = 0; m < 64; ++m) wv[m] = w3[m * 2048 + half * 1024 + ch];
            LAS float* dstt = half ? tbk : tf;
#pragma unroll 2
            for (int i = 0; i < 16; ++i) { const int jj = jq * 16 + i, j = j0 + jj; float af = 0.f;
#pragma unroll
                for (int m = 0; m < 64; ++m) af += h2s[jj * 64 + m] * wv[m];
                dstt[c * 65 + jj] = af * expf(-((float)j / (float)(SEQ - 1)) * delta); }
        }
        __syncthreads();
        { const int c2 = tid >> 2, seg = tid & 3; float* dst = KT + (size_t)(chblk * 128 + c2) * 16384;
#pragma unroll
          for (int k = 0; k < 16; ++k) { const int jj = seg * 16 + k, j = j0 + jj; dst[j] = tf[c2 * 65 + jj];
              if (j == 0) dst[8192] = 0.f; else dst[16384 - j] = tbk[c2 * 65 + jj]; } }
        __syncthreads();
    }
}

__device__ __forceinline__ void p4_conv_direct(const Args& a, LAS unsigned char* lds, int vcu, int G, int tid) {
    const float* KT = (const float*)(a.ws + WS_KT); float* ZT = (float*)(a.ws + WS_ZT); const float* dbias = a.in[16];
    LAS float* kk = (LAS float*)lds;
    LAS float* zz = kk + 17408;
    LAS float* red = zz + 16384;
    const int lane = tid & 63, wave = tid >> 6;
    for (int ch = vcu; ch < HW; ch += G) {
        float ss = 0.f;
        for (int i = tid; i < 16384; i += 512) { const float v = KT[(size_t)ch * 16384 + i]; ss += v * v; kk[i + (i >> 4)] = v; }
        for (int i = tid; i < 16384; i += 512) zz[i] = ZT[(size_t)ch * 16384 + i];
        ss = wave_sum(ss); if (lane == 0) red[wave] = ss;
        __syncthreads();
        float tot = 0.f;
#pragma unroll
        for (int w = 0; w < 8; ++w) tot += red[w];
        const float scale = rsqrtf(tot + FILTER_EPS), db = dbias[ch];
        const int t0 = tid * 16;
        float acc0[16], acc1[16];
#pragma unroll
        for (int i = 0; i < 16; ++i) { acc0[i] = 0.f; acc1[i] = 0.f; }
        for (int s0 = 0; s0 < SEQ; s0 += 16) {
            float kw[31];
#pragma unroll
            for (int q = 0; q < 31; ++q) { const int idx = (t0 - s0 - 15 + q) & 16383; kw[q] = kk[idx + (idx >> 4)]; }
#pragma unroll
            for (int jj = 0; jj < 16; ++jj) { const float z0 = zz[s0 + jj], z1 = zz[SEQ + s0 + jj];
#pragma unroll
                for (int i = 0; i < 16; ++i) { acc0[i] += kw[i - jj + 15] * z0; acc1[i] += kw[i - jj + 15] * z1; } }
        }
        float* y0 = ZT + (size_t)ch * 16384 + t0; float* y1 = y0 + SEQ;
#pragma unroll
        for (int i = 0; i < 16; ++i) { y0[i] = acc0[i] * scale + db * zz[t0 + i]; y1[i] = acc1[i] * scale + db * zz[SEQ + t0 + i]; }
        __syncthreads();
    }
}

__device__ __forceinline__ void p5_ah(const Args& a, LAS unsigned char* lds, int vcu, int G, int tid) {
    const float* YT = (const float*)(a.ws + WS_ZT); const bf16* X0C = (const bf16*)(a.ws + WS_X0C); bf16* AH = (bf16*)(a.ws + WS_AH);
    LAS float* yt = (LAS float*)lds;
    for (int it = vcu; it < 2048; it += G) {
        const int tokblk = it >> 3, chblk = it & 7, T0 = tokblk * 64, b = T0 >> 13, s0 = T0 & (SEQ - 1);
        { const int c2 = tid >> 2, seg = tid & 3; const float* src = YT + ((size_t)(chblk * 128 + c2) * 2 + b) * SEQ + s0 + seg * 16;
#pragma unroll
          for (int k = 0; k < 4; ++k) { const f32x4 v = *(const f32x4*)(src + 4 * k); yt[c2 * 65 + seg * 16 + 4 * k] = v.x; yt[c2 * 65 + seg * 16 + 4 * k + 1] = v.y; yt[c2 * 65 + seg * 16 + 4 * k + 2] = v.z; yt[c2 * 65 + seg * 16 + 4 * k + 3] = v.w; } }
        __syncthreads();
        { const int t = tid >> 3, cs = tid & 7; const size_t off = (size_t)(T0 + t) * HW + chblk * 128 + cs * 16;
          const v4u xa = *(const v4u*)(X0C + off), xb = *(const v4u*)(X0C + off + 8);
          const unsigned xw[8] = {xa.x, xa.y, xa.z, xa.w, xb.x, xb.y, xb.z, xb.w}; unsigned ow[8];
#pragma unroll
          for (int k = 0; k < 8; ++k) ow[k] = pk2(bf_lo(xw[k]) * yt[(cs * 16 + 2 * k) * 65 + t], bf_hi(xw[k]) * yt[(cs * 16 + 2 * k + 1) * 65 + t]);
          *(v4u*)(AH + off) = (v4u){ow[0], ow[1], ow[2], ow[3]}; *(v4u*)(AH + off + 8) = (v4u){ow[4], ow[5], ow[6], ow[7]}; }
        __syncthreads();
    }
}

typedef float f32x4m __attribute__((ext_vector_type(4)));
__device__ __forceinline__ void p8_ln_route(const Args& a, LAS unsigned char* lds, int vcu, int G, int tid) {
    const float* PRE = (const float*)(a.ws + WS_PRE1); float* H1 = a.out; const float* g = a.in[20]; const float* bt = a.in[21];
    const float* WRT = (const float*)(a.ws + WS_WRT); const float* brg = a.in[23]; const float* bre = a.in[25];
    int* ETOK = (int*)(a.ws + WS_ETOK); float* EW = (float*)(a.ws + WS_EW); gu32* ctl = (gu32*)(a.ws + WS_CTL);
    LAS float* lg = (LAS float*)lds;
    LAS int* lcnt = (LAS int*)(lds + 16384); LAS int* lbase = (LAS int*)(lds + 16384 + 128);
    const int lane = tid & 63, wave = tid >> 6;
    for (int it = vcu; it < NTOK / 64; it += G) {
        const int r0 = it * 64;
        if (tid < 32) lcnt[tid] = 0;
        for (int i = 0; i < 8; ++i) { const int r = r0 + wave * 8 + i;
            const GAS f32x4* xr = (const GAS f32x4*)(PRE + (size_t)r * DM) + lane; f32x4 v[8]; float s = 0.f;
#pragma unroll
            for (int j = 0; j < 8; ++j) { v[j] = xr[64 * j]; s += (v[j].x + v[j].y) + (v[j].z + v[j].w); }
            const float mean = wave_sum(s) * (1.f / DM); float s2 = 0.f;
#pragma unroll
            for (int j = 0; j < 8; ++j) { v[j] = v[j] - mean; s2 += (v[j].x * v[j].x + v[j].y * v[j].y) + (v[j].z * v[j].z + v[j].w * v[j].w); }
            const float rstd = 1.f / sqrtf(wave_sum(s2) * (1.f / DM) + LN_EPS);
            GAS f32x4* o = (GAS f32x4*)(H1 + (size_t)r * DM) + lane;
#pragma unroll
            for (int j = 0; j < 8; ++j) { const f32x4 gg = *(const f32x4*)(g + 4 * lane + 256 * j), bb = *(const f32x4*)(bt + 4 * lane + 256 * j); o[64 * j] = v[j] * rstd * gg + bb; }
        }
        VM_WAIT(); __syncthreads();
        if (wave < 4) {
            f32x4m acc0 = {0.f, 0.f, 0.f, 0.f}, acc1 = acc0, acc2 = acc0;
            const float* ap = H1 + (size_t)(r0 + wave * 16 + (lane & 15)) * DM + 4 * (lane >> 4);
            const float* bp = WRT + (size_t)(lane & 15) * DM + 4 * (lane >> 4);
#pragma unroll 2
            for (int k0 = 0; k0 < DM; k0 += 16) {
                const f32x4 av = *(const f32x4*)(ap + k0), b0 = *(const f32x4*)(bp + k0), b1 = *(const f32x4*)(bp + 16 * DM + k0), b2 = *(const f32x4*)(bp + 32 * DM + k0);
#pragma unroll
                for (int j = 0; j < 4; ++j) { acc0 = __builtin_amdgcn_mfma_f32_16x16x4f32(av[j], b0[j], acc0, 0, 0, 0); acc1 = __builtin_amdgcn_mfma_f32_16x16x4f32(av[j], b1[j], acc1, 0, 0, 0); acc2 = __builtin_amdgcn_mfma_f32_16x16x4f32(av[j], b2[j], acc2, 0, 0, 0); }
            }
#pragma unroll
            for (int r = 0; r < 4; ++r) { LAS float* p = lg + (wave * 16 + (lane >> 4) * 4 + r) * 48 + (lane & 15); p[0] = acc0[r]; p[16] = acc1[r]; p[32] = acc2[r]; }
        }
        __syncthreads();
        int e0 = 0, e1 = 0, p0 = 0, p1 = 0; float w0 = 0.f, w1 = 0.f;
        if (tid < 64) {
            const LAS float* L = lg + tid * 48;
            float c[4]; int grp = 0; float cm;
#pragma unroll
            for (int i = 0; i < 4; ++i) c[i] = L[i] + brg[i];
            cm = c[0];
#pragma unroll
            for (int i = 1; i < 4; ++i) if (c[i] > cm) { cm = c[i]; grp = i; }
            float den = 0.f;
#pragma unroll
            for (int i = 0; i < 4; ++i) den += expf(c[i] - cm);
            const float pg = 1.f / den;
            float f[8];
#pragma unroll
            for (int i = 0; i < 8; ++i) f[i] = L[4 + grp * 8 + i] + bre[grp * 8 + i];
            int i0 = 0; float f0 = f[0];
#pragma unroll
            for (int i = 1; i < 8; ++i) if (f[i] > f0) { f0 = f[i]; i0 = i; }
            int i1 = -1; float f1 = -3.0e38f;
#pragma unroll
            for (int i = 0; i < 8; ++i) if (i != i0 && f[i] > f1) { f1 = f[i]; i1 = i; }
            const float q0 = 1.f / (1.f + expf(f1 - f0));
            w0 = pg * q0; w1 = pg * (1.f - q0); e0 = grp * 8 + i0; e1 = grp * 8 + i1;
            p0 = atomicAdd((int*)(lcnt + e0), 1); p1 = atomicAdd((int*)(lcnt + e1), 1);
        }
        __syncthreads();
        if (tid < 32) { const int n = lcnt[tid]; lbase[tid] = n ? (int)__hip_atomic_fetch_add(ctl + CW_ECNT + 64 * tid, (unsigned)n, RLX_AGENT) : 0; }
        __syncthreads();
        if (tid < 64) { const int tok = r0 + tid; const int q0 = lbase[e0] + p0, q1 = lbase[e1] + p1;
            ETOK[e0 * ELIST + q0] = tok * 2; EW[e0 * ELIST + q0] = w0; ETOK[e1 * ELIST + q1] = tok * 2 + 1; EW[e1 * ELIST + q1] = w1; }
        __syncthreads();
    }
}
__device__ __forceinline__ int expert_tables(const Args& a, LAS unsigned char* lds, int tid) {
    LAS int* cnt = (LAS int*)(lds + L_CNT); LAS int* off = (LAS int*)(lds + L_OFF); LAS int* rbx = (LAS int*)(lds + L_RBX);
    gu32* ctl = (gu32*)(a.ws + WS_CTL);
    __syncthreads();
    if (tid < 32) cnt[tid] = (int)__hip_atomic_load(ctl + CW_ECNT + 64 * tid, RLX_AGENT);
    __syncthreads();
    if (tid == 0) { int o = 0; for (int e = 0; e < 32; ++e) { off[e] = o; const int nb = (cnt[e] + 255) >> 8; for (int k = 0; k < nb; ++k) rbx[(o >> 8) + k] = e; o += nb << 8; } off[32] = o; }
    __syncthreads();
    return off[32];
}
__device__ __forceinline__ void p9_gather(const Args& a, LAS unsigned char* lds, int gw, int NGW, int tid) {
    const int total = expert_tables(a, lds, tid);
    LAS int* cnt = (LAS int*)(lds + L_CNT); LAS int* off = (LAS int*)(lds + L_OFF); LAS int* rbx = (LAS int*)(lds + L_RBX);
    const int* ETOK = (const int*)(a.ws + WS_ETOK); const float* EW = (const float*)(a.ws + WS_EW); int* META = (int*)(a.ws + WS_META);
    bf16* XS = (bf16*)(a.ws + WS_XS); const float* H1 = a.out; const int lane = tid & 63;
    for (int row = gw; row < total; row += NGW) {
        const int e = rbx[row >> 8], pos = row - off[e];
        GAS u64* o8 = (GAS u64*)(XS + (size_t)row * DM) + lane;
        if (pos < cnt[e]) { const int ts = ETOK[e * ELIST + pos]; const float w = EW[e * ELIST + pos];
            if (lane == 0) { META[2 * row] = ts; META[2 * row + 1] = __float_as_int(w); }
            const GAS f32x4* xr = (const GAS f32x4*)(H1 + (size_t)(ts >> 1) * DM) + lane;
#pragma unroll
            for (int j = 0; j < 8; ++j) { const f32x4 v = xr[64 * j]; o8[64 * j] = (u64)pk2(v.x, v.y) | ((u64)pk2(v.z, v.w) << 32); }
        } else { if (lane == 0) { META[2 * row] = -1; META[2 * row + 1] = 0; }
#pragma unroll
            for (int j = 0; j < 8; ++j) o8[64 * j] = 0ull; }
    }
}
__device__ __forceinline__ void p12_final(const Args& a, int gw, int NGW, int lane) {
    float* H1 = a.out; const bf16* Y = (const bf16*)(a.ws + WS_Y); const float* g = a.in[29]; const float* bt = a.in[30];
    for (int r = gw; r < NTOK; r += NGW) {
        GAS f32x4* xr = (GAS f32x4*)(H1 + (size_t)r * DM) + lane; const GAS u32x2* y0 = (const GAS u32x2*)(Y + (size_t)r * DM) + lane; const GAS u32x2* y1 = (const GAS u32x2*)(Y + ((size_t)NTOK + r) * DM) + lane;
        f32x4 v[8]; float s = 0.f;
#pragma unroll
        for (int j = 0; j < 8; ++j) { const u32x2 ya = y0[64 * j], yb = y1[64 * j];
            v[j] = xr[64 * j] * ALPHA + (f32x4){bf_lo(ya.x), bf_hi(ya.x), bf_lo(ya.y), bf_hi(ya.y)} + (f32x4){bf_lo(yb.x), bf_hi(yb.x), bf_lo(yb.y), bf_hi(yb.y)};
            s += (v[j].x + v[j].y) + (v[j].z + v[j].w); }
        const float mean = wave_sum(s) * (1.f / DM); float s2 = 0.f;
#pragma unroll
        for (int j = 0; j < 8; ++j) { v[j] = v[j] - mean; s2 += (v[j].x * v[j].x + v[j].y * v[j].y) + (v[j].z * v[j].z + v[j].w * v[j].w); }
        const float rstd = 1.f / sqrtf(wave_sum(s2) * (1.f / DM) + LN_EPS);
#pragma unroll
        for (int j = 0; j < 8; ++j) { const f32x4 gg = *(const f32x4*)(g + 4 * lane + 256 * j), bb = *(const f32x4*)(bt + 4 * lane + 256 * j); xr[64 * j] = v[j] * rstd * gg + bb; }
    }
}
#ifndef MK_ONE_LAUNCH
#define MK_ONE_LAUNCH 0
#endif
constexpr int N_PHASES = 12;
__global__ void __launch_bounds__(NWAVES * 64, 2) fwd(Args args) {
    extern __shared__ __attribute__((aligned(16))) unsigned char lds_raw[];
    LAS unsigned char* lds = (LAS unsigned char*)lds_raw;
    const int tid = threadIdx.x, lane = tid & 63, wave = __builtin_amdgcn_readfirstlane(tid >> 6);
    const int G = gridDim.x, bx = blockIdx.x, vcu = (G % 8 == 0) ? (bx % 8) * (G / 8) + bx / 8 : bx;
    const int gw = vcu * NWAVES + wave, NGW = G * NWAVES;
    unsigned char* ws = args.ws;
    gu32* ctl = (gu32*)(ws + WS_CTL);
    for (int u = tid; u < (LDS_BYTES - LDSCTL_OFF) / 4; u += NWAVES * 64) ((LAS unsigned*)(lds + LDSCTL_OFF))[u] = 0u;
    __syncthreads();
    XcdBarrier bar; bar.bar = (unsigned*)(ctl + CW_BAR); bar.x = 0; bar.st = nullptr;
    if (MK_ONE_LAUNCH) bar = xcd_barrier_post((unsigned*)(ctl + CW_BAR), (volatile LAS unsigned*)(lds + L_MISC) + 8);
    const int lo = args.ph_lo, hi = args.ph_hi;
#ifndef PHMASK
#define PHMASK 0xFFFF
#endif
#define IN(k) (((PHMASK >> (k)) & 1) && lo <= (k) && (k) < hi)
#define SEAM(k) do { if (MK_ONE_LAUNCH && IN(k) && IN((k) + 1)) xcd_barrier(bar); } while (0)

    bf16* PROJ = (bf16*)(ws + WS_PROJ);
    if (IN(0)) { p0_prologue(args, lds, gw, NGW, wave, lane); }
    SEAM(0);
    if (IN(1)) {
        pg8::Gemm g{(const bf16*)(ws + WS_XN), (const bf16*)(ws + WS_WIN), NTOK, INW, DM}; pg8::StaticOrder S; S.init(NTOK, INW, G, bx);
        pg8::EpiProj E{PROJ, INW, args.in[4], COL_G / 256};
        pg8::gemm_phase<pg8::EpiProj, pg8::StaticOrder, true, true>(lds, g, S, E);
    }
    SEAM(1);
    if (IN(2)) { p2_qk(args, gw, NGW, lane); p2_conv(args, lds, vcu, G, tid); p2_filter(args, lds, vcu, G, tid); }
    SEAM(2);
    if (IN(3)) {
        for (int u = bx; u < BATCH * 8 * 32; u += G) {
            const int b = u >> 8, x = u & 255, kvh = (x & 7) >> 2, within = (x & 3) + 4 * (x >> 3), hq = kvh * 4 + (within >> 5), qb = within & 31;
            const bf16* Qb = PROJ + (size_t)(b * SEQ + qb * 256) * INW + COL_Q + hq * 128;
            const bf16* Kh = PROJ + (size_t)(b * SEQ) * INW + COL_K + kvh * 128;
            const bf16* Vh = PROJ + (size_t)(b * SEQ) * INW + COL_V + kvh * 128;
            bf16* Ob = (bf16*)(ws + WS_O) + (size_t)(b * SEQ + qb * 256) * 1024 + hq * 128;
            attn::attn_dense_body(Qb, Kh, Vh, Ob, SEQ, (char*)lds_raw);
        }
        p4_conv_direct(args, lds, vcu, G, tid);
    }
    SEAM(3);
    if (IN(4)) {
        p5_ah(args, lds, vcu, G, tid);
        pg8::Gemm g{(const bf16*)(ws + WS_O), (const bf16*)(ws + WS_WAO), NTOK, DM, 1024}; pg8::StaticOrder S; S.init(NTOK, DM, G, bx);
        pg8::EpiGate1 E{PROJ + COL_G, INW, (bf16*)(ws + WS_XN), DM};
        pg8::gemm_phase<pg8::EpiGate1, pg8::StaticOrder, true, true>(lds, g, S, E);
    }
    SEAM(4);
    if (IN(5)) {
        pg8::Gemm g{(const bf16*)(ws + WS_AH), (const bf16*)(ws + WS_WHY), NTOK, DM, 1024}; pg8::StaticOrder S; S.init(NTOK, DM, G, bx);
        pg8::EpiGate2 E{PROJ + COL_G + DM, INW, (bf16*)(ws + WS_XN), DM};
        pg8::gemm_phase<pg8::EpiGate2, pg8::StaticOrder, true, true>(lds, g, S, E);
    }
    SEAM(5);
    if (IN(6)) {
        pg8::Gemm g{(const bf16*)(ws + WS_XN), (const bf16*)(ws + WS_WOUT), NTOK, DM, DM}; pg8::StaticOrder S; S.init(NTOK, DM, G, bx);
        pg8::EpiPre1 E{args.in[0], (const float*)(ws + WS_STATS), args.in[1], args.in[2], (float*)(ws + WS_PRE1), DM, ALPHA};
        pg8::gemm_phase<pg8::EpiPre1, pg8::StaticOrder, true, true>(lds, g, S, E);
    }
    SEAM(6);
    if (IN(7)) { p8_ln_route(args, lds, vcu, G, tid); }
    SEAM(7);
    if (IN(8)) { p9_gather(args, lds, gw, NGW, tid); }
    SEAM(8);
    if (IN(9)) {
        const int total = expert_tables(args, lds, tid);
        pg8::Gemm g{(const bf16*)(ws + WS_XS), (const bf16*)(ws + WS_WGU), total, NEXP * 2048, DM};
        pg8::ExpertOrder S{(const LAS int*)(lds + L_RBX), total >> 8, G, bx};
        pg8::EpiSwiglu E{(bf16*)(ws + WS_HB), DEXP};
        pg8::gemm_phase<pg8::EpiSwiglu, pg8::ExpertOrder, true, true>(lds, g, S, E);
    }
    SEAM(9);
    if (IN(10)) {
        const int total = expert_tables(args, lds, tid);
        pg8::Gemm g{(const bf16*)(ws + WS_HB), (const bf16*)(ws + WS_WD), total, NEXP * 2048, DEXP};
        pg8::ExpertOrder S{(const LAS int*)(lds + L_RBX), total >> 8, G, bx};
        pg8::EpiDown E{(const int*)(ws + WS_META), (bf16*)(ws + WS_Y), DM, NTOK};
        pg8::gemm_phase<pg8::EpiDown, pg8::ExpertOrder, true, true>(lds, g, S, E);
    }
    SEAM(10);
    if (IN(11)) { p12_final(args, gw, NGW, lane); }
#undef IN
#undef SEAM
}

extern "C" void kernel_launch(void* const* d_in, const int* in_sizes, int n_in, void* d_out, int out_size, void* d_ws, size_t ws_size, hipStream_t stream) {
    static int grid = 0;
    if (grid == 0) {
        if (n_in != 31 || out_size != NTOK * DM || ws_size < WS_END) { fprintf(stderr, "kernel_launch: unexpected shapes: n_in %d out %d ws %zu (need >= %zu)\n", n_in, out_size, ws_size, (size_t)WS_END); grid = -1; return; }
        int dev = 0, cus = 0, per_cu = 0;
        if (hipGetDevice(&dev) != hipSuccess || hipDeviceGetAttribute(&cus, hipDeviceAttributeMultiprocessorCount, dev) != hipSuccess) { grid = -1; return; }
        if (hipFuncSetAttribute((const void*)fwd, hipFuncAttributeMaxDynamicSharedMemorySize, LDS_BYTES) != hipSuccess) { fprintf(stderr, "kernel_launch: hipFuncSetAttribute failed\n"); grid = -1; return; }
        if (hipOccupancyMaxActiveBlocksPerMultiprocessor(&per_cu, (const void*)fwd, NWAVES * 64, LDS_BYTES) != hipSuccess || per_cu < 1) fprintf(stderr, "kernel_launch: occupancy query reports %d\n", per_cu);
        (void)hipGetLastError();
        grid = cus;
    }
    if (grid < 0) return;
    if (hipMemsetAsync((char*)d_ws + WS_CTL, 0, CTL_ZERO_BYTES, stream) != hipSuccess) return;
    Args a{};
    for (int i = 0; i < 31; ++i) a.in[i] = (const float*)d_in[i];
    a.out = (float*)d_out; a.ws = (unsigned char*)d_ws;
#if MK_ONE_LAUNCH
    a.ph_lo = 0; a.ph_hi = N_PHASES;
    hipLaunchKernelGGL(fwd, dim3(grid), dim3(NWAVES * 64), LDS_BYTES, stream, a);
#else
    for (int p = 0; p < N_PHASES; ++p) { a.ph_lo = p; a.ph_hi = p + 1; hipLaunchKernelGGL(fwd, dim3(grid), dim3(NWAVES * 64), LDS_BYTES, stream, a); }
#endif
    const hipError_t le = hipPeekAtLastError();
    if (le != hipSuccess) fprintf(stderr, "kernel_launch: launch failed: %s\n", hipGetErrorName(le));
}
```

```cpp
#include <hip/hip_runtime.h>
#include <hip/hip_bf16.h>
#include <cstdio>
#include <cstdint>
#include <cmath>
namespace pg8 {
#define PG8_LAS __attribute__((address_space(3)))
typedef unsigned short bf16_t;
typedef short bf16x8 __attribute__((ext_vector_type(8)));
typedef float f32x4 __attribute__((ext_vector_type(4)));
typedef unsigned u32x4 __attribute__((ext_vector_type(4)));
constexpr int BM = 256, BK = 64, HALF = 128, HTB = HALF * BK * 2  , STAGE_BYTES = 8 * HTB, NXCD = 8, WGM = 8;

__host__ __device__ __forceinline__ int lds_byte(int r, int c) { const int st = (r >> 4) * 2 + (c >> 5), rr = r & 15, cc = c & 31, ob = rr * 64 + cc * 2; return st * 1024 + (ob ^ (((ob >> 9) & 1) << 5)); }
__host__ __device__ __forceinline__ void stage_rc(int b, int& R, int& C) { const int st = b / 1024, sb = b % 1024, swz = sb ^ (((sb >> 9) & 1) << 5); R = (st >> 1) * 16 + swz / 64; C = (st & 1) * 32 + (swz % 64) / 2; }
__host__ __device__ __forceinline__ int perm32(int rho) { const int n = rho >> 4, i = rho & 15; return 8 * (i >> 2) + 4 * n + (i & 3); }

struct Unit { int pm, pn; };
struct Gemm { const bf16_t* A; const bf16_t* Bt; int M, N, K;
              const int* etok; const PG8_LAS int* gcnt; const PG8_LAS int* goff; int elist; };

struct StaticOrder {
    int nM, nN, nwg, G, c;
    __host__ __device__ void init(int M, int N, int G_, int c_) { nM = M / BM; nN = N / BM; nwg = nM * nN; G = G_; c = c_; }
    __host__ __device__ bool next(int i, Unit& u) const {
        const long L = (long)i * G + c; if (L >= nwg) return false;
        int wgid = (int)L; { const int q = nwg / NXCD, r = nwg % NXCD, xcd = wgid % NXCD, off = wgid / NXCD; wgid = (xcd < r ? xcd * (q + 1) : r * (q + 1) + (xcd - r) * q) + off; }
        const int nig = WGM * nN, gid = wgid / nig, fm = gid * WGM, gsz = (nM - fm) < WGM ? (nM - fm) : WGM;
        u.pm = fm + ((wgid % nig) % gsz); u.pn = (wgid % nig) / gsz; return true;
    }
    __device__ __forceinline__ void a_ready(const Unit&) const {}
    __device__ __forceinline__ void done(const Unit&) const {}
};

__device__ __forceinline__ unsigned cvt_pk_bf16(float lo, float hi) { unsigned r; asm volatile("v_cvt_pk_bf16_f32 %0, %1, %2" : "=v"(r) : "v"(lo), "v"(hi)); return r; }
__device__ __forceinline__ float bflo(unsigned w) { return __uint_as_float(w << 16); }
__device__ __forceinline__ float bfhi(unsigned w) { return __uint_as_float(w & 0xffff0000u); }
__device__ __forceinline__ float sigm(float x) { return 1.f / (1.f + __expf(-x)); }
__device__ __forceinline__ u32x4 pack8(const f32x4 v0, const f32x4 v1) { u32x4 w; w.x = cvt_pk_bf16(v0[0], v0[1]); w.y = cvt_pk_bf16(v0[2], v0[3]); w.z = cvt_pk_bf16(v1[0], v1[1]); w.w = cvt_pk_bf16(v1[2], v1[3]); return w; }
__device__ __forceinline__ void unpack8(const u32x4 w, f32x4& v0, f32x4& v1) { v0 = (f32x4){bflo(w.x), bfhi(w.x), bflo(w.y), bfhi(w.y)}; v1 = (f32x4){bflo(w.z), bfhi(w.z), bflo(w.w), bfhi(w.w)}; }

struct EpiProj {
    static constexpr bool PERM = true, AFTER_DRAIN = false;
    bf16_t* O; int ldc; const float* bgate; int gate_pn0;
    __device__ __forceinline__ void operator()(const f32x4 (&acc)[2][2][4][2], const Unit& u, int wr, int wc, int fr, int fq) const {
        const int row0 = u.pm * BM + wr * 64 + fr, col0 = u.pn * BM + wc * 32 + 8 * fq;
        const bool gate = u.pn >= gate_pn0;
        f32x4 bv[2][2];
#pragma unroll
        for (int bj = 0; bj < 2; ++bj)
#pragma unroll
            for (int n = 0; n < 2; ++n) bv[bj][n] = gate ? *(const f32x4*)(bgate + (col0 - gate_pn0 * BM) + bj * HALF + 4 * n) : (f32x4){0.f, 0.f, 0.f, 0.f};
#pragma unroll
        for (int ai = 0; ai < 2; ++ai)
#pragma unroll
            for (int m = 0; m < 4; ++m) { bf16_t* rowp = O + (size_t)(row0 + ai * HALF + m * 16) * ldc + col0;
#pragma unroll
                for (int bj = 0; bj < 2; ++bj) { f32x4 v0 = acc[ai][bj][m][0] + bv[bj][0], v1 = acc[ai][bj][m][1] + bv[bj][1];
                    if (gate) {
#pragma unroll
                        for (int e = 0; e < 4; ++e) { v0[e] = sigm(v0[e]); v1[e] = sigm(v1[e]); } }
                    *(u32x4*)(rowp + bj * HALF) = pack8(v0, v1); } }
    }
};
struct EpiGate8 {
    static constexpr bool PERM = true, AFTER_DRAIN = false;
    bf16_t* O; int ldc; const float* bgate; int gate_col0;
    __device__ __forceinline__ void operator()(const f32x4 (&acc)[2][2][4][2], const Unit& u, int wr, int wc, int fr, int fq) const {
        const bool gate = u.pn >= 6;
        const int row0 = u.pm * BM + wr * 64 + fr, cl = wc * 32 + 8 * fq, col0 = (gate ? gate_col0 + (u.pn - 6) * BM : u.pn * BM) + cl, bcol = (gate ? (u.pn - 6) * BM : 0) + cl;
        f32x4 bv[2][2];
#pragma unroll
        for (int bj = 0; bj < 2; ++bj)
#pragma unroll
            for (int n = 0; n < 2; ++n) bv[bj][n] = gate ? *(const f32x4*)(bgate + bcol + bj * HALF + 4 * n) : (f32x4){0.f, 0.f, 0.f, 0.f};
#pragma unroll
        for (int ai = 0; ai < 2; ++ai)
#pragma unroll
            for (int m = 0; m < 4; ++m) { bf16_t* rowp = O + (size_t)(row0 + ai * HALF + m * 16) * ldc + col0;
#pragma unroll
                for (int bj = 0; bj < 2; ++bj) { f32x4 v0 = acc[ai][bj][m][0] * (1.f / 256.f) + bv[bj][0], v1 = acc[ai][bj][m][1] * (1.f / 256.f) + bv[bj][1];
                    if (gate) {
#pragma unroll
                        for (int e = 0; e < 4; ++e) { v0[e] = sigm(v0[e]); v1[e] = sigm(v1[e]); } }
                    *(u32x4*)(rowp + bj * HALF) = pack8(v0, v1); } }
    }
};
struct GateOrder {
    StaticOrder base; int G, c, split;
    __device__ __forceinline__ bool next(int i, Unit& u) const {
        int L;
        if (split == 0) { L = i * G + c; if (L >= base.nwg) return false; }
        else if (c < split) { if (i >= 3) return false; L = i * split + c; }
        else { if (i >= 5) return false; L = 3 * split + i * (G - split) + (c - split); }
        StaticOrder t = base; t.G = 1; t.c = L; return t.next(0, u);
    }
    __device__ __forceinline__ void a_ready(const Unit&) const {}
    __device__ __forceinline__ void done(const Unit&) const {}
};
struct EpiMerge {
    static constexpr bool PERM = true, AFTER_DRAIN = false;
    const bf16_t* Ga; const bf16_t* Gh; int ldg; bf16_t* O; int ldc; float mscale;
    __device__ __forceinline__ void mid(f32x4 (&acc)[2][2][4][2], const Unit& u, int wr, int wc, int fr, int fq) const {
        asm volatile("" : "+v"(fr), "+v"(fq));
        const int row0 = u.pm * BM + wr * 64 + fr, col0 = u.pn * BM + wc * 32 + 8 * fq;
#pragma unroll
        for (int ai = 0; ai < 2; ++ai)
#pragma unroll
            for (int m = 0; m < 4; ++m) { const size_t r = (size_t)(row0 + ai * HALF + m * 16);
#pragma unroll
                for (int bj = 0; bj < 2; ++bj) { const u32x4 aw = *(const u32x4*)(Ga + r * ldg + col0 + bj * HALF), hw = *(const u32x4*)(Gh + r * ldg + col0 + bj * HALF);
                    f32x4 a0, a1, h0, h1; unpack8(aw, a0, a1); unpack8(hw, h0, h1);
#pragma unroll
                    for (int e = 0; e < 4; ++e) { acc[ai][bj][m][0][e] *= a0[e] * mscale * __builtin_amdgcn_rcpf(fmaxf(h0[e], 1e-30f)); acc[ai][bj][m][1][e] *= a1[e] * mscale * __builtin_amdgcn_rcpf(fmaxf(h1[e], 1e-30f)); }
                    asm volatile("" : "+v"(acc[ai][bj][m][0]), "+v"(acc[ai][bj][m][1]) :: "memory"); } }
    }
    __device__ __forceinline__ void operator()(const f32x4 (&acc)[2][2][4][2], const Unit& u, int wr, int wc, int fr, int fq) const {
        const int row0 = u.pm * BM + wr * 64 + fr, col0 = u.pn * BM + wc * 32 + 8 * fq;
#pragma unroll
        for (int ai = 0; ai < 2; ++ai)
#pragma unroll
            for (int m = 0; m < 4; ++m) { const size_t r = (size_t)(row0 + ai * HALF + m * 16);
#pragma unroll
                for (int bj = 0; bj < 2; ++bj) { const u32x4 hw = *(const u32x4*)(Gh + r * ldg + col0 + bj * HALF); f32x4 h0, h1; unpack8(hw, h0, h1);
                    *(u32x4*)(O + r * ldc + col0 + bj * HALF) = pack8(acc[ai][bj][m][0] * h0, acc[ai][bj][m][1] * h1); } }
    }
};
struct EpiPre1 {
    static constexpr bool PERM = true, AFTER_DRAIN = false;
    const bf16_t* HA; bf16_t* O; int ldc;
    __device__ __forceinline__ void operator()(const f32x4 (&acc)[2][2][4][2], const Unit& u, int wr, int wc, int fr, int fq) const {
        const int row0 = u.pm * BM + wr * 64 + fr, col0 = u.pn * BM + wc * 32 + 8 * fq;
#pragma unroll
        for (int ai = 0; ai < 2; ++ai)
#pragma unroll
            for (int m = 0; m < 4; ++m) { const size_t r = (size_t)(row0 + ai * HALF + m * 16);
#pragma unroll
                for (int bj = 0; bj < 2; ++bj) { const u32x4 hw = *(const u32x4*)(HA + r * ldc + col0 + bj * HALF); f32x4 h0, h1; unpack8(hw, h0, h1);
                    *(u32x4*)(O + r * ldc + col0 + bj * HALF) = pack8(acc[ai][bj][m][0] + h0, acc[ai][bj][m][1] + h1); } }
    }
};
__device__ __forceinline__ unsigned pk4f8(float a, float b, float c, float d) { int w = 0; w = __builtin_amdgcn_cvt_pk_fp8_f32(a, b, w, false); w = __builtin_amdgcn_cvt_pk_fp8_f32(c, d, w, true); return (unsigned)w; }
struct EpiSwiglu {
    static constexpr bool PERM = true, AFTER_DRAIN = false;
    unsigned char* O; int ldc;
    __device__ __forceinline__ void operator()(const f32x4 (&acc)[2][2][4][2], const Unit& u, int wr, int wc, int fr, int fq) const {
        const int row0 = u.pm * BM + wr * 64 + fr, col0 = (u.pn & 7) * HALF + wc * 32 + 8 * fq; constexpr float S = 1.f / 256.f;
        typedef unsigned u32x2_ __attribute__((ext_vector_type(2)));
#pragma unroll
        for (int ai = 0; ai < 2; ++ai)
#pragma unroll
            for (int m = 0; m < 4; ++m) { f32x4 h[2];
#pragma unroll
                for (int n = 0; n < 2; ++n)
#pragma unroll
                    for (int e = 0; e < 4; ++e) { const float gg = acc[ai][0][m][n][e] * S; h[n][e] = gg * sigm(gg) * (acc[ai][1][m][n][e] * S); }
                *(u32x2_*)(O + (size_t)(row0 + ai * HALF + m * 16) * ldc + col0) = (u32x2_){pk4f8(h[0][0], h[0][1], h[0][2], h[0][3]), pk4f8(h[1][0], h[1][1], h[1][2], h[1][3])}; }
    }
};
struct EpiDown {
    static constexpr bool PERM = true, AFTER_DRAIN = false;
    const int* etok; const float* ew; const PG8_LAS int* cnt; const PG8_LAS int* off; int elist; bf16_t* Y; int ldc; int ntok;
    __device__ __forceinline__ void operator()(const f32x4 (&acc)[2][2][4][2], const Unit& u, int wr, int wc, int fr, int fq) const {
        const int e = u.pn >> 3, c = cnt[e], pos0 = u.pm * BM - off[e] + wr * 64 + fr, col0 = (u.pn & 7) * BM + wc * 32 + 8 * fq;
#pragma unroll
        for (int ai = 0; ai < 2; ++ai)
#pragma unroll
            for (int m = 0; m < 4; ++m) { const int pos = pos0 + ai * HALF + m * 16;
                if (pos < c) { const int ts = etok[e * elist + pos]; const float w = ew[e * elist + pos] * (1.f / 256.f);
                    bf16_t* yp = Y + ((size_t)(ts & 1) * ntok + (size_t)(ts >> 1)) * ldc + col0;
#pragma unroll
                    for (int bj = 0; bj < 2; ++bj) *(u32x4*)(yp + bj * HALF) = pack8(acc[ai][bj][m][0] * w, acc[ai][bj][m][1] * w); } }
    }
};
struct ExpertOrder {
    const PG8_LAS int* rbx; int nrb, G, c, rep;
    __device__ __forceinline__ bool next(int i, Unit& u) const {
        int L = i * G + c; if (L >= nrb * 8 * rep) return false;
        if (L >= nrb * 8) L -= nrb * 8;
        const int rb = L >> 3; u.pm = rb; u.pn = rbx[rb] * 8 + (L & 7); return true;
    }
    __device__ __forceinline__ void a_ready(const Unit&) const {}
    __device__ __forceinline__ void done(const Unit&) const {}
};
typedef int pg8_v4i __attribute__((ext_vector_type(4))); typedef int pg8_v8i __attribute__((ext_vector_type(8)));
template <class Epi, class Sched, bool ALIGN_EPI = false, bool SP2 = false, bool GATHER = false, bool MID = false, bool FP8 = false, int NF8 = 0>
__device__ __forceinline__ void gemm_phase(PG8_LAS unsigned char* lds, const Gemm g, const Sched& S, const Epi& E) {
    const int tid = threadIdx.x, wid = __builtin_amdgcn_readfirstlane(tid >> 6), lane = tid & 63, wr = wid >> 2, wc = wid & 3, fr = lane & 15, fq = lane >> 4;
    const int K = g.K, nt = K / BK;
    unsigned voffA[2], voffB[2]; int RA[2], CA[2];
#pragma unroll
    for (int i = 0; i < 2; ++i) { int R, C; stage_rc(tid * 16 + i * 8192, R, C); const int Rb = Epi::PERM ? ((R & ~31) + perm32(R & 31)) : R; RA[i] = R; CA[i] = C;
        voffA[i] = (unsigned)(R * K + C) * 2u; voffB[i] = (unsigned)(Rb * BK + C) * 2u; }
    const size_t kstep = (size_t)(BK * 2);
    const size_t hstep = (size_t)HALF * K * 2;
    const size_t tstep = 2 * hstep;
    const size_t kstepB = (size_t)BM * BK * 2, hstepB = (size_t)HALF * BK * 2, tstepB = (size_t)(K / BK) * kstepB;
    const unsigned ldsw = (unsigned)wid * 1024u;
    const int aoff = lds_byte(wr * 64 + fr, fq * 8), boff = lds_byte(wc * 32 + fr, fq * 8);
#define PG8_SA(b, h) (((b) * 2 + (h)) * HTB)
#define PG8_SB(b, h) ((4 + (b) * 2 + (h)) * HTB)
#define PG8_STAGE(bufoff, gbase, voff) do { _Pragma("unroll") for (int _i = 0; _i < 2; ++_i) \
        __builtin_amdgcn_global_load_lds((const unsigned*)((const char*)(gbase) + (voff)[_i]), (PG8_LAS unsigned*)(lds + (bufoff) + ldsw + _i * 8192), 16, 0, 0); } while (0)
#define PG8_GVOFF(u, v) do { const int e_ = (u).pn >> 3, c_ = g.gcnt[e_] - 1, bp_ = (u).pm * BM - g.goff[e_]; \
        _Pragma("unroll") for (int h_ = 0; h_ < 2; ++h_) _Pragma("unroll") for (int i_ = 0; i_ < 2; ++i_) { int p_ = bp_ + h_ * HALF + RA[i_]; p_ = p_ < c_ ? p_ : c_; \
            const int tk_ = g.etok[e_ * g.elist + p_] >> 1; (v)[h_][i_] = (unsigned)(tk_ * K + CA[i_]) * 2u; } } while (0)
#define PG8_STAGE_A(bufoff, base, h, nx) do { if constexpr (GATHER) { unsigned vv_[2]; vv_[0] = (nx) ? vAn[h][0] : vAc[h][0]; vv_[1] = (nx) ? vAn[h][1] : vAc[h][1]; PG8_STAGE(bufoff, base, vv_); } \
        else { PG8_STAGE(bufoff, (base) + (h) * hstep, voffA); } } while (0)
#define PG8_LDA(dst, b, h) do { _Pragma("unroll") for (int m = 0; m < 4; ++m) { if (f8_) { const pg8_v4i lo_ = *(const PG8_LAS pg8_v4i*)(lds + PG8_SA(b, h) + aoff + m * 2048), hi_ = *(const PG8_LAS pg8_v4i*)(lds + PG8_SA(b, h) + aoff + m * 2048 + 1024); \
        dst##_8[m] = __builtin_shufflevector(lo_, hi_, 0, 1, 2, 3, 4, 5, 6, 7); } else { _Pragma("unroll") for (int k = 0; k < 2; ++k) dst[m][k] = *(const PG8_LAS bf16x8*)(lds + PG8_SA(b, h) + aoff + m * 2048 + k * 1024); } } } while (0)
#define PG8_LDB(dst, b, h) do { _Pragma("unroll") for (int n = 0; n < 2; ++n) { if (f8_) { const pg8_v4i lo_ = *(const PG8_LAS pg8_v4i*)(lds + PG8_SB(b, h) + boff + n * 2048), hi_ = *(const PG8_LAS pg8_v4i*)(lds + PG8_SB(b, h) + boff + n * 2048 + 1024); \
        dst##_8[n] = __builtin_shufflevector(lo_, hi_, 0, 1, 2, 3, 4, 5, 6, 7); } else { _Pragma("unroll") for (int k = 0; k < 2; ++k) dst[n][k] = *(const PG8_LAS bf16x8*)(lds + PG8_SB(b, h) + boff + n * 2048 + k * 1024); } } } while (0)
#define PG8_MMA(ai, bj, At, Bt) do { __builtin_amdgcn_s_setprio(1); _Pragma("unroll") for (int m = 0; m < 4; ++m) _Pragma("unroll") for (int n = 0; n < 2; ++n) { \
        if (f8_) { asm volatile("v_mfma_f32_16x16x128_f8f6f4 %0, %1, %2, %0" : "+v"(acc[ai][bj][m][n]) : "v"(Bt##_8[n]), "v"(At##_8[m])); } \
        else { _Pragma("unroll") for (int k = 0; k < 2; ++k) acc[ai][bj][m][n] = __builtin_amdgcn_mfma_f32_16x16x32_bf16(Bt[n][k], At[m][k], acc[ai][bj][m][n], 0, 0, 0); } } \
        __builtin_amdgcn_s_setprio(0); } while (0)
#define PG8_WAIT_V(n) asm volatile("s_waitcnt vmcnt(" #n ")" ::: "memory")
#define PG8_WAIT_L(n) asm volatile("s_waitcnt lgkmcnt(" #n ")" ::: "memory")
#define PG8_BAR __builtin_amdgcn_s_barrier()
#define PG8_SCHED __builtin_amdgcn_sched_barrier(0)
    Unit cur, nxt; int ui = 0;
    if (!S.next(0, cur)) return;
    f32x4 acc[2][2][4][2];
#pragma unroll
    for (int a = 0; a < 2; ++a)
#pragma unroll
        for (int b = 0; b < 2; ++b)
#pragma unroll
            for (int m = 0; m < 4; ++m)
#pragma unroll
                for (int n = 0; n < 2; ++n) acc[a][b][m][n] = (f32x4){0.f, 0.f, 0.f, 0.f};
    bf16x8 At[4][2], B0[2][2], B1[2][2]; pg8_v8i At_8[4], B0_8[2], B1_8[2]; const int f8scale = 0x7F7F7F7F;
    unsigned vAc[2][2] = {{0u, 0u}, {0u, 0u}}, vAn[2][2] = {{0u, 0u}, {0u, 0u}};
    if constexpr (GATHER) PG8_GVOFF(cur, vAc);
    const char* cA = (const char*)g.A + (GATHER ? (size_t)0 : (size_t)cur.pm * tstep); const char* cB = (const char*)g.Bt + (size_t)cur.pn * tstepB;
    S.a_ready(cur);
    if constexpr (SP2) {
        PG8_STAGE(PG8_SB(0, 0), cB, voffB); PG8_STAGE(PG8_SB(0, 1), cB + hstepB, voffB); PG8_STAGE_A(PG8_SA(0, 0), cA, 0, false); PG8_STAGE_A(PG8_SA(0, 1), cA, 1, false);
        if (wr == 1) PG8_BAR;
        PG8_WAIT_V(2); PG8_BAR;
        PG8_STAGE(PG8_SB(1, 0), cB + kstepB, voffB); PG8_STAGE_A(PG8_SA(1, 0), cA + kstep, 0, false); PG8_STAGE(PG8_SB(1, 1), cB + hstepB + kstepB, voffB);
        PG8_WAIT_V(6); PG8_BAR;
    } else {
        PG8_STAGE(PG8_SB(0, 0), cB, voffB); PG8_STAGE_A(PG8_SA(0, 0), cA, 0, false); PG8_STAGE(PG8_SB(0, 1), cB + hstepB, voffB); PG8_STAGE_A(PG8_SA(0, 1), cA, 1, false);
        if (wr == 1) PG8_BAR;
        PG8_WAIT_V(4); PG8_BAR;
        PG8_STAGE(PG8_SB(1, 0), cB + kstepB, voffB); PG8_STAGE_A(PG8_SA(1, 0), cA + kstep, 0, false); PG8_STAGE(PG8_SB(1, 1), cB + hstepB + kstepB, voffB);
        PG8_WAIT_V(6); PG8_BAR;
    }
    for (;;) {
        const bool has_next = S.next(ui + 1, nxt);
        if constexpr (GATHER) { if (has_next) PG8_GVOFF(nxt, vAn); else { vAn[0][0] = vAc[0][0]; vAn[0][1] = vAc[0][1]; vAn[1][0] = vAc[1][0]; vAn[1][1] = vAc[1][1]; } }
        const char* nA = (has_next && !GATHER) ? (const char*)g.A + (size_t)nxt.pm * tstep : cA; const char* nB = has_next ? (const char*)g.Bt + (size_t)nxt.pn * tstepB : cB;
        if constexpr (NF8 > 0) {
#pragma unroll 1
        for (int t = 0; t < NF8; t += 2) { constexpr bool f8_ = true;
            const bool last = (t == nt - 2);
            if constexpr (MID) { if (t == (NF8 > 0 ? NF8 : nt / 2)) { if constexpr (NF8 > 0) asm volatile("s_nop 15\n\ts_nop 15" ::: "memory"); E.mid(acc, cur, wr, wc, fr, fq); } }
            const char* a1 = cA + (size_t)(t + 1) * kstep;
            const char* a2 = last ? nA : cA + (size_t)(t + 2) * kstep; const char* b2 = last ? nB : cB + (size_t)(t + 2) * kstepB;
            const char* a3 = a2 + kstep; const char* b3 = b2 + kstepB;
            if (last && has_next) S.a_ready(nxt);
            if constexpr (SP2) {
            PG8_LDB(B0, 0, 0); PG8_LDB(B1, 0, 1); PG8_SCHED; PG8_LDA(At, 0, 0); PG8_STAGE_A(PG8_SA(1, 1), a1, 1, false);
            PG8_WAIT_V(8); PG8_WAIT_L(0); PG8_BAR; PG8_MMA(0, 0, At, B0); PG8_MMA(0, 1, At, B1); PG8_BAR; PG8_SCHED;
            PG8_LDA(At, 0, 1); PG8_STAGE(PG8_SB(0, 0), b2, voffB); PG8_STAGE(PG8_SB(0, 1), b2 + hstepB, voffB); PG8_STAGE_A(PG8_SA(0, 0), a2, 0, last);
            PG8_WAIT_V(8); PG8_WAIT_L(0); PG8_BAR; PG8_MMA(1, 0, At, B0); PG8_MMA(1, 1, At, B1); PG8_BAR; PG8_SCHED;
            PG8_LDB(B0, 1, 0); PG8_LDB(B1, 1, 1); PG8_SCHED; PG8_LDA(At, 1, 0); PG8_STAGE_A(PG8_SA(0, 1), a2, 1, last);
            PG8_WAIT_V(8); PG8_WAIT_L(0); PG8_BAR; PG8_MMA(0, 0, At, B0); PG8_MMA(0, 1, At, B1); PG8_BAR; PG8_SCHED;
            PG8_LDA(At, 1, 1); PG8_STAGE(PG8_SB(1, 0), b3, voffB); PG8_STAGE(PG8_SB(1, 1), b3 + hstepB, voffB); PG8_STAGE_A(PG8_SA(1, 0), a3, 0, last);
            PG8_WAIT_V(8); PG8_WAIT_L(0); PG8_BAR; PG8_MMA(1, 0, At, B0); PG8_MMA(1, 1, At, B1); PG8_BAR; PG8_SCHED;
            } else {
            PG8_LDB(B0, 0, 0); PG8_SCHED; PG8_LDA(At, 0, 0); PG8_STAGE_A(PG8_SA(1, 1), a1, 1, false);
            PG8_WAIT_L(8); PG8_BAR; PG8_WAIT_L(0); PG8_MMA(0, 0, At, B0); PG8_BAR; PG8_SCHED;
            PG8_LDB(B1, 0, 1); PG8_STAGE(PG8_SB(0, 0), b2, voffB);
            PG8_BAR; PG8_WAIT_L(0); PG8_MMA(0, 1, At, B1); PG8_BAR;
            PG8_LDA(At, 0, 1); PG8_STAGE_A(PG8_SA(0, 0), a2, 0, last);
            PG8_BAR; PG8_WAIT_L(0); PG8_MMA(1, 0, At, B0); PG8_BAR; PG8_SCHED;
            PG8_STAGE(PG8_SB(0, 1), b2 + hstepB, voffB);
            PG8_WAIT_V(6); PG8_BAR; PG8_MMA(1, 1, At, B1); PG8_BAR;
            PG8_LDB(B0, 1, 0); PG8_SCHED; PG8_LDA(At, 1, 0); PG8_STAGE_A(PG8_SA(0, 1), a2, 1, last);
            PG8_WAIT_L(8); PG8_BAR; PG8_WAIT_L(0); PG8_MMA(0, 0, At, B0); PG8_BAR; PG8_SCHED;
            PG8_LDB(B1, 1, 1); PG8_STAGE(PG8_SB(1, 0), b3, voffB);
            PG8_BAR; PG8_WAIT_L(0); PG8_MMA(0, 1, At, B1); PG8_BAR;
            PG8_LDA(At, 1, 1); PG8_STAGE_A(PG8_SA(1, 0), a3, 0, last);
            PG8_BAR; PG8_WAIT_L(0); PG8_MMA(1, 0, At, B0); PG8_BAR; PG8_SCHED;
            PG8_STAGE(PG8_SB(1, 1), b3 + hstepB, voffB);
            PG8_WAIT_V(6); PG8_BAR; PG8_MMA(1, 1, At, B1); PG8_BAR;
            }
        }
#pragma unroll 1
        for (int t = NF8; t < nt; t += 2) { constexpr bool f8_ = false;
            const bool last = (t == nt - 2);
            if constexpr (MID) { if (t == (NF8 > 0 ? NF8 : nt / 2)) { if constexpr (NF8 > 0) asm volatile("s_nop 15\n\ts_nop 15" ::: "memory"); E.mid(acc, cur, wr, wc, fr, fq); } }
            const char* a1 = cA + (size_t)(t + 1) * kstep;
            const char* a2 = last ? nA : cA + (size_t)(t + 2) * kstep; const char* b2 = last ? nB : cB + (size_t)(t + 2) * kstepB;
            const char* a3 = a2 + kstep; const char* b3 = b2 + kstepB;
            if (last && has_next) S.a_ready(nxt);
            if constexpr (SP2) {
            PG8_LDB(B0, 0, 0); PG8_LDB(B1, 0, 1); PG8_SCHED; PG8_LDA(At, 0, 0); PG8_STAGE_A(PG8_SA(1, 1), a1, 1, false);
            PG8_WAIT_V(8); PG8_WAIT_L(0); PG8_BAR; PG8_MMA(0, 0, At, B0); PG8_MMA(0, 1, At, B1); PG8_BAR; PG8_SCHED;
            PG8_LDA(At, 0, 1); PG8_STAGE(PG8_SB(0, 0), b2, voffB); PG8_STAGE(PG8_SB(0, 1), b2 + hstepB, voffB); PG8_STAGE_A(PG8_SA(0, 0), a2, 0, last);
            PG8_WAIT_V(8); PG8_WAIT_L(0); PG8_BAR; PG8_MMA(1, 0, At, B0); PG8_MMA(1, 1, At, B1); PG8_BAR; PG8_SCHED;
            PG8_LDB(B0, 1, 0); PG8_LDB(B1, 1, 1); PG8_SCHED; PG8_LDA(At, 1, 0); PG8_STAGE_A(PG8_SA(0, 1), a2, 1, last);
            PG8_WAIT_V(8); PG8_WAIT_L(0); PG8_BAR; PG8_MMA(0, 0, At, B0); PG8_MMA(0, 1, At, B1); PG8_BAR; PG8_SCHED;
            PG8_LDA(At, 1, 1); PG8_STAGE(PG8_SB(1, 0), b3, voffB); PG8_STAGE(PG8_SB(1, 1), b3 + hstepB, voffB); PG8_STAGE_A(PG8_SA(1, 0), a3, 0, last);
            PG8_WAIT_V(8); PG8_WAIT_L(0); PG8_BAR; PG8_MMA(1, 0, At, B0); PG8_MMA(1, 1, At, B1); PG8_BAR; PG8_SCHED;
            } else {
            PG8_LDB(B0, 0, 0); PG8_SCHED; PG8_LDA(At, 0, 0); PG8_STAGE_A(PG8_SA(1, 1), a1, 1, false);
            PG8_WAIT_L(8); PG8_BAR; PG8_WAIT_L(0); PG8_MMA(0, 0, At, B0); PG8_BAR; PG8_SCHED;
            PG8_LDB(B1, 0, 1); PG8_STAGE(PG8_SB(0, 0), b2, voffB);
            PG8_BAR; PG8_WAIT_L(0); PG8_MMA(0, 1, At, B1); PG8_BAR;
            PG8_LDA(At, 0, 1); PG8_STAGE_A(PG8_SA(0, 0), a2, 0, last);
            PG8_BAR; PG8_WAIT_L(0); PG8_MMA(1, 0, At, B0); PG8_BAR; PG8_SCHED;
            PG8_STAGE(PG8_SB(0, 1), b2 + hstepB, voffB);
            PG8_WAIT_V(6); PG8_BAR; PG8_MMA(1, 1, At, B1); PG8_BAR;
            PG8_LDB(B0, 1, 0); PG8_SCHED; PG8_LDA(At, 1, 0); PG8_STAGE_A(PG8_SA(0, 1), a2, 1, last);
            PG8_WAIT_L(8); PG8_BAR; PG8_WAIT_L(0); PG8_MMA(0, 0, At, B0); PG8_BAR; PG8_SCHED;
            PG8_LDB(B1, 1, 1); PG8_STAGE(PG8_SB(1, 0), b3, voffB);
            PG8_BAR; PG8_WAIT_L(0); PG8_MMA(0, 1, At, B1); PG8_BAR;
            PG8_LDA(At, 1, 1); PG8_STAGE_A(PG8_SA(1, 0), a3, 0, last);
            PG8_BAR; PG8_WAIT_L(0); PG8_MMA(1, 0, At, B0); PG8_BAR; PG8_SCHED;
            PG8_STAGE(PG8_SB(1, 1), b3 + hstepB, voffB);
            PG8_WAIT_V(6); PG8_BAR; PG8_MMA(1, 1, At, B1); PG8_BAR;
            }
        }
        } else {
#pragma unroll 1
        for (int t = 0; t < nt; t += 2) { constexpr bool f8_ = FP8;
            const bool last = (t == nt - 2);
            if constexpr (MID) { if (t == (NF8 > 0 ? NF8 : nt / 2)) { if constexpr (NF8 > 0) asm volatile("s_nop 15\n\ts_nop 15" ::: "memory"); E.mid(acc, cur, wr, wc, fr, fq); } }
            const char* a1 = cA + (size_t)(t + 1) * kstep;
            const char* a2 = last ? nA : cA + (size_t)(t + 2) * kstep; const char* b2 = last ? nB : cB + (size_t)(t + 2) * kstepB;
            const char* a3 = a2 + kstep; const char* b3 = b2 + kstepB;
            if (last && has_next) S.a_ready(nxt);
            if constexpr (SP2) {
            PG8_LDB(B0, 0, 0); PG8_LDB(B1, 0, 1); PG8_SCHED; PG8_LDA(At, 0, 0); PG8_STAGE_A(PG8_SA(1, 1), a1, 1, false);
            PG8_WAIT_V(8); PG8_WAIT_L(0); PG8_BAR; PG8_MMA(0, 0, At, B0); PG8_MMA(0, 1, At, B1); PG8_BAR; PG8_SCHED;
            PG8_LDA(At, 0, 1); PG8_STAGE(PG8_SB(0, 0), b2, voffB); PG8_STAGE(PG8_SB(0, 1), b2 + hstepB, voffB); PG8_STAGE_A(PG8_SA(0, 0), a2, 0, last);
            PG8_WAIT_V(8); PG8_WAIT_L(0); PG8_BAR; PG8_MMA(1, 0, At, B0); PG8_MMA(1, 1, At, B1); PG8_BAR; PG8_SCHED;
            PG8_LDB(B0, 1, 0); PG8_LDB(B1, 1, 1); PG8_SCHED; PG8_LDA(At, 1, 0); PG8_STAGE_A(PG8_SA(0, 1), a2, 1, last);
            PG8_WAIT_V(8); PG8_WAIT_L(0); PG8_BAR; PG8_MMA(0, 0, At, B0); PG8_MMA(0, 1, At, B1); PG8_BAR; PG8_SCHED;
            PG8_LDA(At, 1, 1); PG8_STAGE(PG8_SB(1, 0), b3, voffB); PG8_STAGE(PG8_SB(1, 1), b3 + hstepB, voffB); PG8_STAGE_A(PG8_SA(1, 0), a3, 0, last);
            PG8_WAIT_V(8); PG8_WAIT_L(0); PG8_BAR; PG8_MMA(1, 0, At, B0); PG8_MMA(1, 1, At, B1); PG8_BAR; PG8_SCHED;
            } else {
            PG8_LDB(B0, 0, 0); PG8_SCHED; PG8_LDA(At, 0, 0); PG8_STAGE_A(PG8_SA(1, 1), a1, 1, false);
            PG8_WAIT_L(8); PG8_BAR; PG8_WAIT_L(0); PG8_MMA(0, 0, At, B0); PG8_BAR; PG8_SCHED;
            PG8_LDB(B1, 0, 1); PG8_STAGE(PG8_SB(0, 0), b2, voffB);
            PG8_BAR; PG8_WAIT_L(0); PG8_MMA(0, 1, At, B1); PG8_BAR;
            PG8_LDA(At, 0, 1); PG8_STAGE_A(PG8_SA(0, 0), a2, 0, last);
            PG8_BAR; PG8_WAIT_L(0); PG8_MMA(1, 0, At, B0); PG8_BAR; PG8_SCHED;
            PG8_STAGE(PG8_SB(0, 1), b2 + hstepB, voffB);
            PG8_WAIT_V(6); PG8_BAR; PG8_MMA(1, 1, At, B1); PG8_BAR;
            PG8_LDB(B0, 1, 0); PG8_SCHED; PG8_LDA(At, 1, 0); PG8_STAGE_A(PG8_SA(0, 1), a2, 1, last);
            PG8_WAIT_L(8); PG8_BAR; PG8_WAIT_L(0); PG8_MMA(0, 0, At, B0); PG8_BAR; PG8_SCHED;
            PG8_LDB(B1, 1, 1); PG8_STAGE(PG8_SB(1, 0), b3, voffB);
            PG8_BAR; PG8_WAIT_L(0); PG8_MMA(0, 1, At, B1); PG8_BAR;
            PG8_LDA(At, 1, 1); PG8_STAGE_A(PG8_SA(1, 0), a3, 0, last);
            PG8_BAR; PG8_WAIT_L(0); PG8_MMA(1, 0, At, B0); PG8_BAR; PG8_SCHED;
            PG8_STAGE(PG8_SB(1, 1), b3 + hstepB, voffB);
            PG8_WAIT_V(6); PG8_BAR; PG8_MMA(1, 1, At, B1); PG8_BAR;
            }
        }
        }
        if constexpr (ALIGN_EPI) { if (wr == 0) PG8_BAR; }
        if constexpr (FP8) asm volatile("s_nop 15\n\ts_nop 15" ::: "memory");
        if constexpr (!Epi::AFTER_DRAIN) { E(acc, cur, wr, wc, fr, fq); S.done(cur); }
        if (!has_next) break;
#pragma unroll
        for (int a = 0; a < 2; ++a)
#pragma unroll
            for (int b = 0; b < 2; ++b)
#pragma unroll
                for (int m = 0; m < 4; ++m)
#pragma unroll
                    for (int n = 0; n < 2; ++n) acc[a][b][m][n] = (f32x4){0.f, 0.f, 0.f, 0.f};
        cur = nxt; cA = nA; cB = nB; ++ui;
        if constexpr (GATHER) { vAc[0][0] = vAn[0][0]; vAc[0][1] = vAn[0][1]; vAc[1][0] = vAn[1][0]; vAc[1][1] = vAn[1][1]; }
        if constexpr (ALIGN_EPI) { if (wr == 1) PG8_BAR; }
    }
    PG8_WAIT_V(0);
    if constexpr (!ALIGN_EPI) { if (wr == 0) PG8_BAR; }
    PG8_BAR;
    if constexpr (Epi::AFTER_DRAIN) { E.fused(acc, cur, wr, wc, fr, fq, lds, wid, lane); S.done(cur); }
#undef PG8_SA
#undef PG8_SB
#undef PG8_STAGE
#undef PG8_GVOFF
#undef PG8_STAGE_A
#undef PG8_LDA
#undef PG8_LDB
#undef PG8_MMA
#undef PG8_WAIT_V
#undef PG8_WAIT_L
#undef PG8_BAR
#undef PG8_SCHED
}
}
namespace attn {
using bf16 = unsigned short;
constexpr int   D = 128, NW = 8, QBLK = 32, KVBLK = 64;
constexpr float SCALE = 0.088388347648318440f;
constexpr float THR = 1.2f;
constexpr int SDEPTH = 2;
constexpr int LDQ = 8704, LDK = 128, LDO = 3072;
constexpr size_t SHM_V = KVBLK * D  , SHM_K = KVBLK * D  , SHM_ATTN = 8 * SHM_V + 8 * SHM_K + NW * 64 * 4;
using bf16x8 = __attribute__((ext_vector_type(8))) short;
using s16x4  = __attribute__((ext_vector_type(4))) short;
using f32x16 = __attribute__((ext_vector_type(16))) float;
using f32x8  = __attribute__((ext_vector_type(8))) float;
using u32x4  = __attribute__((ext_vector_type(4))) unsigned;
#define KSWZ(row, colB) ((row) * 256 + ((colB) ^ (((row) & 7) << 4)))
#define SBAR() __builtin_amdgcn_sched_barrier(0)
__device__ __forceinline__ int crow(int r, int hi) { return (r & 3) + 8 * (r >> 2) + 4 * hi; }
__device__ __forceinline__ unsigned cvtpk(float lo, float hi) {
  unsigned r; asm volatile("v_cvt_pk_bf16_f32 %0, %1, %2" : "=v"(r) : "v"(lo), "v"(hi)); return r;
}
struct StageB { using T = bf16x8;
  __device__ static __forceinline__ T ld8(const bf16* p) { return *reinterpret_cast<const bf16x8*>(p); }
  __device__ static __forceinline__ bf16x8 tobf(T x) { return x; } };
__device__ __forceinline__ void partialSM(f32x16& p0, f32x16& p1, float& m_reg, float& mn, float& alpha) {
  constexpr float C = SCALE * 1.4426950408889634f;
  float pmax = p0[0]; for (int r = 1; r < 16; ++r) pmax = fmaxf(pmax, p0[r]); for (int r = 0; r < 16; ++r) pmax = fmaxf(pmax, p1[r]);
  { auto rr = __builtin_amdgcn_permlane32_swap(__float_as_uint(pmax), __float_as_uint(pmax), false, false);
    pmax = fmaxf(__uint_as_float(rr[0]), __uint_as_float(rr[1])); }
  if (__builtin_expect(__all(pmax - m_reg <= THR / SCALE), 1)) { mn = m_reg; alpha = 1.f; }
  else { mn = fmaxf(m_reg, pmax); alpha = __builtin_amdgcn_exp2f((m_reg - mn) * C); m_reg = mn; }
  float mnC = 7.f - mn * C;
  for (int r = 0; r < 16; ++r) p0[r] = fmaf(p0[r], C, mnC); for (int r = 0; r < 16; ++r) p1[r] = fmaf(p1[r], C, mnC);
  for (int r = 0; r < 16; ++r) p0[r] = __builtin_amdgcn_exp2f(p0[r]);
}
constexpr float THR2 = THR * 1.4426950408889634f;
__device__ __forceinline__ float max3f(float a, float b, float c) { float r; asm("v_max3_f32 %0, %1, %2, %3" : "=v"(r) : "v"(a), "v"(b), "v"(c)); return r; }
__device__ __forceinline__ float max2f(float a, float b) { float r; asm("v_max_f32 %0, %1, %2" : "=v"(r) : "v"(a), "v"(b)); return r; }
template <bool FIRST> __device__ __forceinline__ void partialSM2(f32x16& p0, f32x16& p1, f32x16& negm, float& alpha, int hi) {
  float pmax;
  if (FIRST) { float pma = max2f(p0[0], p0[1]), pmb = max2f(p1[0], p1[1]);
    for (int r = 2; r < 16; r += 2) { pma = max3f(pma, p0[r], p0[r + 1]); pmb = max3f(pmb, p1[r], p1[r + 1]); }
    pma = max2f(pma, pmb);
    auto rr = __builtin_amdgcn_permlane32_swap(__float_as_uint(pma), __float_as_uint(pma), false, false);
    pmax = max2f(__uint_as_float(rr[0]), __uint_as_float(rr[1])); }
  else {
    int ia = __float_as_int(p0[0]), ib = __float_as_int(p1[0]);
    for (int r = 1; r < 16; ++r) { ia = ia > __float_as_int(p0[r]) ? ia : __float_as_int(p0[r]); ib = ib > __float_as_int(p1[r]) ? ib : __float_as_int(p1[r]); }
    ia = ia > ib ? ia : ib;
    auto rr = __builtin_amdgcn_permlane32_swap((unsigned)ia, (unsigned)ia, false, false);
    const int i0 = (int)rr[0], i1 = (int)rr[1]; pmax = __int_as_float(i0 > i1 ? i0 : i1); }
  if (!FIRST && __builtin_expect(__all(pmax <= 7.f + THR2), 1)) alpha = 1.f;
  else { float d = pmax - 7.f; if (!FIRST) d = fmaxf(d, 0.f); alpha = FIRST ? 1.f : __builtin_amdgcn_exp2f(-d);
    const float one = hi ? 0.f : 1.f, nd = hi ? 0.f : -d;
    asm volatile("s_nop 3\n\t"
                 "v_mfma_f32_32x32x2_f32 %0, %3, %4, %0\n\t"
                 "v_mfma_f32_32x32x2_f32 %1, %3, %4, %1\n\t"
                 "v_mfma_f32_32x32x2_f32 %2, %3, %4, %2\n\t"
                 "s_nop 15\n\ts_nop 7" : "+v"(p0), "+v"(p1), "+v"(negm) : "v"(one), "v"(nd)); }
#if defined(PROBE_NOEXP)
  for (int r = 0; r < 16; ++r) p0[r] = __builtin_fmaf(__builtin_fabsf(p0[r]), 0.01f, 1.f);
#else
  for (int r = 0; r < 16; ++r) p0[r] = __builtin_amdgcn_exp2f(p0[r]);
#endif
}
__device__ __forceinline__ void finishSM(f32x16& p0, f32x16& p1, float alpha, float& l_reg, bf16x8& pa0, bf16x8& pa1, bf16x8& pa2, bf16x8& pa3) {
  for (int r = 0; r < 16; ++r) p1[r] = __builtin_amdgcn_exp2f(p1[r]);
  float ps = 0; for (int r = 0; r < 16; ++r) ps += p0[r]; for (int r = 0; r < 16; ++r) ps += p1[r];
  { auto rr = __builtin_amdgcn_permlane32_swap(__float_as_uint(ps), __float_as_uint(ps), false, false);
    ps = __uint_as_float(rr[0]) + __uint_as_float(rr[1]); }
  l_reg = l_reg * alpha + ps;
#define PK4(P, BASE, OUT) do { unsigned a0 = cvtpk(P[BASE + 0], P[BASE + 1]), a1 = cvtpk(P[BASE + 2], P[BASE + 3]);   \
    unsigned b0 = cvtpk(P[BASE + 4], P[BASE + 5]), b1 = cvtpk(P[BASE + 6], P[BASE + 7]);                              \
    auto r0 = __builtin_amdgcn_permlane32_swap(a0, b0, false, false); auto r1 = __builtin_amdgcn_permlane32_swap(a1, b1, false, false); \
    u32x4 w = {r0[0], r1[0], r0[1], r1[1]}; OUT = *reinterpret_cast<bf16x8*>(&w); } while (0)
  PK4(p0, 0, pa0); PK4(p0, 8, pa1); PK4(p1, 0, pa2); PK4(p1, 8, pa3);
#undef PK4
}
typedef int v8i_p __attribute__((ext_vector_type(8))); typedef int v4i_a __attribute__((ext_vector_type(4)));
__device__ __forceinline__ int pk4f8_(float a, float b, float c, float d) { int w = 0; w = __builtin_amdgcn_cvt_pk_fp8_f32(a, b, w, false); w = __builtin_amdgcn_cvt_pk_fp8_f32(c, d, w, true); return w; }
__device__ __forceinline__ void finishSM8(f32x16& p0, f32x16& p1, float alpha, float& l_reg, v8i_p& pa) {
  for (int r = 0; r < 16; ++r) p1[r] = __builtin_amdgcn_exp2f(p1[r]);
  float ps = 0; for (int r = 0; r < 16; ++r) ps += p0[r]; for (int r = 0; r < 16; ++r) ps += p1[r];
  { auto rr = __builtin_amdgcn_permlane32_swap(__float_as_uint(ps), __float_as_uint(ps), false, false);
    ps = __uint_as_float(rr[0]) + __uint_as_float(rr[1]); }
  l_reg = l_reg * alpha + ps;
  for (int i = 0; i < 4; ++i) { pa[i] = pk4f8_(p0[4 * i], p0[4 * i + 1], p0[4 * i + 2], p0[4 * i + 3]); pa[4 + i] = pk4f8_(p1[4 * i], p1[4 * i + 1], p1[4 * i + 2], p1[4 * i + 3]); }
}
__device__ __forceinline__ void finishSM8n(f32x16& p0, f32x16& p1, v8i_p& pa) {
#if defined(PROBE_NOEXP)
  for (int r = 0; r < 16; ++r) p1[r] = __builtin_fmaf(__builtin_fabsf(p1[r]), 0.01f, 1.f);
#else
  for (int r = 0; r < 16; ++r) p1[r] = __builtin_amdgcn_exp2f(p1[r]);
#endif
  for (int i = 0; i < 4; ++i) { int w = pa[i]; w = __builtin_amdgcn_cvt_pk_fp8_f32(p0[4 * i], p0[4 * i + 1], w, false); w = __builtin_amdgcn_cvt_pk_fp8_f32(p0[4 * i + 2], p0[4 * i + 3], w, true); pa[i] = w;
    int u = pa[4 + i]; u = __builtin_amdgcn_cvt_pk_fp8_f32(p1[4 * i], p1[4 * i + 1], u, false); u = __builtin_amdgcn_cvt_pk_fp8_f32(p1[4 * i + 2], p1[4 * i + 3], u, true); pa[4 + i] = u; }
}
__host__ __device__ __forceinline__ int vt_pos(int t) { const int c = t & 31; return 32 * ((c >> 2) & 1) + 16 * (t >> 5) + (c & 3) + 4 * (c >> 3); }
__device__ __forceinline__ void pv8(f32x16* o, const char* Vt, const v8i_p& pa, int r32, int hi) {
  const int sa = 0x78787878, sb = 0x7F7F7F7F;
#pragma unroll
  for (int g = 0; g < 2; ++g) { v8i_p b[2];
#pragma unroll
    for (int e = 0; e < 2; ++e) { const int d = 32 * (2 * g + e) + r32, sw = (d >> 2) & 3;
      const v4i_a lo = *reinterpret_cast<const v4i_a*>(Vt + d * 64 + (((2 * hi) ^ sw) << 4)), up = *reinterpret_cast<const v4i_a*>(Vt + d * 64 + (((2 * hi + 1) ^ sw) << 4));
      b[e] = __builtin_shufflevector(lo, up, 0, 1, 2, 3, 4, 5, 6, 7); }
    asm volatile("v_mfma_scale_f32_32x32x64_f8f6f4 %0, %2, %3, %0, %5, %6 op_sel_hi:[0,0,0]\n\t"
                 "v_mfma_scale_f32_32x32x64_f8f6f4 %1, %2, %4, %1, %5, %6 op_sel_hi:[0,0,0]"
                 : "+v"(o[2 * g]), "+v"(o[2 * g + 1]) : "v"(pa), "v"(b[0]), "v"(b[1]), "v"(sa), "v"(sb)); }
}
__device__ __forceinline__ void pv8n(f32x16* o, f32x16& lacc, const char* Vt, const v8i_p& pa, const v4i_a& ones4, int r32, int hi) {
  const int sa = 0x78787878, sb = 0x7F7F7F7F;
#pragma unroll
  for (int g = 0; g < 2; ++g) { v8i_p b[2];
#pragma unroll
    for (int e = 0; e < 2; ++e) { const int d = 32 * (2 * g + e) + r32, sw = (d >> 2) & 3;
      const v4i_a lo = *reinterpret_cast<const v4i_a*>(Vt + d * 64 + (((2 * hi) ^ sw) << 4)), up = *reinterpret_cast<const v4i_a*>(Vt + d * 64 + (((2 * hi + 1) ^ sw) << 4));
      b[e] = __builtin_shufflevector(lo, up, 0, 1, 2, 3, 4, 5, 6, 7); }
    if (g == 0) asm volatile("v_mfma_scale_f32_32x32x64_f8f6f4 %0, %2, %3, %0, %5, %6 op_sel_hi:[0,0,0]\n\t"
                 "v_mfma_scale_f32_32x32x64_f8f6f4 %1, %2, %4, %1, %5, %6 op_sel_hi:[0,0,0]"
                 : "+v"(o[0]), "+v"(o[1]) : "v"(pa), "v"(b[0]), "v"(b[1]), "v"(sa), "v"(sb));
    else        asm volatile("v_mfma_scale_f32_32x32x64_f8f6f4 %0, %3, %4, %0, %7, %8 op_sel_hi:[0,0,0]\n\t"
                 "v_mfma_scale_f32_32x32x64_f8f6f4 %1, %3, %5, %1, %7, %8 op_sel_hi:[0,0,0]\n\t"
                 "v_mfma_scale_f32_32x32x64_f8f6f4 %2, %3, %6, %2, %7, %8 op_sel_hi:[0,0,0] blgp:4"
                 : "+v"(o[2]), "+v"(o[3]), "+v"(lacc) : "v"(pa), "v"(b[0]), "v"(b[1]), "v"(ones4), "v"(sa), "v"(sb)); }
}
__device__ __forceinline__ void qkt(f32x16& p0, f32x16& p1, const bf16* Ks, const bf16x8* qr, int r32, int hi) {
  p0 = f32x16{}; p1 = f32x16{};
  for (int d0 = 0; d0 < 8; ++d0) { int cb = (d0 * 16 + hi * 8) * 2;
    bf16x8 b0 = *reinterpret_cast<const bf16x8*>((const char*)Ks + KSWZ(r32, cb));
    bf16x8 b1 = *reinterpret_cast<const bf16x8*>((const char*)Ks + KSWZ(32 + r32, cb));
    p0 = __builtin_amdgcn_mfma_f32_32x32x16_bf16(b0, qr[d0], p0, 0, 0, 0);
    p1 = __builtin_amdgcn_mfma_f32_32x32x16_bf16(b1, qr[d0], p1, 0, 0, 0); }
}
typedef int v4i_a __attribute__((ext_vector_type(4))); typedef int v8i_a __attribute__((ext_vector_type(8)));
__device__ __forceinline__ void qkt8(f32x16& p0, f32x16& p1, const char* Ks, const v8i_a (&q8)[2], int r32, int hi) {
  p0 = f32x16{}; p1 = f32x16{};
  const int sc = 0x7F7F7F7F;
#pragma unroll
  for (int s = 0; s < 2; ++s) { v8i_a a[2];
#pragma unroll
    for (int kh = 0; kh < 2; ++kh) { const int row = kh * 32 + r32, cb = 64 * s + 32 * hi, sw = (row & 7) << 4;
      const v4i_a lo = *reinterpret_cast<const v4i_a*>(Ks + row * 128 + (cb ^ sw)), up = *reinterpret_cast<const v4i_a*>(Ks + row * 128 + ((cb + 16) ^ sw));
      a[kh] = __builtin_shufflevector(lo, up, 0, 1, 2, 3, 4, 5, 6, 7); }
    if (s == 0) asm volatile("s_nop 3\n\t"
                 "v_mfma_scale_f32_32x32x64_f8f6f4 %0, %2, %4, %0, %5, %5 op_sel_hi:[0,0,0]\n\t"
                 "v_mfma_scale_f32_32x32x64_f8f6f4 %1, %3, %4, %1, %5, %5 op_sel_hi:[0,0,0]"
                 : "+v"(p0), "+v"(p1) : "v"(a[0]), "v"(a[1]), "v"(q8[0]), "v"(sc));
    else        asm volatile("v_mfma_scale_f32_32x32x64_f8f6f4 %0, %2, %4, %0, %5, %5 op_sel_hi:[0,0,0]\n\t"
                 "v_mfma_scale_f32_32x32x64_f8f6f4 %1, %3, %4, %1, %5, %5 op_sel_hi:[0,0,0]\n\t"
                 "s_nop 15\n\ts_nop 7"
                 : "+v"(p0), "+v"(p1) : "v"(a[0]), "v"(a[1]), "v"(q8[1]), "v"(sc)); }
}
__device__ __forceinline__ void qkt8n(f32x16& p0, f32x16& p1, const char* Ks, const v8i_a (&q8)[2], const f32x16& negm, int r32, int hi) {
  const int sk = 0x7F7F7F7F, sq = 0x7C7C7C7C;
#pragma unroll
  for (int s = 0; s < 2; ++s) { v8i_a a[2];
#pragma unroll
    for (int kh = 0; kh < 2; ++kh) { const int row = kh * 32 + r32, cb = 64 * s + 32 * hi, sw = (row & 7) << 4;
      const v4i_a lo = *reinterpret_cast<const v4i_a*>(Ks + row * 128 + (cb ^ sw)), up = *reinterpret_cast<const v4i_a*>(Ks + row * 128 + ((cb + 16) ^ sw));
      a[kh] = __builtin_shufflevector(lo, up, 0, 1, 2, 3, 4, 5, 6, 7); }
    if (s == 0) asm volatile("s_nop 3\n\t"
                 "v_mfma_scale_f32_32x32x64_f8f6f4 %0, %2, %4, %5, %6, %7 op_sel_hi:[0,0,0]\n\t"
                 "v_mfma_scale_f32_32x32x64_f8f6f4 %1, %3, %4, %5, %6, %7 op_sel_hi:[0,0,0]"
                 : "=&v"(p0), "=&v"(p1) : "v"(a[0]), "v"(a[1]), "v"(q8[0]), "v"(negm), "v"(sk), "v"(sq));
    else        asm volatile("v_mfma_scale_f32_32x32x64_f8f6f4 %0, %2, %4, %0, %5, %6 op_sel_hi:[0,0,0]\n\t"
                 "v_mfma_scale_f32_32x32x64_f8f6f4 %1, %3, %4, %1, %5, %6 op_sel_hi:[0,0,0]\n\t"
                 "s_nop 15\n\ts_nop 7"
                 : "+v"(p0), "+v"(p1) : "v"(a[0]), "v"(a[1]), "v"(q8[1]), "v"(sk), "v"(sq)); }
}
__device__ __forceinline__ void ldK8(v8i_a (&ka)[2][2], const char* Ks, int r32, int hi) {
#if defined(PROBE_LDSBCAST)
  r32 = 0; hi = 0;
#endif
#pragma unroll
  for (int s = 0; s < 2; ++s)
#pragma unroll
    for (int kh = 0; kh < 2; ++kh) { const int row = kh * 32 + r32, cb = 64 * s + 32 * hi, sw = ((row >> 1) & 7) << 4;
      const v4i_a lo = *reinterpret_cast<const v4i_a*>(Ks + row * 128 + (cb ^ sw)), up = *reinterpret_cast<const v4i_a*>(Ks + row * 128 + ((cb + 16) ^ sw));
      ka[s][kh] = __builtin_shufflevector(lo, up, 0, 1, 2, 3, 4, 5, 6, 7); }
}
__device__ __forceinline__ void ldV8one(v8i_p& b, const char* Vt, int blk, int r32, int hi) {
  const int d = 32 * blk + r32, sw = (d >> 2) & 3;
  const v4i_a lo = *reinterpret_cast<const v4i_a*>(Vt + d * 64 + (((2 * hi) ^ sw) << 4)), up = *reinterpret_cast<const v4i_a*>(Vt + d * 64 + (((2 * hi + 1) ^ sw) << 4));
  b = __builtin_shufflevector(lo, up, 0, 1, 2, 3, 4, 5, 6, 7);
}
__device__ __forceinline__ void ldV8(v8i_p (&b)[2], const char* Vt, int g, int r32, int hi) {
#if defined(PROBE_LDSBCAST)
  r32 = 0; hi = 0;
#endif
#pragma unroll
  for (int e = 0; e < 2; ++e) { const int d = 32 * (2 * g + e) + r32, sw = (d >> 2) & 3;
    const v4i_a lo = *reinterpret_cast<const v4i_a*>(Vt + d * 64 + (((2 * hi) ^ sw) << 4)), up = *reinterpret_cast<const v4i_a*>(Vt + d * 64 + (((2 * hi + 1) ^ sw) << 4));
    b[e] = __builtin_shufflevector(lo, up, 0, 1, 2, 3, 4, 5, 6, 7); }
}
template <bool TAILNOP> __device__ __forceinline__ void qk_mma(f32x16& p0, f32x16& p1, const v8i_a (&ka)[2][2], const v8i_a (&q8)[2], const f32x16& negm) {
  asm volatile("s_nop 3\n\t"
               "v_mfma_f32_32x32x64_f8f6f4 %0, %2, %4, %5\n\t"
               "v_mfma_f32_32x32x64_f8f6f4 %1, %3, %4, %5"
               : "=&v"(p0), "=&v"(p1) : "v"(ka[0][0]), "v"(ka[0][1]), "v"(q8[0]), "v"(negm));
#if defined(PROBE_DUPMFMA)
  for (int rep = 0; rep < 2; ++rep)
  asm volatile("v_mfma_f32_32x32x64_f8f6f4 %0, %2, %4, %5\n\t"
               "v_mfma_f32_32x32x64_f8f6f4 %1, %3, %4, %5"
               : "=&v"(p0), "=&v"(p1) : "v"(ka[0][0]), "v"(ka[0][1]), "v"(q8[0]), "v"(negm));
#endif
#if defined(PROBE_FEWMFMA)
  if (TAILNOP) asm volatile("s_nop 15\n\ts_nop 7" ::: "memory");
  return;
#endif
  if (TAILNOP) asm volatile("v_mfma_f32_32x32x64_f8f6f4 %0, %2, %4, %0\n\t"
               "v_mfma_f32_32x32x64_f8f6f4 %1, %3, %4, %1\n\t"
               "s_nop 15\n\ts_nop 7"
               : "+v"(p0), "+v"(p1) : "v"(ka[1][0]), "v"(ka[1][1]), "v"(q8[1]));
  else         asm volatile("v_mfma_f32_32x32x64_f8f6f4 %0, %2, %4, %0\n\t"
               "v_mfma_f32_32x32x64_f8f6f4 %1, %3, %4, %1"
               : "+v"(p0), "+v"(p1) : "v"(ka[1][0]), "v"(ka[1][1]), "v"(q8[1]));
}
__device__ __forceinline__ void pv_mma0(f32x16* o, const v8i_p& pa, const v8i_p (&b)[2]) {
  asm volatile("v_mfma_f32_32x32x64_f8f6f4 %0, %2, %3, %0\n\t"
               "v_mfma_f32_32x32x64_f8f6f4 %1, %2, %4, %1"
               : "+v"(o[0]), "+v"(o[1]) : "v"(pa), "v"(b[0]), "v"(b[1]));
}
__device__ __forceinline__ void pv_mma1(f32x16* o, f32x16& lacc, const v8i_p& pa, const v8i_p (&b)[2], const v4i_a& ones4) {
#if defined(PROBE_FEWMFMA)
  asm volatile("v_mfma_f32_32x32x64_f8f6f4 %2, %3, %6, %2 blgp:4"
               : "+v"(o[2]), "+v"(o[3]), "+v"(lacc) : "v"(pa), "v"(b[0]), "v"(b[1]), "v"(ones4));
  return;
#endif
  asm volatile("v_mfma_f32_32x32x64_f8f6f4 %0, %3, %4, %0\n\t"
               "v_mfma_f32_32x32x64_f8f6f4 %1, %3, %5, %1\n\t"
               "v_mfma_f32_32x32x64_f8f6f4 %2, %3, %6, %2 blgp:4"
               : "+v"(o[2]), "+v"(o[3]), "+v"(lacc) : "v"(pa), "v"(b[0]), "v"(b[1]), "v"(ones4));
}
__device__ __forceinline__ int v_st(int k, int c) { const int kk = (k & ~0xC) | ((k & 4) << 1) | ((k & 8) >> 1); return ((kk >> 3) * 4 + (c >> 5)) * 512 + ((kk & 7) * 32 + (c & 31)) * 2; }
__device__ __forceinline__ int v_rd_base(int lane) { return ((lane & 3) << 3) | (((lane >> 2) & 3) << 6) | (((lane >> 4) & 1) << 5) | (((lane >> 5) & 1) << 8); }
constexpr int v_rd_off(int d0, int ks, int half) { return d0 * 512 + ks * 4096 + half * 2048; }
template <int OFF> __device__ __forceinline__ s16x4 tr_read(int vb) {
  s16x4 r; asm volatile("ds_read_b64_tr_b16 %0, %1 offset:%2" : "=&v"(r) : "v"(vb), "i"(OFF) : "memory"); return r;
}
template <int D0> __device__ __forceinline__ void pv_one(f32x16& od, int vb, bf16x8 pa0, bf16x8 pa1, bf16x8 pa2, bf16x8 pa3) {
  const s16x4 l0 = tr_read<v_rd_off(D0, 0, 0)>(vb), h0 = tr_read<v_rd_off(D0, 0, 1)>(vb), l1 = tr_read<v_rd_off(D0, 1, 0)>(vb), h1 = tr_read<v_rd_off(D0, 1, 1)>(vb);
  const s16x4 l2 = tr_read<v_rd_off(D0, 2, 0)>(vb), h2 = tr_read<v_rd_off(D0, 2, 1)>(vb), l3 = tr_read<v_rd_off(D0, 3, 0)>(vb), h3 = tr_read<v_rd_off(D0, 3, 1)>(vb);
  asm volatile("s_waitcnt lgkmcnt(0)" ::: "memory"); SBAR();
#define PK(L, H) (bf16x8){L[0], L[1], L[2], L[3], H[0], H[1], H[2], H[3]}
  od = __builtin_amdgcn_mfma_f32_32x32x16_bf16(pa0, PK(l0, h0), od, 0, 0, 0);
  od = __builtin_amdgcn_mfma_f32_32x32x16_bf16(pa1, PK(l1, h1), od, 0, 0, 0);
  od = __builtin_amdgcn_mfma_f32_32x32x16_bf16(pa2, PK(l2, h2), od, 0, 0, 0);
  od = __builtin_amdgcn_mfma_f32_32x32x16_bf16(pa3, PK(l3, h3), od, 0, 0, 0);
#undef PK
}
__device__ __forceinline__ void pv_d0(f32x16* o, int vb, bf16x8 pa0, bf16x8 pa1, bf16x8 pa2, bf16x8 pa3) {
  pv_one<0>(o[0], vb, pa0, pa1, pa2, pa3); pv_one<1>(o[1], vb, pa0, pa1, pa2, pa3); pv_one<2>(o[2], vb, pa0, pa1, pa2, pa3); pv_one<3>(o[3], vb, pa0, pa1, pa2, pa3);
}

__device__ __forceinline__ void attn_dense_body(const bf16* __restrict__ Qb, const unsigned char* __restrict__ Kh, const unsigned char* __restrict__ Vh,
                                                unsigned char* __restrict__ Ob, int seq, char* lds) {
  using St = StageB; using SQ = StageB;
  int tid_ = threadIdx.x; asm volatile("v_mov_b32 %0, %0" : "+v"(tid_));
  const int tid = tid_, wid = tid >> 6, lane = tid & 63, r32 = lane & 31, hi = lane >> 5;
  bf16* V_lds = (bf16*)lds; bf16* K_lds = (bf16*)(lds + 8 * SHM_V);
  float* ws = (float*)(lds + 8 * SHM_V + 8 * SHM_K) + wid * 64; float* li_l = ws; float* al_l = ws + 32;
  f32x16 o[4] = {}, lacc = {}; v8i_a qr[2]; f32x16 negm; v8i_p pa = {}; v4i_a ones4;
  for (int i = 0; i < 4; ++i) ones4[i] = 0x22222222;
  { float seven; asm volatile("v_mov_b32 %0, 0x40e00000" : "=v"(seven)); for (int r = 0; r < 16; ++r) negm[r] = seven; }
  constexpr float QS = SCALE * 1.4426950408889634f;
#pragma unroll
  for (int s = 0; s < 2; ++s) { const bf16* qp = Qb + (long)(wid * QBLK + r32) * LDQ + 64 * s + 32 * hi; unsigned wq[16];
#pragma unroll
    for (int i = 0; i < 4; ++i) { const u32x4 w = *reinterpret_cast<const u32x4*>(qp + 8 * i); wq[4 * i] = w.x; wq[4 * i + 1] = w.y; wq[4 * i + 2] = w.z; wq[4 * i + 3] = w.w; }
#pragma unroll
    for (int i = 0; i < 8; ++i) { int d = 0; d = __builtin_amdgcn_cvt_pk_fp8_f32(QS * __uint_as_float(wq[2 * i] << 16), QS * __uint_as_float(wq[2 * i] & 0xffff0000u), d, false);
      d = __builtin_amdgcn_cvt_pk_fp8_f32(QS * __uint_as_float(wq[2 * i + 1] << 16), QS * __uint_as_float(wq[2 * i + 1] & 0xffff0000u), d, true); qr[s][i] = d; } }
  const int vst = (tid >> 2) * 64 + ((((tid & 3) ^ ((tid >> 4) & 3))) << 4);
  const int krow = tid >> 3, kch = tid & 7, kst = krow * 128 + ((kch * 16) ^ (((krow >> 1) & 7) << 4));
  const int widu = __builtin_amdgcn_readfirstlane(wid);
  PG8_LAS unsigned char* ldsA = (PG8_LAS unsigned char*)lds;
#define SDMA(b, k0) do { \
    __builtin_amdgcn_global_load_lds((const unsigned*)(Vh + (long)(k0) * 128 + vst), (PG8_LAS unsigned*)(ldsA + (b) * SHM_V + widu * 1024), 16, 0, 0); \
    __builtin_amdgcn_global_load_lds((const unsigned*)(Kh + (long)(k0) * 128 + kst), (PG8_LAS unsigned*)(ldsA + 8 * SHM_V + (b) * SHM_K + widu * 1024), 16, 0, 0); } while (0)
#define SWAIT() asm volatile("s_waitcnt vmcnt(0)" ::: "memory")
#define RESC(a) do { if (__any((a) < 1.f)) { if (hi == 0) al_l[r32] = (a); asm volatile("s_nop 15\n\ts_nop 15\n\ts_waitcnt lgkmcnt(0)" ::: "memory"); \
    for (int r = 0; r < 16; ++r) { const float a_ = al_l[crow(r, hi)]; for (int d = 0; d < 4; ++d) o[d][r] *= a_; lacc[r] *= a_; } } } while (0)
  f32x16 p0, p1; float al; const int NT = seq / KVBLK;
  const bool halfB = widu >= 4;
#define KB(i) ((const char*)K_lds + (i) * SHM_K)
#define VB(i) ((const char*)V_lds + (i) * SHM_V)
#define BAR() __builtin_amdgcn_s_barrier()
  SDMA(0, 0); SDMA(1, KVBLK); SDMA(2, 2 * KVBLK); SDMA(3, 3 * KVBLK); SWAIT(); BAR();
  if (halfB) BAR();
  v8i_a ka[2][2]; v8i_p vb[2], vc[2];
  ldK8(ka, KB(0), r32, hi);
  qk_mma<true>(p0, p1, ka, qr, negm);
  BAR();
  SDMA(4, 4 * KVBLK);
  ldK8(ka, KB(1), r32, hi); ldV8(vb, VB(0), 0, r32, hi); ldV8one(vc[0], VB(0), 2, r32, hi); SBAR();
  partialSM2<true>(p0, p1, negm, al, hi); finishSM8n(p0, p1, pa); SBAR(); BAR();
#pragma unroll 1
  for (int tau = 1; tau < NT; ++tau) {
    { qk_mma<false>(p0, p1, ka, qr, negm); SBAR();
      ldV8one(vc[1], VB((tau - 1) & 7), 3, r32, hi); SBAR();
      pv_mma0(o, pa, vb); pv_mma1(o, lacc, pa, vc, ones4); SBAR(); }
    if (tau + 3 < NT) asm volatile("s_waitcnt vmcnt(2)" ::: "memory"); else asm volatile("s_waitcnt vmcnt(0)" ::: "memory");
    BAR();
    if (tau + 4 < NT) SDMA((tau + 4) & 7, (tau + 4) * KVBLK);
    if (tau + 1 < NT) ldK8(ka, KB((tau + 1) & 7), r32, hi);
    ldV8(vb, VB(tau & 7), 0, r32, hi); ldV8one(vc[0], VB(tau & 7), 2, r32, hi); SBAR();
    partialSM2<false>(p0, p1, negm, al, hi);
    RESC(al);
    finishSM8n(p0, p1, pa); SBAR();
    BAR();
  }
  { ldV8one(vc[1], VB((NT - 1) & 7), 3, r32, hi); pv_mma0(o, pa, vb); pv_mma1(o, lacc, pa, vc, ones4); }
  if (!halfB) BAR();
#undef BAR
#undef KB
#undef VB
  asm volatile("s_nop 15\n\ts_nop 15\n\ts_nop 15\n\ts_nop 15" ::: "memory");
  float rli[16];
#pragma unroll
  for (int r = 0; r < 16; ++r) rli[r] = __builtin_amdgcn_rcpf(lacc[r]);
  unsigned char* Ow = Ob + (long)(wid * QBLK) * LDO;
#pragma unroll
  for (int r = 0; r < 16; ++r) { int orow = crow(r, hi);
    for (int d0 = 0; d0 < 4; ++d0) { const int pk = __builtin_amdgcn_cvt_pk_fp8_f32(o[d0][r] * rli[r], 0.f, 0, false); Ow[(long)orow * LDO + d0 * 32 + r32] = (unsigned char)(pk & 0xff); } }
  __syncthreads();
#undef SDMA
#undef SWAIT
#undef RESC
}

}
#define GAS __attribute__((address_space(1)))
#define LAS __attribute__((address_space(3)))
typedef unsigned short bf16;
typedef unsigned v4u __attribute__((ext_vector_type(4)));
typedef float f32x4 __attribute__((ext_vector_type(4)));
typedef short bf16x8 __attribute__((ext_vector_type(8)));
typedef GAS unsigned gu32;
typedef GAS unsigned long long gu64;
#define RLX_AGENT __ATOMIC_RELAXED, __HIP_MEMORY_SCOPE_AGENT
#define LDS_WAIT() asm volatile("s_waitcnt lgkmcnt(0)" ::: "memory")
#define VM_WAIT() asm volatile("s_waitcnt vmcnt(0)" ::: "memory")
__device__ __forceinline__ unsigned long long rt() { return __builtin_amdgcn_s_memrealtime(); }
__device__ __forceinline__ unsigned f2bf(float f) { unsigned u = __builtin_bit_cast(unsigned, f); return (u + 0x7fffu + ((u >> 16) & 1u)) >> 16; }
__device__ __forceinline__ unsigned pk2(float lo, float hi) { unsigned r; asm volatile("v_cvt_pk_bf16_f32 %0, %1, %2" : "=v"(r) : "v"(lo), "v"(hi)); return r; }

#define XB_TMO      128
#define XB_XCNT(j)  (256  + 64 * (j))
#define XB_XSUB(j)  (1280 + 64 * (j))
#define XB_XGEN(j)  (2304 + 64 * (j))
#define XB_TOP      3328
#define XB_TOPGEN   3392
#define XCD_BAR_WORDS 3456
#define XB_SPIN_CAP (1u << 18)

__device__ __forceinline__ unsigned xb_ld(unsigned* p)              { return __hip_atomic_load(p, __ATOMIC_RELAXED, __HIP_MEMORY_SCOPE_AGENT); }
__device__ __forceinline__ unsigned xb_add(unsigned* p, unsigned v) { return __hip_atomic_fetch_add(p, v, __ATOMIC_RELAXED, __HIP_MEMORY_SCOPE_AGENT); }
__device__ __forceinline__ unsigned xb_xcc_id() { return (unsigned)__builtin_amdgcn_s_getreg((3 << 11) | 20) & 0xFu; }
#define XB_SPIN(cond, bar) do { unsigned _sp = 0; while (cond) { __builtin_amdgcn_s_sleep(1); \
    if ((++_sp & 255u) == 0u) { if (xb_ld(&(bar)[XB_TMO])) break; if (_sp > XB_SPIN_CAP) { atomicAdd(&(bar)[XB_TMO], 1u); break; } } } } while (0)

struct XcdBarrier {
    unsigned* bar; unsigned x;
    volatile LAS unsigned* st;
};

__device__ __forceinline__ XcdBarrier xcd_barrier_post(unsigned* bar, volatile LAS unsigned* st) {
    XcdBarrier b; b.bar = bar; b.x = xb_xcc_id(); b.st = st;
    if (threadIdx.x == 0) (void)xb_add(&bar[XB_XCNT(b.x)], 1u);
    return b;
}
__device__ __forceinline__ void xcd_barrier_complete(unsigned* bar, unsigned x, unsigned& nloc, unsigned& nx) {
    const unsigned G = gridDim.x * gridDim.y * gridDim.z;
    unsigned sum, cnt, mine, sp = 0u;
    for (;;) {
        sum = 0u; cnt = 0u; mine = 0u;
#pragma unroll
        for (unsigned j = 0; j < 16; ++j) { const unsigned c = xb_ld(&bar[XB_XCNT(j)]); sum += c; cnt += (c > 0u) ? 1u : 0u; mine = (j == x) ? c : mine; }
        if (sum == G) break;
        __builtin_amdgcn_s_sleep(1);
        if ((++sp & 255u) == 0u) { if (xb_ld(&bar[XB_TMO])) break; if (sp > XB_SPIN_CAP) { atomicAdd(&bar[XB_TMO], 1u); break; } }
    }
    nloc = mine > 0u ? mine : 1u; nx = cnt > 0u ? cnt : 1u;
}

__device__ __forceinline__ void xcd_barrier(const XcdBarrier& b) {
    asm volatile("s_waitcnt vmcnt(0)" ::: "memory");
    __syncthreads();
    if (threadIdx.x == 0) {
        unsigned* bar = b.bar;
        __builtin_amdgcn_s_waitcnt(0);
        unsigned nloc = b.st[0], nx = b.st[1];
        if (nloc == 0u) { xcd_barrier_complete(bar, b.x, nloc, nx); b.st[0] = nloc; b.st[1] = nx; }
        const unsigned old = xb_add(&bar[XB_XSUB(b.x)], 1u);
        const unsigned gen = old / nloc;
        if (old + 1u == (gen + 1u) * nloc) {
            __builtin_amdgcn_fence(__ATOMIC_RELEASE, "agent");
            asm volatile("s_waitcnt vmcnt(0)" ::: "memory");
            const unsigned og = xb_add(&bar[XB_TOP], 1u);
            const unsigned tg = og / nx;
            if (og + 1u == (tg + 1u) * nx) xb_add(&bar[XB_TOPGEN], 1u);
            else XB_SPIN(xb_ld(&bar[XB_TOPGEN]) == tg, bar);
            __builtin_amdgcn_fence(__ATOMIC_ACQUIRE, "agent");
            xb_add(&bar[XB_XGEN(b.x)], 1u);
            asm volatile("s_waitcnt vmcnt(0)" ::: "memory");
        } else {
            XB_SPIN(xb_ld(&bar[XB_XGEN(b.x)]) == gen, bar);
            __builtin_amdgcn_fence(__ATOMIC_ACQUIRE, "agent");
            asm volatile("s_waitcnt vmcnt(0)" ::: "memory");
        }
    }
    __syncthreads();
}
constexpr int NWAVES = 8;
constexpr int BATCH = 2, SEQ = 8192, DM = 2048, NTOK = BATCH * SEQ;
constexpr int INW = 8704, COL_Q = 0, COL_K = 1024, COL_V = 1280, COL_HY = 1536, COL_G = 4608;
constexpr int HW = 1024;
constexpr int NEXP = 32, DEXP = 1024;
constexpr int FHID = 64;
constexpr float LN_EPS = 1e-5f, QK_EPS = 1e-6f, FILTER_EPS = 1e-6f;
constexpr float ALPHA = 1.189207115002721f;
constexpr int MAXROWS = 2 * NTOK + NEXP * 256;
constexpr int ELIST = NTOK;

constexpr size_t MiB = 1u << 20;
constexpr size_t WS_CTL = 0, CTL_ZERO_BYTES = 1 * MiB;
constexpr size_t WS_STATS = 1 * MiB;
constexpr size_t WS_ROPEC = 2 * MiB, WS_ROPES = 4 * MiB;
constexpr size_t WS_H2 = 6 * MiB;
constexpr size_t WS_WRT = 8 * MiB;
constexpr size_t WS_ETOK = 9 * MiB;
constexpr size_t WS_EW = 11 * MiB;
constexpr size_t WS_META = 13 * MiB;
constexpr size_t WS_WIN = 16 * MiB;
constexpr size_t WS_WIN8 = 34 * MiB;
constexpr size_t WS_XN8 = 514 * MiB;
constexpr size_t WS_WCAT = 50 * MiB;
constexpr size_t WS_WOUT = 58 * MiB;
constexpr size_t WS_WGU = 66 * MiB;
constexpr size_t WS_WD = 322 * MiB;
constexpr size_t WS_XN = 450 * MiB;
constexpr size_t WS_ACAT = 450 * MiB;
constexpr size_t WS_KR = 514 * MiB;
constexpr size_t WS_MRG = 514 * MiB;
constexpr size_t WS_X0C = 546 * MiB;
constexpr size_t WS_Y = 450 * MiB;
constexpr size_t WS_ZT = 578 * MiB;
constexpr size_t WS_KT = 642 * MiB;
constexpr size_t WS_PROJ = 706 * MiB;
constexpr size_t WS_PRE1 = 706 * MiB;
constexpr size_t WS_H1B = 834 * MiB;
constexpr size_t WS_HB = 898 * MiB;
constexpr size_t WS_KC = 978 * MiB;
constexpr size_t WS_VC = 986 * MiB;
constexpr size_t WS_END = 994 * MiB;
constexpr int CW_TMO = 0, CW_CODE = 1;
constexpr int CW_BAR = 4096;
constexpr int CW_ECNT = 16384;

constexpr int LDS_BYTES = 147456;
constexpr int LDSCTL_OFF = 145408;
constexpr int L_MISC = LDSCTL_OFF;
constexpr int L_CNT = LDSCTL_OFF + 128;
constexpr int L_OFF = LDSCTL_OFF + 256;
constexpr int L_RBX = LDSCTL_OFF + 512;
constexpr int L_LB = LDSCTL_OFF + 1280;

struct Args { const float* in[31]; float* out; unsigned char* ws; int ph_lo, ph_hi; };
typedef unsigned long long u64;
typedef float f32x2 __attribute__((ext_vector_type(2)));
typedef unsigned u32x2 __attribute__((ext_vector_type(2)));

__device__ __forceinline__ float wave_sum(float v) {
#pragma unroll
    for (int o = 1; o < 64; o <<= 1) v += __shfl_xor(v, o);
    return v;
}
__device__ __forceinline__ float bf_lo(unsigned w) { return __uint_as_float(w << 16); }
__device__ __forceinline__ float bf_hi(unsigned w) { return __uint_as_float(w & 0xffff0000u); }
__device__ __forceinline__ float bf_1(bf16 b) { return __uint_as_float((unsigned)b << 16); }

constexpr int W_IN = 32 * 12, W_AO = 16 * 8, W_HY = 16 * 8, W_OUT = 32 * 8, W_GU = 32 * 32 * 8, W_D = 32 * 16 * 8;
constexpr int NWITEMS = W_IN + W_HY + W_OUT;
constexpr int W8_GU = 32 * 16 * 8, W8_D = 32 * 8 * 8, NW8 = W8_GU + W8_D, W8_IN = 22 * 16, W8_AO = 8 * 8;
struct ConvItem { const float* srcL; const float* srcR; bf16* dst; int N; };
__device__ __forceinline__ bf16* tile_ptr(bf16* base, int K, int rt, int kb) { return base + ((size_t)rt * (K >> 6) + kb) * 16384; }
__device__ __forceinline__ ConvItem conv_decode(const Args& a, int it) {
    unsigned char* ws = a.ws; ConvItem c; int r = it;
    if (r < W_IN) { const int kb = r / 12, nt = r % 12; c.N = INW; c.srcL = a.in[3] + (size_t)(kb * 64) * INW + COL_HY + nt * 256; c.srcR = c.srcL + 128; c.dst = tile_ptr((bf16*)(ws + WS_WIN), 2048, nt, kb); return c; } r -= W_IN;
    if (r < W_HY) { const int kb = r >> 3, nt = r & 7; c.N = 2048; c.srcL = a.in[18] + (size_t)(kb * 64) * 2048 + nt * 256; c.srcR = c.srcL + 128; c.dst = (bf16*)(ws + WS_WCAT + ((size_t)nt * 24 + 8 + kb) * 32768); return c; } r -= W_HY;
    { const int kb = r >> 3, nt = r & 7; c.N = 2048; c.srcL = a.in[19] + (size_t)(kb * 64) * 2048 + nt * 256; c.srcR = c.srcL + 128; c.dst = tile_ptr((bf16*)(ws + WS_WOUT), 2048, nt, kb); return c; }
}
__device__ __forceinline__ ConvItem conv_decode8(const Args& a, int it) {
    unsigned char* ws = a.ws; ConvItem c;
    if (it < W8_GU) { const int e = it >> 7, q = it & 127, kb = q >> 3, t = q & 7; c.N = 1024; const size_t off = (size_t)e * 2048 * 1024 + (size_t)(kb * 128) * 1024 + t * 128;
        c.srcL = a.in[26] + off; c.srcR = a.in[27] + off; c.dst = (bf16*)(ws + WS_WGU + ((size_t)(e * 8 + t) * 16 + kb) * 32768); return c; }
    if (it >= NW8 + W8_IN) { const int r = it - NW8 - W8_IN, kb = r >> 3, nt = r & 7; c.N = 2048; c.srcL = a.in[17] + (size_t)(kb * 128) * 2048 + nt * 256; c.srcR = c.srcL + 128;
        c.dst = (bf16*)(ws + WS_WCAT + ((size_t)nt * 24 + kb) * 32768); return c; }
    if (it >= NW8) { const int r = it - NW8, kb = r / 22, nt = r % 22; c.N = INW; c.srcL = a.in[3] + (size_t)(kb * 128) * INW + (nt < 6 ? nt * 256 : COL_G + (nt - 6) * 256); c.srcR = c.srcL + 128;
        c.dst = (bf16*)(ws + WS_WIN8 + ((size_t)nt * 16 + kb) * 32768); return c; }
    const int r = it - W8_GU, e = r >> 6, q = r & 63, kb = q >> 3, nt = q & 7; c.N = 2048;
    c.srcL = a.in[28] + (size_t)e * 1024 * 2048 + (size_t)(kb * 128) * 2048 + nt * 256; c.srcR = c.srcL + 128; c.dst = (bf16*)(ws + WS_WD + ((size_t)(e * 8 + nt) * 8 + kb) * 32768); return c;
}
__device__ __forceinline__ unsigned pk4_fp8(float a, float b, float c, float d) { int w = 0; w = __builtin_amdgcn_cvt_pk_fp8_f32(a, b, w, false); w = __builtin_amdgcn_cvt_pk_fp8_f32(c, d, w, true); return (unsigned)w; }
__device__ __forceinline__ void tr_load(f32x4 (&v)[8], const ConvItem& c, int wave, int lane, int row0 = 0) {
    const float* s = ((lane < 32) ? c.srcL : c.srcR) + 4 * (lane & 31);
#pragma unroll
    for (int i = 0; i < 8; ++i) v[i] = *(const GAS f32x4*)(s + (size_t)(row0 + wave * 8 + i) * c.N);
}
__device__ __forceinline__ void tr_write(const f32x4 (&v)[8], LAS float* scr, int wave, int lane) {
#pragma unroll
    for (int i = 0; i < 8; ++i) *(LAS f32x4*)(scr + (wave * 8 + i) * 256 + ((4 * lane) ^ (4 * wave))) = v[i];
}
__device__ __forceinline__ void tr_emit(const ConvItem& c, const LAS float* scr, int tid) {
    const int kc = tid & 7;
#pragma unroll
    for (int j = 0; j < 4; ++j) { const int n = (tid >> 3) + 64 * j; const LAS float* s = scr + (8 * kc) * 256 + (n ^ (4 * kc));
        v4u o; o.x = pk2(s[0 * 256], s[1 * 256]); o.y = pk2(s[2 * 256], s[3 * 256]); o.z = pk2(s[4 * 256], s[5 * 256]); o.w = pk2(s[6 * 256], s[7 * 256]);
        *(GAS v4u*)(c.dst + n * 64 + 8 * kc) = o; }
}
__device__ __forceinline__ void tr_emit8(const ConvItem& c, const LAS float* scr0, int tid) {
    const int kc = tid & 7; const LAS float* tile = scr0 + (kc >> 2) * (64 * 256); const int k0 = 16 * (kc & 3);
#pragma unroll
    for (int j = 0; j < 4; ++j) { const int n = (tid >> 3) + 64 * j; float f[16];
#pragma unroll
        for (int e = 0; e < 16; ++e) f[e] = tile[(k0 + e) * 256 + (n ^ (4 * ((k0 + e) >> 3)))] * 256.f;
        v4u o; o.x = pk4_fp8(f[0], f[1], f[2], f[3]); o.y = pk4_fp8(f[4], f[5], f[6], f[7]); o.z = pk4_fp8(f[8], f[9], f[10], f[11]); o.w = pk4_fp8(f[12], f[13], f[14], f[15]);
        *(GAS v4u*)((unsigned char*)c.dst + n * 128 + 16 * kc) = o; }
}
__device__ __forceinline__ void cv8_load(f32x4 (&v)[16], const ConvItem& c, int wave, int lane) {
    const float* s = ((lane < 32) ? c.srcL : c.srcR) + 4 * (lane & 31) + (size_t)(16 * wave) * c.N;
#pragma unroll
    for (int i = 0; i < 16; ++i) v[i] = *(const GAS f32x4*)(s + (size_t)i * c.N);
}
__device__ __forceinline__ void cv8_emit(const f32x4 (&v)[16], const ConvItem& c, LAS unsigned char* T, int wave, int lane) {
#pragma unroll
    for (int j = 0; j < 4; ++j) { v4u o;
        o.x = pk4_fp8(v[0][j] * 256.f, v[1][j] * 256.f, v[2][j] * 256.f, v[3][j] * 256.f);     o.y = pk4_fp8(v[4][j] * 256.f, v[5][j] * 256.f, v[6][j] * 256.f, v[7][j] * 256.f);
        o.z = pk4_fp8(v[8][j] * 256.f, v[9][j] * 256.f, v[10][j] * 256.f, v[11][j] * 256.f);  o.w = pk4_fp8(v[12][j] * 256.f, v[13][j] * 256.f, v[14][j] * 256.f, v[15][j] * 256.f);
        *(LAS v4u*)(T + (4 * lane + j) * 128 + 16 * (wave ^ (lane & 7))) = o; }
    LDS_WAIT(); __syncthreads();
#pragma unroll
    for (int q = 0; q < 4; ++q) { const int r = wave * 32 + q * 8 + (lane >> 3), ch = lane & 7;
        const v4u w = *(const LAS v4u*)(T + r * 128 + 16 * (ch ^ ((r >> 2) & 7)));
        *(GAS v4u*)((unsigned char*)c.dst + r * 128 + 16 * ch) = w; }
}
__device__ __forceinline__ void conv_items_fp8(const Args& a, LAS unsigned char* lds, int first, int last, int wg, int nwg, int tid) {
    const int wave = __builtin_amdgcn_readfirstlane(tid >> 6), lane = tid & 63;
    int it0 = first + wg, it1 = it0 + nwg, it2 = it1 + nwg;
    if (it0 >= last) return;
    f32x4 v0[16], v1[16], v2[16];
    ConvItem c0 = conv_decode8(a, it0), c1 = c0, c2 = c0;
    cv8_load(v0, c0, wave, lane);
    if (it1 < last) { c1 = conv_decode8(a, it1); cv8_load(v1, c1, wave, lane); }
    LAS unsigned char* T0 = lds; LAS unsigned char* T1 = lds + 32768;
    for (;;) {
        if (it2 < last) { c2 = conv_decode8(a, it2); cv8_load(v2, c2, wave, lane); }
        cv8_emit(v0, c0, T0, wave, lane);
        if (it1 >= last) break;
        it0 = it2 + nwg;
        if (it0 < last) { c0 = conv_decode8(a, it0); cv8_load(v0, c0, wave, lane); }
        cv8_emit(v1, c1, T1, wave, lane);
        if (it2 >= last) break;
        it1 = it0 + nwg;
        if (it1 < last) { c1 = conv_decode8(a, it1); cv8_load(v1, c1, wave, lane); }
        cv8_emit(v2, c2, T0, wave, lane);
        if (it0 >= last) break;
        it2 = it1 + nwg;
        { LAS unsigned char* t_ = T0; T0 = T1; T1 = t_; }
    }
    LDS_WAIT(); __syncthreads();
}
__device__ __forceinline__ void conv_items(const Args& a, LAS unsigned char* lds, int first, int last, int wg, int nwg, int tid) {
    LAS float* scr0 = (LAS float*)lds; LAS float* scr1 = scr0 + 64 * 256;
    const int wave = __builtin_amdgcn_readfirstlane(tid >> 6), lane = tid & 63;
    int it = first + wg;
    if (it >= last) return;
    f32x4 vA0[8], vA1[8], vB0[8], vB1[8];
    ConvItem cA0 = conv_decode(a, it), cA1 = cA0, cB0 = cA0, cB1 = cA0;
    bool hA1 = it + nwg < last, hB0 = false, hB1 = false;
    tr_load(vA0, cA0, wave, lane); if (hA1) { cA1 = conv_decode(a, it + nwg); tr_load(vA1, cA1, wave, lane); }
    for (;;) {
        int nx = it + 2 * nwg; hB0 = nx < last; hB1 = nx + nwg < last;
        if (hB0) { cB0 = conv_decode(a, nx); tr_load(vB0, cB0, wave, lane); } if (hB1) { cB1 = conv_decode(a, nx + nwg); tr_load(vB1, cB1, wave, lane); }
        tr_write(vA0, scr0, wave, lane); if (hA1) tr_write(vA1, scr1, wave, lane);
        LDS_WAIT(); __syncthreads();
        tr_emit(cA0, scr0, tid); if (hA1) tr_emit(cA1, scr1, tid);
        LDS_WAIT(); __syncthreads();
        if (!hB0) break;
        it = nx; nx = it + 2 * nwg; const bool h0 = nx < last; hA1 = nx + nwg < last;
        if (h0) { cA0 = conv_decode(a, nx); tr_load(vA0, cA0, wave, lane); } if (hA1) { cA1 = conv_decode(a, nx + nwg); tr_load(vA1, cA1, wave, lane); }
        tr_write(vB0, scr0, wave, lane); if (hB1) tr_write(vB1, scr1, wave, lane);
        LDS_WAIT(); __syncthreads();
        tr_emit(cB0, scr0, tid); if (hB1) tr_emit(cB1, scr1, tid);
        LDS_WAIT(); __syncthreads();
        if (!h0) break;
        it = nx;
    }
}
__device__ __forceinline__ void p0_prologue(const Args& a, LAS unsigned char* lds, int gw, int NGW, int wave, int lane) {
    unsigned char* ws = a.ws;
    conv_items(a, lds, 0, W_IN, gw / NWAVES, NGW / NWAVES, wave * 64 + lane); __syncthreads(); conv_items_fp8(a, lds, NW8, NW8 + W8_IN, gw / NWAVES, NGW / NWAVES, wave * 64 + lane); __syncthreads();
    {
        const float* g = a.in[1]; const float* b = a.in[2]; bf16* XN = (bf16*)(ws + WS_XN);
        for (int m = gw; m < NTOK; m += NGW) {
            const GAS f32x4* xr = (const GAS f32x4*)(a.in[0] + (size_t)m * DM) + lane;
            f32x4 v[8]; float s = 0.f;
#pragma unroll
            for (int j = 0; j < 8; ++j) { v[j] = xr[64 * j]; s += (v[j].x + v[j].y) + (v[j].z + v[j].w); }
            const float mean = wave_sum(s) * (1.f / DM); float s2 = 0.f;
#pragma unroll
            for (int j = 0; j < 8; ++j) { v[j] = v[j] - mean; s2 += (v[j].x * v[j].x + v[j].y * v[j].y) + (v[j].z * v[j].z + v[j].w * v[j].w); }
            const float rstd = 1.f / sqrtf(wave_sum(s2) * (1.f / DM) + LN_EPS);
            GAS u64* o8 = (GAS u64*)(XN + (size_t)m * DM) + lane; GAS u64* h8 = (GAS u64*)((bf16*)a.out + (size_t)m * DM) + lane; GAS unsigned* x8 = (GAS unsigned*)(ws + WS_XN8 + (size_t)m * DM) + lane;
#pragma unroll
            for (int j = 0; j < 8; ++j) { const f32x4 gg = *(const f32x4*)(g + 4 * lane + 256 * j), bb = *(const f32x4*)(b + 4 * lane + 256 * j); const f32x4 y = v[j] * rstd * gg + bb, ya = y * ALPHA;
                o8[64 * j] = (u64)pk2(y.x, y.y) | ((u64)pk2(y.z, y.w) << 32); h8[64 * j] = (u64)pk2(ya.x, ya.y) | ((u64)pk2(ya.z, ya.w) << 32); x8[64 * j] = pk4_fp8(y.x, y.y, y.z, y.w); }
        }
    }
    const int gt = gw * 64 + lane, NGT = NGW * 64;
    {
        float* WRT = (float*)(ws + WS_WRT); float* RC = WRT + 48 * 2048; const float* g1 = a.in[20]; const float* b1 = a.in[21];
        for (int i = gt; i < 48 * 2048; i += NGT) { const int col = i >> 11, k = i & 2047; float v = 0.f;
            if (col < 4) v = a.in[22][k * 4 + col]; else if (col < 36) v = a.in[24][k * 32 + (col - 4)];
            const float wv = v * g1[k]; WRT[i] = wv;
            unsigned uh = __float_as_uint(wv); uh += 0x7fffu + ((uh >> 16) & 1u); uh &= 0xffff0000u; const float rem = wv - __uint_as_float(uh);
            unsigned ul = __float_as_uint(rem); ul += 0x7fffu + ((ul >> 16) & 1u);
            ((unsigned short*)(ws + WS_WRT + 512 * 1024))[i] = (unsigned short)(uh >> 16); ((unsigned short*)(ws + WS_WRT + 768 * 1024))[i] = (unsigned short)(ul >> 16); }
        for (int col = gw; col < 48; col += NGW) { float s1 = 0.f, s2 = 0.f;
            if (col < 36) for (int k = lane; k < 2048; k += 64) { const float w = (col < 4) ? a.in[22][k * 4 + col] : a.in[24][k * 32 + (col - 4)]; s1 += g1[k] * w; s2 += b1[k] * w; }
            s1 = wave_sum(s1); s2 = wave_sum(s2);
            if (lane == 0) { RC[col] = s1; RC[48 + col] = s2 + ((col < 4) ? a.in[23][col] : (col < 36 ? a.in[25][col - 4] : 0.f)); } }
    }
    {
        float* rc = (float*)(ws + WS_ROPEC); float* rs = (float*)(ws + WS_ROPES);
        for (int i = gt; i < SEQ * 64; i += NGT) { const int t = i >> 6, f = i & 63; const int pos = (f < 32) ? (t >> 6) : (t & 63); const int fi = f & 31;
            const float inv = exp2f(-(float)fi * (13.287712379549449f / 32.0f));
            const float ang = (float)pos * inv;
            rc[i] = cosf(ang); rs[i] = sinf(ang); }
    }
    {
        const float* w1 = a.in[9]; const float* b1 = a.in[10]; const float* f1 = a.in[11]; const float* w2 = a.in[12]; const float* b2 = a.in[13]; const float* f2 = a.in[14];
        float* H2 = (float*)(ws + WS_H2);
        LAS float* fe = (LAS float*)(lds + 8 * 17408); LAS float* h1s = fe + 8 * 33;
        const int tid = wave * 64 + lane, p = tid >> 6, m = tid & 63;
        for (int blk = gw / NWAVES; blk < SEQ / 8; blk += NGW / NWAVES) {
            __syncthreads();
            if (tid < 8 * 33) { const int pp = tid / 33, i = tid % 33, j = blk * 8 + pp; float v;
                if (i == 0) v = (float)j / (float)(SEQ - 1);
                else { const int bi = (i - 1) & 15; const double band = 1e-4 + (double)bi * ((15.0 - 1e-4) / 15.0); const double ar = band * (6.283185307179586 * (double)j / (double)SEQ);
                    v = (i <= 16) ? (float)cos(ar) : (float)(-sin(ar)); }
                fe[tid] = v; }
            __syncthreads();
            { float acc = b1[m];
#pragma unroll
              for (int i = 0; i < 33; ++i) acc += fe[p * 33 + i] * w1[i * 64 + m];
              h1s[p * 64 + m] = sinf(f1[m] * acc); }
            __syncthreads();
            { float acc = b2[m];
#pragma unroll 16
              for (int i = 0; i < 64; ++i) acc += h1s[p * 64 + i] * w2[i * 64 + m];
              H2[(size_t)(blk * 8 + p) * 64 + m] = sinf(f2[m] * acc); }
        }
    }
}

__device__ __forceinline__ void p2_qk(const Args& a, int gw, int NGW, int lane) {
    bf16* PROJ = (bf16*)(a.ws + WS_PROJ); const float* rc = (const float*)(a.ws + WS_ROPEC); const float* rs = (const float*)(a.ws + WS_ROPES);
    unsigned short* KC8 = (unsigned short*)(a.ws + WS_KC);
    const float gq0 = a.in[5][2 * lane], gq1 = a.in[5][2 * lane + 1], gk0 = a.in[6][2 * lane], gk1 = a.in[6][2 * lane + 1];
    const int idx = (lane >> 5) * 32 + ((2 * lane) & 31); const float sgn = (lane & 16) ? 1.f : -1.f;
    for (int tok = gw; tok < NTOK; tok += NGW) {
        const int t = tok & (SEQ - 1);
        const float c0 = rc[t * 64 + idx], c1 = rc[t * 64 + idx + 1], s0 = rs[t * 64 + idx] * sgn, s1 = rs[t * 64 + idx + 1] * sgn;
        unsigned* row = (unsigned*)(PROJ + (size_t)tok * INW) + lane;
#pragma unroll
        for (int h = 0; h < 10; ++h) {
            const unsigned w = row[h * 64];
            float x0 = bf_lo(w), x1 = bf_hi(w);
            const float rn = rsqrtf(wave_sum(x0 * x0 + x1 * x1) * (1.f / 128.f) + QK_EPS);
            x0 *= rn * (h < 8 ? gq0 : gk0); x1 *= rn * (h < 8 ? gq1 : gk1);
            const float p0 = __shfl_xor(x0, 16), p1 = __shfl_xor(x1, 16);
            const unsigned o = pk2(x0 * c0 + p0 * s0, x1 * c1 + p1 * s1);
            if (h < 8) row[h * 64] = o;
            else { int d = 0; d = __builtin_amdgcn_cvt_pk_fp8_f32(x0 * c0 + p0 * s0, x1 * c1 + p1 * s1, d, false);
                   KC8[(((size_t)(tok >> 13) * 2 + (h - 8)) * SEQ + t) * 64 + lane] = (unsigned short)d; }
        }
    }
}
__device__ __forceinline__ void p2_vt8(const Args& a, LAS unsigned char* lds, int vcu, int G, int tid) {
    const bf16* PROJ = (const bf16*)(a.ws + WS_PROJ); unsigned char* VT8 = (unsigned char*)(a.ws + WS_VC);
    LAS unsigned char* tl = lds;
    for (int it = vcu; it < 2 * 2 * (SEQ / 64); it += G) {
        const int tile = it & 127, kvh = (it >> 7) & 1, b = it >> 8;
#if defined(BREAK_ATTN)
        const int t = tid >> 3, dc = tid & 7, pos = t;
#else
        const int t = tid >> 3, dc = tid & 7, pos = attn::vt_pos(t);
#endif
        const bf16* src = PROJ + (size_t)(b * SEQ + tile * 64 + t) * INW + COL_V + kvh * 128 + dc * 16;
        const v4u w0 = *(const v4u*)src, w1 = *(const v4u*)(src + 8);
        const unsigned ww[8] = {w0.x, w0.y, w0.z, w0.w, w1.x, w1.y, w1.z, w1.w};
#pragma unroll
        for (int i = 0; i < 8; ++i) { const int d2 = __builtin_amdgcn_cvt_pk_fp8_f32(bf_lo(ww[i]), bf_hi(ww[i]), 0, false);
            tl[(dc * 16 + 2 * i) * 64 + pos] = (unsigned char)(d2 & 0xff); tl[(dc * 16 + 2 * i + 1) * 64 + pos] = (unsigned char)((d2 >> 8) & 0xff); }
        __syncthreads();
        *(GAS v4u*)(VT8 + ((size_t)((b * 2 + kvh) * 128 + tile)) * 8192 + tid * 16) = *(const LAS v4u*)(tl + tid * 16);
        __syncthreads();
    }
}
#if defined(CHECK_ATTN)
#ifndef CHECK_TOL
#define CHECK_TOL 0.3f
#endif
__device__ __forceinline__ float wave_max(float v) {
#pragma unroll
    for (int o = 1; o < 64; o <<= 1) v = fmaxf(v, __shfl_xor(v, o));
    return v;
}
__device__ __forceinline__ void check_attn(const Args& a, int gw, int NGW, int lane) {
    const bf16* PROJ = (const bf16*)(a.ws + WS_PROJ); const unsigned char* O = (const unsigned char*)(a.ws + WS_ACAT); const float* rc = (const float*)(a.ws + WS_ROPEC); const float* rs = (const float*)(a.ws + WS_ROPES);
    gu32* ctl = (gu32*)(a.ws + WS_CTL);
    const float gk0 = a.in[6][2 * lane], gk1 = a.in[6][2 * lane + 1];
    const int idx = (lane >> 5) * 32 + ((2 * lane) & 31); const float sgn = (lane & 16) ? 1.f : -1.f;
    for (int s = gw; s < 2048; s += NGW) {
        const int b = s & 1, hq = (s >> 1) & 7, t = ((s >> 4) * 64 + 13 + 7 * hq) & (SEQ - 1), kvh = hq >> 2;
        const unsigned qw = *((const unsigned*)(PROJ + (size_t)(b * SEQ + t) * INW + hq * 128) + lane);
        const float q0 = bf_lo(qw), q1 = bf_hi(qw);
        float m = -1e30f, l = 0.f, a0 = 0.f, a1 = 0.f;
        for (int j = 0; j < SEQ; ++j) {
            const unsigned* row = (const unsigned*)(PROJ + (size_t)(b * SEQ + j) * INW);
            const unsigned kw = row[(COL_K >> 1) + kvh * 64 + lane], vw = row[(COL_V >> 1) + kvh * 64 + lane];
            float x0 = bf_lo(kw), x1 = bf_hi(kw);
            const float rn = rsqrtf(wave_sum(x0 * x0 + x1 * x1) * (1.f / 128.f) + QK_EPS);
            x0 *= rn * gk0; x1 *= rn * gk1;
            const float p0 = __shfl_xor(x0, 16), p1 = __shfl_xor(x1, 16);
            const float k0 = x0 * rc[j * 64 + idx] + p0 * rs[j * 64 + idx] * sgn, k1 = x1 * rc[j * 64 + idx + 1] + p1 * rs[j * 64 + idx + 1] * sgn;
            const float sc = wave_sum(q0 * k0 + q1 * k1) * 0.088388347648318440f;
            const float mn = fmaxf(m, sc), al = expf(m - mn), p = expf(sc - mn);
            l = l * al + p; a0 = a0 * al + p * bf_lo(vw); a1 = a1 * al + p * bf_hi(vw); m = mn;
        }
        const float r0 = a0 / l, r1 = a1 / l;
        const int ow = (int)*((const unsigned short*)(O + (size_t)(b * SEQ + t) * 3072 + hq * 128) + lane);
        const float o0 = __builtin_amdgcn_cvt_f32_fp8(ow, 0), o1 = __builtin_amdgcn_cvt_f32_fp8(ow, 1);
        const float err = wave_max(fmaxf(fabsf(r0 - o0), fabsf(r1 - o1))), mag = wave_max(fmaxf(fabsf(r0), fabsf(r1)));
        if (lane == 0 && !(err <= CHECK_TOL * mag + 1e-4f)) __hip_atomic_store(ctl + 12, 1u, RLX_AGENT);
    }
}
__device__ __forceinline__ void check_merge(const Args& a, int gw, int NGW, int lane) {
    const unsigned char* AC = (const unsigned char*)(a.ws + WS_ACAT); const bf16* PROJ = (const bf16*)(a.ws + WS_PROJ); const bf16* MRG = (const bf16*)(a.ws + WS_MRG);
    const float* wa = a.in[17]; const float* wh = a.in[18]; gu32* ctl = (gu32*)(a.ws + WS_CTL);
    for (int s = gw; s < 2048; s += NGW) {
        const int r = (s * 8 + 5) & (NTOK - 1), c = ((s * 37) & 31) * 64 + lane;
        const unsigned char* row = AC + (size_t)r * 3072; const bf16* ah = (const bf16*)(row + 1024);
        float ya = 0.f, yh = 0.f;
        for (int k = 0; k < 1024; ++k) { ya += __builtin_amdgcn_cvt_f32_fp8((int)row[k], 0) * wa[(size_t)k * 2048 + c]; yh += bf_1(ah[k]) * wh[(size_t)k * 2048 + c]; }
        const float ga = bf_1(PROJ[(size_t)r * INW + COL_G + c]), gh = bf_1(PROJ[(size_t)r * INW + COL_G + DM + c]);
        const float est = (bf_1(MRG[(size_t)r * DM + c]) - gh * yh) / fmaxf(ga, 1e-6f);
        const float s1 = wave_sum(est * ya), s2 = wave_sum(ya * ya);
        if (lane == 0 && !(s1 >= 0.7f * s2 && s1 <= 1.4f * s2)) __hip_atomic_store(ctl + 12, 1u, RLX_AGENT);
    }
}
#endif
__device__ __forceinline__ void p2_conv(const Args& a, LAS unsigned char* lds, int vcu, int G, int tid) {
    const bf16* PROJ = (const bf16*)(a.ws + WS_PROJ); bf16* X0C = (bf16*)(a.ws + WS_X0C); float* ZT = (float*)(a.ws + WS_ZT);
    const float* cw = a.in[7]; const float* cb = a.in[8];
    LAS float* zt = (LAS float*)lds;
    const int cg = tid & 15, tr = tid >> 4;
    for (int it = vcu; it < 1024; it += G) {
        const int tokblk = it >> 3, chblk = it & 7, ch = chblk * 128 + cg * 8;
        const int T0 = tokblk * 128, tb = T0 + tr * 4, sb = tb & (SEQ - 1);
        float res[3][4][8];
#pragma unroll
        for (int p = 0; p < 3; ++p) {
            const int col = p * 1024 + ch;
            float w0[8], w1[8], w2[8], bs[8];
#pragma unroll
            for (int q = 0; q < 2; ++q) { const f32x4 a0 = *(const f32x4*)(cw + col + 4 * q), a1 = *(const f32x4*)(cw + 3072 + col + 4 * q), a2 = *(const f32x4*)(cw + 6144 + col + 4 * q), bb = *(const f32x4*)(cb + col + 4 * q);
#pragma unroll
                for (int e = 0; e < 4; ++e) { w0[4 * q + e] = a0[e]; w1[4 * q + e] = a1[e]; w2[4 * q + e] = a2[e]; bs[4 * q + e] = bb[e]; } }
            const bf16* src = PROJ + (size_t)tb * INW + COL_HY + col;
            float in[6][8];
#pragma unroll
            for (int i = 0; i < 6; ++i) { const int s = sb + i - 1; v4u w = (v4u){0u, 0u, 0u, 0u};
                if (s >= 0 && s < SEQ) w = *(const v4u*)(src + (long)(i - 1) * INW);
                in[i][0] = bf_lo(w.x); in[i][1] = bf_hi(w.x); in[i][2] = bf_lo(w.y); in[i][3] = bf_hi(w.y); in[i][4] = bf_lo(w.z); in[i][5] = bf_hi(w.z); in[i][6] = bf_lo(w.w); in[i][7] = bf_hi(w.w); }
#pragma unroll
            for (int i = 0; i < 4; ++i)
#pragma unroll
                for (int e = 0; e < 8; ++e) res[p][i][e] = bs[e] + w0[e] * in[i][e] + w1[e] * in[i + 1][e] + w2[e] * in[i + 2][e];
        }
#pragma unroll
        for (int i = 0; i < 4; ++i) { v4u o; o.x = pk2(res[0][i][0], res[0][i][1]); o.y = pk2(res[0][i][2], res[0][i][3]); o.z = pk2(res[0][i][4], res[0][i][5]); o.w = pk2(res[0][i][6], res[0][i][7]);
            *(v4u*)(X0C + (size_t)(tb + i) * HW + ch) = o;
            const int t = tr * 4 + i, tp = t + (t >> 5);
#pragma unroll
            for (int e = 0; e < 8; ++e) zt[(cg * 8 + e) * 133 + tp] = res[2][i][e] * res[1][i][e]; }
        __syncthreads();
        { const int c2 = tid >> 2, seg = tid & 3, b = T0 >> 13, s0 = T0 & (SEQ - 1);
          float* dst = ZT + ((size_t)(chblk * 128 + c2) * 2 + b) * SEQ + s0 + seg * 32; const LAS float* zs = zt + c2 * 133 + seg * 33;
#pragma unroll
          for (int k = 0; k < 8; ++k) { f32x4 v; v.x = zs[4 * k]; v.y = zs[4 * k + 1]; v.z = zs[4 * k + 2]; v.w = zs[4 * k + 3]; *(f32x4*)(dst + 4 * k) = v; } }
        __syncthreads();
    }
}
__device__ __forceinline__ void p2_filter(const Args& a, LAS unsigned char* lds, int first, int stride, int tid) {
    typedef short bf8_t __attribute__((ext_vector_type(8))); typedef float f16_t __attribute__((ext_vector_type(16)));
    const float* H2 = (const float*)(a.ws + WS_H2); const float* w3 = a.in[15]; float* KT = (float*)(a.ws + WS_KT);
    LAS float* tf = (LAS float*)lds; LAS float* tbk = tf + 128 * 65;
    const int lane = tid & 63, wave = tid >> 6, r32 = lane & 31, hi = lane >> 5, half = wave >> 2, cl = 32 * (wave & 3) + r32;
    const float min_decay = -3.0701134573253944f, max_decay = -15.350567286626972f;
    for (int it = first; it < 1024; it += stride) {
        const int jblk = it >> 3, chblk = it & 7, j0 = jblk * 64, ch = chblk * 128 + cl;
        f16_t acc0 = {}, acc1 = {};
#pragma unroll
        for (int s = 0; s < 4; ++s) {
            const int k0 = 16 * s + 8 * hi;
            unsigned bw[4];
#pragma unroll
            for (int q = 0; q < 4; ++q) bw[q] = pk2(w3[(size_t)(k0 + 2 * q) * 2048 + half * 1024 + ch], w3[(size_t)(k0 + 2 * q + 1) * 2048 + half * 1024 + ch]);
            const v4u bq = (v4u){bw[0], bw[1], bw[2], bw[3]}; const bf8_t bfr = __builtin_bit_cast(bf8_t, bq);
#pragma unroll
            for (int mt = 0; mt < 2; ++mt) { const float* hp = H2 + (size_t)(j0 + 32 * mt + r32) * 64 + k0; const f32x4 h0 = *(const f32x4*)hp, h1 = *(const f32x4*)(hp + 4);
                const v4u aq = (v4u){pk2(h0.x, h0.y), pk2(h0.z, h0.w), pk2(h1.x, h1.y), pk2(h1.z, h1.w)}; const bf8_t afr = __builtin_bit_cast(bf8_t, aq);
                if (mt == 0) acc0 = __builtin_amdgcn_mfma_f32_32x32x16_bf16(afr, bfr, acc0, 0, 0, 0); else acc1 = __builtin_amdgcn_mfma_f32_32x32x16_bf16(afr, bfr, acc1, 0, 0, 0); }
        }
        const float delta = fabsf(min_decay + (max_decay - min_decay) * ((float)ch / 1023.f));
        LAS float* dstt = half ? tbk : tf;
#pragma unroll
        for (int r = 0; r < 16; ++r) { const int jj = (r & 3) + 8 * (r >> 2) + 4 * hi;
            dstt[cl * 65 + jj] = acc0[r] * expf(-((float)(j0 + jj) / (float)(SEQ - 1)) * delta);
            dstt[cl * 65 + 32 + jj] = acc1[r] * expf(-((float)(j0 + 32 + jj) / (float)(SEQ - 1)) * delta); }
        __syncthreads();
        { const int c2 = tid >> 2, seg = tid & 3; float* dst = KT + (size_t)(chblk * 128 + c2) * 16384;
#pragma unroll
          for (int k = 0; k < 16; ++k) { const int jj = seg * 16 + k, j = j0 + jj; dst[j] = tf[c2 * 65 + jj];
              if (j == 0) dst[8192] = 0.f; else dst[16384 - j] = tbk[c2 * 65 + jj]; } }
        __syncthreads();
    }
}

__device__ __forceinline__ void p4_conv_direct(const Args& a, LAS unsigned char* lds, int vcu, int G, int tid) {
    const float* KT = (const float*)(a.ws + WS_KT); float* ZT = (float*)(a.ws + WS_ZT); const float* dbias = a.in[16];
    LAS float* kk = (LAS float*)lds;
    LAS float* zz = kk + 17408;
    LAS float* red = zz + 16384;
    const int lane = tid & 63, wave = tid >> 6;
    for (int ch = vcu; ch < HW; ch += G) {
        float ss = 0.f;
        for (int i = tid; i < 16384; i += 512) { const float v = KT[(size_t)ch * 16384 + i]; ss += v * v; kk[i + (i >> 4)] = v; }
        for (int i = tid; i < 16384; i += 512) zz[i] = ZT[(size_t)ch * 16384 + i];
        ss = wave_sum(ss); if (lane == 0) red[wave] = ss;
        __syncthreads();
        float tot = 0.f;
#pragma unroll
        for (int w = 0; w < 8; ++w) tot += red[w];
        const float scale = rsqrtf(tot + FILTER_EPS), db = dbias[ch];
        const int t0 = tid * 16;
        float acc0[16], acc1[16];
#pragma unroll
        for (int i = 0; i < 16; ++i) { acc0[i] = 0.f; acc1[i] = 0.f; }
        for (int s0 = 0; s0 < SEQ; s0 += 16) {
            float kw[31];
#pragma unroll
            for (int q = 0; q < 31; ++q) { const int idx = (t0 - s0 - 15 + q) & 16383; kw[q] = kk[idx + (idx >> 4)]; }
#pragma unroll
            for (int jj = 0; jj < 16; ++jj) { const float z0 = zz[s0 + jj], z1 = zz[SEQ + s0 + jj];
#pragma unroll
                for (int i = 0; i < 16; ++i) { acc0[i] += kw[i - jj + 15] * z0; acc1[i] += kw[i - jj + 15] * z1; } }
        }
        float* y0 = ZT + (size_t)ch * 16384 + t0; float* y1 = y0 + SEQ;
#pragma unroll
        for (int i = 0; i < 16; ++i) { y0[i] = acc0[i] * scale + db * zz[t0 + i]; y1[i] = acc1[i] * scale + db * zz[SEQ + t0 + i]; }
        __syncthreads();
    }
}

__device__ __forceinline__ void p5_ah(const Args& a, LAS unsigned char* lds, int vcu, int G, int tid) {
    const float* YT = (const float*)(a.ws + WS_ZT); const bf16* X0C = (const bf16*)(a.ws + WS_X0C); bf16* AH = (bf16*)(a.ws + WS_ACAT + 1024);
    LAS float* yt = (LAS float*)lds;
    for (int it = vcu; it < 2048; it += G) {
        const int tokblk = it >> 3, chblk = it & 7, T0 = tokblk * 64, b = T0 >> 13, s0 = T0 & (SEQ - 1);
        { const int c2 = tid >> 2, seg = tid & 3; const float* src = YT + ((size_t)(chblk * 128 + c2) * 2 + b) * SEQ + s0 + seg * 16;
#pragma unroll
          for (int k = 0; k < 4; ++k) { const f32x4 v = *(const f32x4*)(src + 4 * k); yt[c2 * 65 + seg * 16 + 4 * k] = v.x; yt[c2 * 65 + seg * 16 + 4 * k + 1] = v.y; yt[c2 * 65 + seg * 16 + 4 * k + 2] = v.z; yt[c2 * 65 + seg * 16 + 4 * k + 3] = v.w; } }
        __syncthreads();
        { const int t = tid >> 3, cs = tid & 7; const size_t off = (size_t)(T0 + t) * HW + chblk * 128 + cs * 16;
          const v4u xa = *(const v4u*)(X0C + off), xb = *(const v4u*)(X0C + off + 8);
          const unsigned xw[8] = {xa.x, xa.y, xa.z, xa.w, xb.x, xb.y, xb.z, xb.w}; unsigned ow[8];
#pragma unroll
          for (int k = 0; k < 8; ++k) ow[k] = pk2(bf_lo(xw[k]) * yt[(cs * 16 + 2 * k) * 65 + t], bf_hi(xw[k]) * yt[(cs * 16 + 2 * k + 1) * 65 + t]);
          const size_t offo = (size_t)(T0 + t) * 1536 + chblk * 128 + cs * 16;
          *(v4u*)(AH + offo) = (v4u){ow[0], ow[1], ow[2], ow[3]}; *(v4u*)(AH + offo + 8) = (v4u){ow[4], ow[5], ow[6], ow[7]}; }
        __syncthreads();
    }
}

typedef float f32x4m __attribute__((ext_vector_type(4)));
__device__ __forceinline__ void p8_ln_route(const Args& a, LAS unsigned char* lds, int vcu, int G, int tid) {
    const bf16* PRE = (const bf16*)(a.ws + WS_PRE1); bf16* H1B = (bf16*)(a.ws + WS_H1B); const float* g = a.in[20]; const float* bt = a.in[21];
    const float* WRT = (const float*)(a.ws + WS_WRT); const float* RC = WRT + 48 * 2048;
    int* ETOK = (int*)(a.ws + WS_ETOK); float* EW = (float*)(a.ws + WS_EW); gu32* ctl = (gu32*)(a.ws + WS_CTL);
    LAS float* lg = (LAS float*)lds;
    LAS int* lcnt = (LAS int*)(lds + 32768); LAS int* lbase = (LAS int*)(lds + 32768 + 128); LAS float* rstat = (LAS float*)(lds + 32768 + 256);
    const int lane = tid & 63, wave = tid >> 6;
    for (int it = vcu; it < NTOK / 64; it += G) {
        const int r0 = it * 64;
        if (tid < 32) lcnt[tid] = 0;
        {
            const int wq = wave & 3, kh = wave >> 2;
            f32x4 acc0 = {0.f, 0.f, 0.f, 0.f}, acc1 = acc0, acc2 = acc0;
            typedef short rt_bf16x8 __attribute__((ext_vector_type(8)));
            const bf16* ap = PRE + (size_t)(r0 + wq * 16 + (lane & 15)) * DM + kh * 1024 + 8 * (lane >> 4);
            const bf16* bh = (const bf16*)(a.ws + WS_WRT + 512 * 1024) + (size_t)(lane & 15) * DM + kh * 1024 + 8 * (lane >> 4);
            const bf16* bl = (const bf16*)(a.ws + WS_WRT + 768 * 1024) + (size_t)(lane & 15) * DM + kh * 1024 + 8 * (lane >> 4);
#pragma unroll 4
            for (int k0 = 0; k0 < DM / 2; k0 += 32) {
                const rt_bf16x8 av = *(const rt_bf16x8*)(ap + k0);
                const rt_bf16x8 h0 = *(const rt_bf16x8*)(bh + k0), h1 = *(const rt_bf16x8*)(bh + 16 * DM + k0), h2 = *(const rt_bf16x8*)(bh + 32 * DM + k0);
                const rt_bf16x8 l0 = *(const rt_bf16x8*)(bl + k0), l1 = *(const rt_bf16x8*)(bl + 16 * DM + k0), l2 = *(const rt_bf16x8*)(bl + 32 * DM + k0);
                acc0 = __builtin_amdgcn_mfma_f32_16x16x32_bf16(av, h0, acc0, 0, 0, 0); acc1 = __builtin_amdgcn_mfma_f32_16x16x32_bf16(av, h1, acc1, 0, 0, 0); acc2 = __builtin_amdgcn_mfma_f32_16x16x32_bf16(av, h2, acc2, 0, 0, 0);
                acc0 = __builtin_amdgcn_mfma_f32_16x16x32_bf16(av, l0, acc0, 0, 0, 0); acc1 = __builtin_amdgcn_mfma_f32_16x16x32_bf16(av, l1, acc1, 0, 0, 0); acc2 = __builtin_amdgcn_mfma_f32_16x16x32_bf16(av, l2, acc2, 0, 0, 0);
            }
#pragma unroll
            for (int r = 0; r < 4; ++r) { LAS float* p = lg + kh * (64 * 48) + (wq * 16 + (lane >> 4) * 4 + r) * 48 + (lane & 15); p[0] = acc0[r]; p[16] = acc1[r]; p[32] = acc2[r]; }
        }
        for (int i = 0; i < 8; ++i) { const int rl = wave * 8 + i, r = r0 + rl;
            const GAS u32x2* xr = (const GAS u32x2*)(PRE + (size_t)r * DM) + lane; f32x4 v[8]; float s = 0.f;
#pragma unroll
            for (int j = 0; j < 8; ++j) { const u32x2 w = xr[64 * j]; v[j] = (f32x4){bf_lo(w.x), bf_hi(w.x), bf_lo(w.y), bf_hi(w.y)}; s += (v[j].x + v[j].y) + (v[j].z + v[j].w); }
            const float mean = wave_sum(s) * (1.f / DM); float s2 = 0.f;
#pragma unroll
            for (int j = 0; j < 8; ++j) { v[j] = v[j] - mean; s2 += (v[j].x * v[j].x + v[j].y * v[j].y) + (v[j].z * v[j].z + v[j].w * v[j].w); }
            const float rstd = 1.f / sqrtf(wave_sum(s2) * (1.f / DM) + LN_EPS);
            if (lane == 0) { rstat[2 * rl] = mean; rstat[2 * rl + 1] = rstd; }
            GAS unsigned* ob = (GAS unsigned*)((unsigned char*)H1B + (size_t)r * DM) + lane;
#pragma unroll
            for (int j = 0; j < 8; ++j) { const f32x4 gg = *(const f32x4*)(g + 4 * lane + 256 * j), bb = *(const f32x4*)(bt + 4 * lane + 256 * j); const f32x4 y = v[j] * rstd * gg + bb;
                ob[64 * j] = pk4_fp8(y.x, y.y, y.z, y.w); }
        }
        __syncthreads();
        int e0 = 0, e1 = 0, p0 = 0, p1 = 0; float w0 = 0.f, w1 = 0.f;
        if (tid < 64) {
            const LAS float* L = lg + tid * 48; const float mean = rstat[2 * tid], rstd = rstat[2 * tid + 1];
#define LOGIT(col) (rstd * ((L[col] + L[64 * 48 + (col)]) - mean * RC[col]) + RC[48 + (col)])
            float c[4]; int grp = 0; float cm;
#pragma unroll
            for (int i = 0; i < 4; ++i) c[i] = LOGIT(i);
            cm = c[0];
#pragma unroll
            for (int i = 1; i < 4; ++i) if (c[i] > cm) { cm = c[i]; grp = i; }
            float den = 0.f;
#pragma unroll
            for (int i = 0; i < 4; ++i) den += expf(c[i] - cm);
            const float pg = 1.f / den;
            float f[8];
#pragma unroll
            for (int i = 0; i < 8; ++i) f[i] = LOGIT(4 + grp * 8 + i);
#undef LOGIT
            int i0 = 0; float f0 = f[0];
#pragma unroll
            for (int i = 1; i < 8; ++i) if (f[i] > f0) { f0 = f[i]; i0 = i; }
            int i1 = -1; float f1 = -3.0e38f;
#pragma unroll
            for (int i = 0; i < 8; ++i) if (i != i0 && f[i] > f1) { f1 = f[i]; i1 = i; }
            const float q0 = 1.f / (1.f + expf(f1 - f0));
            w0 = pg * q0; w1 = pg * (1.f - q0); e0 = grp * 8 + i0; e1 = grp * 8 + i1;
            p0 = __hip_atomic_fetch_add(lcnt + e0, 1, __ATOMIC_RELAXED, __HIP_MEMORY_SCOPE_WORKGROUP); p1 = __hip_atomic_fetch_add(lcnt + e1, 1, __ATOMIC_RELAXED, __HIP_MEMORY_SCOPE_WORKGROUP);
        }
        __syncthreads();
        if (tid < 32) { const int n = lcnt[tid]; lbase[tid] = n ? (int)__hip_atomic_fetch_add(ctl + CW_ECNT + 64 * tid, (unsigned)n, RLX_AGENT) : 0; }
        __syncthreads();
        if (tid < 64) { const int tok = r0 + tid; const int q0 = lbase[e0] + p0, q1 = lbase[e1] + p1;
            ETOK[e0 * ELIST + q0] = tok * 2; EW[e0 * ELIST + q0] = w0; ETOK[e1 * ELIST + q1] = tok * 2 + 1; EW[e1 * ELIST + q1] = w1; }
        __syncthreads();
    }
}
__device__ __forceinline__ int expert_tables(const Args& a, LAS unsigned char* lds, int tid) {
    LAS int* cnt = (LAS int*)(lds + L_CNT); LAS int* off = (LAS int*)(lds + L_OFF); LAS int* rbx = (LAS int*)(lds + L_RBX);
    gu32* ctl = (gu32*)(a.ws + WS_CTL);
    __syncthreads();
    if (tid < 32) cnt[tid] = (int)__hip_atomic_load(ctl + CW_ECNT + 64 * tid, RLX_AGENT);
    __syncthreads();
    if (tid == 0) { int o = 0; for (int e = 0; e < 32; ++e) { off[e] = o; const int nb = (cnt[e] + 255) >> 8; for (int k = 0; k < nb; ++k) rbx[(o >> 8) + k] = e; o += nb << 8; } off[32] = o; }
    __syncthreads();
    return off[32];
}
__device__ __forceinline__ void p12_final(const Args& a, int gw, int NGW, int lane) {
    const bf16* PRE = (const bf16*)(a.ws + WS_PRE1); const bf16* Y = (const bf16*)(a.ws + WS_Y); const float* g1 = a.in[20]; const float* b1 = a.in[21]; const float* g = a.in[29]; const float* bt = a.in[30];
#if defined(CHECK_ATTN)
    const bool bad = __hip_atomic_load((gu32*)(a.ws + WS_CTL) + 12, RLX_AGENT) != 0u;
#endif
    for (int r = gw; r < NTOK; r += NGW) {
        const GAS u32x2* xr = (const GAS u32x2*)(PRE + (size_t)r * DM) + lane; const GAS u32x2* y0 = (const GAS u32x2*)(Y + (size_t)r * DM) + lane; const GAS u32x2* y1 = (const GAS u32x2*)(Y + ((size_t)NTOK + r) * DM) + lane;
        GAS f32x4* orow = (GAS f32x4*)(a.out + (size_t)r * DM) + lane;
        f32x4 v[8]; u32x2 ya[8], yb[8]; float s = 0.f;
#pragma unroll
        for (int j = 0; j < 8; ++j) { const u32x2 w = xr[64 * j]; v[j] = (f32x4){bf_lo(w.x), bf_hi(w.x), bf_lo(w.y), bf_hi(w.y)}; ya[j] = y0[64 * j]; yb[j] = y1[64 * j]; s += (v[j].x + v[j].y) + (v[j].z + v[j].w); }
        const float mean1 = wave_sum(s) * (1.f / DM); float q = 0.f;
#pragma unroll
        for (int j = 0; j < 8; ++j) { v[j] = v[j] - mean1; q += (v[j].x * v[j].x + v[j].y * v[j].y) + (v[j].z * v[j].z + v[j].w * v[j].w); }
        const float rstd1 = 1.f / sqrtf(wave_sum(q) * (1.f / DM) + LN_EPS) * ALPHA;
        s = 0.f;
#pragma unroll
        for (int j = 0; j < 8; ++j) { const f32x4 gg = *(const f32x4*)(g1 + 4 * lane + 256 * j), bb = *(const f32x4*)(b1 + 4 * lane + 256 * j);
            v[j] = v[j] * rstd1 * gg + bb * ALPHA + (f32x4){bf_lo(ya[j].x), bf_hi(ya[j].x), bf_lo(ya[j].y), bf_hi(ya[j].y)} + (f32x4){bf_lo(yb[j].x), bf_hi(yb[j].x), bf_lo(yb[j].y), bf_hi(yb[j].y)};
            s += (v[j].x + v[j].y) + (v[j].z + v[j].w); }
        const float mean = wave_sum(s) * (1.f / DM); float s2 = 0.f;
#pragma unroll
        for (int j = 0; j < 8; ++j) { v[j] = v[j] - mean; s2 += (v[j].x * v[j].x + v[j].y * v[j].y) + (v[j].z * v[j].z + v[j].w * v[j].w); }
        const float rstd = 1.f / sqrtf(wave_sum(s2) * (1.f / DM) + LN_EPS);
#pragma unroll
        for (int j = 0; j < 8; ++j) { const f32x4 gg = *(const f32x4*)(g + 4 * lane + 256 * j), bb = *(const f32x4*)(bt + 4 * lane + 256 * j); f32x4 ov = v[j] * rstd * gg + bb;
#if defined(CHECK_ATTN)
            if (bad) ov = (f32x4){__builtin_nanf(""), __builtin_nanf(""), __builtin_nanf(""), __builtin_nanf("")};
#endif
            orow[64 * j] = ov; }
    }
}
__device__ __forceinline__ f32x2 cmul(const f32x2 a, const f32x2 b) { return (f32x2){a.x * b.x - a.y * b.y, a.x * b.y + a.y * b.x}; }
template <int DIR> __device__ __forceinline__ void dft4(f32x2& a0, f32x2& a1, f32x2& a2, f32x2& a3) {
    const f32x2 t0 = a0 + a2, t1 = a0 - a2, t2 = a1 + a3, t3 = a1 - a3;
    a0 = t0 + t2; a2 = t0 - t2;
    if (DIR < 0) { a1 = (f32x2){t1.x + t3.y, t1.y - t3.x}; a3 = (f32x2){t1.x - t3.y, t1.y + t3.x}; }
    else         { a1 = (f32x2){t1.x - t3.y, t1.y + t3.x}; a3 = (f32x2){t1.x + t3.y, t1.y - t3.x}; }
}
template <int DIR> __device__ __forceinline__ void fft16(f32x2 (&v)[16], f32x2 (&o)[16]) {
    constexpr float C[10] = {1.f, 0.92387953251128674f, 0.70710678118654752f, 0.38268343236508977f, 0.f, -0.38268343236508977f, -0.70710678118654752f, -0.92387953251128674f, -1.f, -0.92387953251128674f};
    constexpr float S[10] = {0.f, 0.38268343236508977f, 0.70710678118654752f, 0.92387953251128674f, 1.f, 0.92387953251128674f, 0.70710678118654752f, 0.38268343236508977f, 0.f, -0.38268343236508977f};
#pragma unroll
    for (int j0 = 0; j0 < 4; ++j0) dft4<DIR>(v[j0], v[j0 + 4], v[j0 + 8], v[j0 + 12]);
#pragma unroll
    for (int j0 = 1; j0 < 4; ++j0)
#pragma unroll
        for (int k1 = 1; k1 < 4; ++k1) { const int m = j0 * k1; v[j0 + 4 * k1] = cmul(v[j0 + 4 * k1], (f32x2){C[m], (float)DIR * S[m]}); }
#pragma unroll
    for (int k1 = 0; k1 < 4; ++k1) dft4<DIR>(v[4 * k1], v[4 * k1 + 1], v[4 * k1 + 2], v[4 * k1 + 3]);
#pragma unroll
    for (int k1 = 0; k1 < 4; ++k1)
#pragma unroll
        for (int k2 = 0; k2 < 4; ++k2) o[k1 + 4 * k2] = v[4 * k1 + k2];
}
template <int DIR> __device__ __forceinline__ void tw_apply(f32x2 (&v)[16], float frac2) {
    const float s = __builtin_amdgcn_sinf(frac2 * 0.5f), c = __builtin_amdgcn_cosf(frac2 * 0.5f);
    const f32x2 w1 = (f32x2){c, (float)DIR * s};
    const f32x2 w2 = cmul(w1, w1), w3 = cmul(w2, w1), w4 = cmul(w2, w2);
    v[1] = cmul(v[1], w1); v[2] = cmul(v[2], w2); v[3] = cmul(v[3], w3); v[4] = cmul(v[4], w4);
    const f32x2 w5 = cmul(w4, w1), w6 = cmul(w3, w3), w7 = cmul(w4, w3), w8 = cmul(w4, w4);
    v[5] = cmul(v[5], w5); v[6] = cmul(v[6], w6); v[7] = cmul(v[7], w7); v[8] = cmul(v[8], w8);
    v[9] = cmul(v[9], cmul(w8, w1)); v[10] = cmul(v[10], cmul(w5, w5)); v[11] = cmul(v[11], cmul(w8, w3)); v[12] = cmul(v[12], cmul(w6, w6));
    v[13] = cmul(v[13], cmul(w8, w5)); v[14] = cmul(v[14], cmul(w7, w7)); v[15] = cmul(v[15], cmul(w8, w7));
}
__device__ __forceinline__ float dpp_x1(float v) { return __int_as_float(__builtin_amdgcn_update_dpp(0, __float_as_int(v), 0xB1, 0xF, 0xF, true)); }
__device__ __forceinline__ float dpp_x2(float v) { return __int_as_float(__builtin_amdgcn_update_dpp(0, __float_as_int(v), 0x4E, 0xF, 0xF, true)); }
__device__ __forceinline__ void quad_fwd(f32x2& v, int b) {
    const bool hi = (b & 2) != 0, odd = (b & 1) != 0; const float s2 = hi ? -1.f : 1.f, sg = odd ? -1.f : 1.f;
    const f32x2 p = (f32x2){dpp_x2(v.x), dpp_x2(v.y)};
    const f32x2 t = (f32x2){p.x + s2 * v.x, p.y + s2 * v.y};
    const f32x2 q = (f32x2){dpp_x1(t.x), dpp_x1(t.y)};
    const f32x2 base = odd ? q : t, oth = odd ? t : q;
    const float ax = sg * (hi ? oth.y : oth.x), ay = (hi ? -sg : sg) * (hi ? oth.x : oth.y);
    v = (f32x2){base.x + ax, base.y + ay};
}
__device__ __forceinline__ void quad_inv(f32x2& v, int b) {
    const bool hi = (b & 2) != 0, odd = (b & 1) != 0; const float s2 = hi ? -1.f : 1.f;
    const f32x2 q = (f32x2){dpp_x1(v.x), dpp_x1(v.y)};
    const f32x2 sm = v + q, d = q - v;
    const f32x2 o = odd ? (hi ? (f32x2){-d.y, d.x} : d) : sm;
    const f32x2 p = (f32x2){dpp_x2(o.x), dpp_x2(o.y)};
    v = (f32x2){p.x + s2 * o.x, p.y + s2 * o.y};
}
__device__ __forceinline__ int padi(int i) { return i + ((i >> 6) << 2); }
__device__ __forceinline__ void fft_fwd_tail(LAS f32x2* L, int tid, f32x2 (&R)[2][16]) {
    asm volatile("v_mov_b32 %0, %1" : "=v"(tid) : "v"(tid));
#pragma unroll 1
    for (int h = 0; h < 2; ++h) { const int beta = tid + 512 * h, k1 = beta >> 6, b = beta & 63; f32x2 v[16], o[16];
#pragma unroll
        for (int j = 0; j < 16; ++j) v[j] = L[padi(k1 * 1024 + b + 64 * j)];
        fft16<-1>(v, o); tw_apply<-1>(o, (float)b * (1.f / 512.f));
#pragma unroll
        for (int k = 0; k < 16; ++k) L[padi(k1 * 1024 + b + 64 * k)] = o[k]; }
    __syncthreads();
#pragma unroll
    for (int h = 0; h < 2; ++h) { const int beta = tid + 512 * h, q = beta >> 2, b = beta & 3; f32x2 v[16];
#pragma unroll
        for (int j = 0; j < 16; ++j) v[j] = L[padi(64 * q + b + 4 * j)];
        fft16<-1>(v, R[h]); tw_apply<-1>(R[h], (float)b * (1.f / 32.f));
#pragma unroll
        for (int k = 0; k < 16; ++k) quad_fwd(R[h][k], b);
        __builtin_amdgcn_sched_barrier(0); }
}
__device__ __forceinline__ void p4_conv_fft(const Args& a, LAS unsigned char* lds, int vcu, int G, int tid_) {
    const float* KT = (const float*)(a.ws + WS_KT); float* ZT = (float*)(a.ws + WS_ZT); const float* dbias = a.in[16];
    LAS f32x2* L = (LAS f32x2*)lds;
    LAS float* red = (LAS float*)(lds + 139264);
    f32x2* KRa = (f32x2*)(a.ws + WS_KR) + (size_t)blockIdx.x * 16384;
    f32x2* KRb = (f32x2*)(a.ws + WS_WIN) + (size_t)blockIdx.x * 16384;
    const int lane = tid_ & 63, wave = tid_ >> 6;
    for (int pc = vcu; pc < HW; pc += 2 * G) {
        const int chA = pc, chB = pc + G; const bool hasB = chB < HW;
        const float* kpa = KT + (size_t)chA * 16384; const float* kpb = KT + (size_t)(hasB ? chB : chA) * 16384;
        int tid; asm volatile("v_mov_b32 %0, %1" : "=v"(tid) : "v"(tid_));
        f32x2 R[2][16];
        float ssa = 0.f, ssb = 0.f;
#pragma unroll 1
        for (int h = 0; h < 2; ++h) { const int beta = tid + 512 * h; f32x2 v[16], o[16];
#pragma unroll
            for (int j = 0; j < 16; ++j) { const float xa = kpa[beta + 1024 * j]; float xb = kpb[beta + 1024 * j]; xb = hasB ? xb : 0.f; ssa += xa * xa; ssb += xb * xb; v[j] = (f32x2){xa, xb}; }
            fft16<-1>(v, o); tw_apply<-1>(o, (float)beta * (1.f / 8192.f));
#pragma unroll
            for (int k = 0; k < 16; ++k) L[padi(beta + 1024 * k)] = o[k]; }
        ssa = wave_sum(ssa); ssb = wave_sum(ssb); if (lane == 0) { red[wave] = ssa; red[8 + wave] = ssb; }
        __syncthreads();
        fft_fwd_tail(L, tid, R);
        __syncthreads();
        asm volatile("v_mov_b32 %0, %1" : "=v"(tid) : "v"(tid_));
#pragma unroll
        for (int h = 0; h < 2; ++h) { const int beta = tid + 512 * h, q = beta >> 2, bp = beta & 3, rev = ((bp & 1) << 1) | (bp >> 1), s0 = rev + 4 * (q & 15) + 64 * (q >> 4);
#pragma unroll
            for (int k = 0; k < 16; ++k) L[s0 + 1024 * k] = R[h][k]; }
        __syncthreads();
        { float ta = 0.f, tb = 0.f;
#pragma unroll
          for (int w = 0; w < 8; ++w) { ta += red[w]; tb += red[8 + w]; }
          const float sA = rsqrtf(ta + FILTER_EPS) * (0.5f / 16384.f), dA = dbias[chA] * (1.f / 16384.f);
          const float sB = rsqrtf(tb + FILTER_EPS) * (0.5f / 16384.f), dB = dbias[hasB ? chB : chA] * (1.f / 16384.f);
#pragma unroll
          for (int h = 0; h < 2; ++h) { const int beta = tid + 512 * h, q = beta >> 2, bp = beta & 3, rev = ((bp & 1) << 1) | (bp >> 1), f0 = (q >> 4) + 16 * (q & 15) + 4096 * rev;
#pragma unroll
              for (int k = 0; k < 16; ++k) { const int g = (16384 - (f0 + 256 * k)) & 16383, sg = ((g >> 12) & 3) | (((g >> 4) & 15) << 2) | ((g & 15) << 6) | (((g >> 8) & 15) << 10);
                  const f32x2 Q = L[sg], P = R[h][k];
                  KRa[(h * 16 + k) * 512 + tid] = (f32x2){(P.x + Q.x) * sA + dA, (P.y - Q.y) * sA};
                  KRb[(h * 16 + k) * 512 + tid] = (f32x2){(P.y + Q.y) * sB + dB, (Q.x - P.x) * sB}; } } }
        __syncthreads();
#pragma unroll 1
        for (int sel = 0; sel < (hasB ? 2 : 1); ++sel) {
        const int ch = sel ? chB : chA; const f32x2* KRg = sel ? KRb : KRa;
        float* z0 = ZT + (size_t)ch * 16384; float* z1 = z0 + SEQ;
        asm volatile("v_mov_b32 %0, %1" : "=v"(tid) : "v"(tid_));
#pragma unroll 1
        for (int h = 0; h < 2; ++h) { const int beta = tid + 512 * h; f32x2 v[16], o[16];
#pragma unroll
            for (int j = 0; j < 8; ++j) v[j] = (f32x2){z0[beta + 1024 * j], z1[beta + 1024 * j]};
#pragma unroll
            for (int j = 8; j < 16; ++j) v[j] = (f32x2){0.f, 0.f};
            fft16<-1>(v, o); tw_apply<-1>(o, (float)beta * (1.f / 8192.f));
#pragma unroll
            for (int k = 0; k < 16; ++k) L[padi(beta + 1024 * k)] = o[k]; }
        __syncthreads();
        fft_fwd_tail(L, tid, R);
        asm volatile("v_mov_b32 %0, %1" : "=v"(tid) : "v"(tid_));
#pragma unroll
        for (int h = 0; h < 2; ++h) { const int beta = tid + 512 * h, q = beta >> 2, b = beta & 3; f32x2 o[16];
#pragma unroll
            for (int k = 0; k < 16; ++k) { R[h][k] = cmul(R[h][k], KRg[(h * 16 + k) * 512 + tid]); quad_inv(R[h][k], b); }
            tw_apply<1>(R[h], (float)b * (1.f / 32.f)); fft16<1>(R[h], o);
#pragma unroll
            for (int j = 0; j < 16; ++j) L[padi(64 * q + b + 4 * j)] = o[j];
            __builtin_amdgcn_sched_barrier(0); }
        __syncthreads();
        asm volatile("v_mov_b32 %0, %1" : "=v"(tid) : "v"(tid_));
#pragma unroll 1
        for (int h = 0; h < 2; ++h) { const int beta = tid + 512 * h, k1 = beta >> 6, b = beta & 63; f32x2 v[16], o[16];
#pragma unroll
            for (int k = 0; k < 16; ++k) v[k] = L[padi(k1 * 1024 + b + 64 * k)];
            tw_apply<1>(v, (float)b * (1.f / 512.f)); fft16<1>(v, o);
#pragma unroll
            for (int j = 0; j < 16; ++j) L[padi(k1 * 1024 + b + 64 * j)] = o[j]; }
        __syncthreads();
        asm volatile("v_mov_b32 %0, %1" : "=v"(tid) : "v"(tid_));
#pragma unroll 1
        for (int h = 0; h < 2; ++h) { const int beta = tid + 512 * h; f32x2 v[16], o[16];
#pragma unroll
            for (int k = 0; k < 16; ++k) v[k] = L[padi(beta + 1024 * k)];
            tw_apply<1>(v, (float)beta * (1.f / 8192.f)); fft16<1>(v, o);
#pragma unroll
            for (int j = 0; j < 8; ++j) { z0[beta + 1024 * j] = o[j].x; z1[beta + 1024 * j] = o[j].y; } }
        __syncthreads();
        }
    }
}
#ifndef MK_ONE_LAUNCH
#define MK_ONE_LAUNCH 1
#endif
constexpr int N_PHASES = 11;
#if defined(BREAK_MERGE)
constexpr float MERGE_MSCALE = 1.f / 64.f;
#else
constexpr float MERGE_MSCALE = 1.f / 256.f;
#endif
__global__ void __launch_bounds__(NWAVES * 64, 2) fwd(Args args) {
    extern __shared__ __attribute__((aligned(16))) unsigned char lds_raw[];
    LAS unsigned char* lds = (LAS unsigned char*)lds_raw;
    const int tid = threadIdx.x, lane = tid & 63, wave = __builtin_amdgcn_readfirstlane(tid >> 6);
    const int G = gridDim.x, bx = blockIdx.x, vcu = (G % 8 == 0) ? (bx % 8) * (G / 8) + bx / 8 : bx;
    const int gw = vcu * NWAVES + wave, NGW = G * NWAVES;
    unsigned char* ws = args.ws;
    gu32* ctl = (gu32*)(ws + WS_CTL);
    for (int u = tid; u < (LDS_BYTES - LDSCTL_OFF) / 4; u += NWAVES * 64) ((LAS unsigned*)(lds + LDSCTL_OFF))[u] = 0u;
    __syncthreads();
    XcdBarrier bar; bar.bar = (unsigned*)(ctl + CW_BAR); bar.x = 0; bar.st = nullptr;
    if (MK_ONE_LAUNCH) bar = xcd_barrier_post((unsigned*)(ctl + CW_BAR), (volatile LAS unsigned*)(lds + L_MISC) + 8);
    const int lo = args.ph_lo, hi = args.ph_hi;
#ifndef PHMASK
#define PHMASK 0xFFFF
#endif
#define IN(k) (((PHMASK >> (k)) & 1) && lo <= (k) && (k) < hi)
#ifndef PROBE_DUP
#define PROBE_DUP -1
#endif
#ifndef PROBE_MASK
#define PROBE_MASK 0
#endif
#define REP(k) for (int rep_ = 0; rep_ < ((PROBE_DUP == (k) || ((PROBE_MASK >> (k)) & 1)) ? 2 : 1); ++rep_)
#define SEAM(k) do { if (MK_ONE_LAUNCH && IN(k) && IN((k) + 1)) xcd_barrier(bar); } while (0)

    bf16* PROJ = (bf16*)(ws + WS_PROJ);
#if defined(LEAK_A)
    LAS unsigned long long* tst = (LAS unsigned long long*)(lds + LDSCTL_OFF + 1536);
    int n_st = 0;
#define STAMP() do { if (bx == 0 && tid == 0) tst[n_st] = __builtin_amdgcn_s_memrealtime(); ++n_st; } while (0)
    STAMP();
#else
#define STAMP() do { } while (0)
#endif
    if (IN(0)) REP(0) { p0_prologue(args, lds, gw, NGW, wave, lane); __syncthreads(); }
    SEAM(0); STAMP();
    if (IN(1)) {
        {
            pg8::Gemm g{(const bf16*)(ws + WS_XN), (const bf16*)(ws + WS_WIN), NTOK, 3 * HW, DM}; pg8::StaticOrder S; S.init(NTOK, 3 * HW, G, bx);
            pg8::EpiProj E{PROJ + COL_HY, INW, args.in[4], 1 << 30};
            pg8::gemm_phase<pg8::EpiProj, pg8::StaticOrder, true, true>(lds, g, S, E);
        }
        {
            pg8::Gemm g{(const bf16*)(ws + WS_XN8), (const bf16*)(ws + WS_WIN8), NTOK, 22 * 256, DM / 2};
            pg8::GateOrder S; S.base.init(NTOK, 22 * 256, G, bx); S.G = G; S.c = bx; S.split = 0;
            pg8::EpiGate8 E{PROJ, INW, args.in[4], COL_G};
            pg8::gemm_phase<pg8::EpiGate8, pg8::GateOrder, true, true, false, false, true>(lds, g, S, E);
        }
        __syncthreads(); p2_filter(args, lds, bx, G, tid);
    }
    SEAM(1); STAMP();
    if (IN(2)) { p2_qk(args, gw, NGW, lane); p2_vt8(args, lds, vcu, G, tid); REP(2) { p2_conv(args, lds, vcu, G, tid); } }
    SEAM(2); STAMP();
    if (IN(3)) {
        const int grp = bx % 3;
#define CONV_SLOT(s) do { if (grp == (s)) { for (int rp_ = 0; rp_ < ((PROBE_DUP == 33) ? 2 : 1); ++rp_) { conv_items(args, lds, W_IN, NWITEMS, vcu, G, threadIdx.x); __syncthreads(); conv_items_fp8(args, lds, 0, NW8, vcu, G, threadIdx.x); __syncthreads(); conv_items_fp8(args, lds, NW8 + W8_IN, NW8 + W8_IN + W8_AO, vcu, G, threadIdx.x); __syncthreads(); } } } while (0)
#define ATTN_UNIT(uu) do { const int u = (uu); if (u < BATCH * 8 * 32) { \
            int b = u >> 8, x = u & 255, kvh = (x & 7) >> 2, within = (x & 3) + 4 * (x >> 3); \
            if (G == 256) { const int c_ = x & 7, j_ = (x >> 3) + 32 * (u >> 8);     \
                b = c_ >> 2; kvh = (c_ >> 1) & 1; within = j_ + 64 * (c_ & 1); } \
            const int hq = kvh * 4 + (within >> 5), qb = within & 31; \
            const bf16* Qb = PROJ + (size_t)(b * SEQ + qb * 256) * INW + COL_Q + hq * 128; \
            const unsigned char* Kh = (const unsigned char*)(ws + WS_KC) + (size_t)(b * 2 + kvh) * SEQ * 128; \
            const unsigned char* Vh = (const unsigned char*)(ws + WS_VC) + (size_t)(b * 2 + kvh) * SEQ * 128; \
            unsigned char* Ob = (unsigned char*)(ws + WS_ACAT) + (size_t)(b * SEQ + qb * 256) * 3072 + hq * 128; \
            attn::attn_dense_body(Qb, Kh, Vh, Ob, SEQ, (char*)lds_raw); } } while (0)
#if PROBE_DUP == 34
        CONV_SLOT(0); ATTN_UNIT(bx); ATTN_UNIT(bx); CONV_SLOT(1); ATTN_UNIT(bx + G); ATTN_UNIT(bx + G); CONV_SLOT(2);
#else
        CONV_SLOT(0); ATTN_UNIT(bx); CONV_SLOT(1); ATTN_UNIT(bx + G); CONV_SLOT(2);
#endif
        for (int u2 = bx + 2 * G; u2 < BATCH * 8 * 32; u2 += G) ATTN_UNIT(u2);
#undef CONV_SLOT
#undef ATTN_UNIT
        p4_conv_fft(args, lds, vcu, G, tid);
    }
    SEAM(3); STAMP();
    if (IN(4)) {
#if defined(CHECK_ATTN)
        check_attn(args, gw, NGW, lane);
#endif
        p5_ah(args, lds, vcu, G, tid); }
    SEAM(4); STAMP();
    if (IN(5)) {
        pg8::Gemm g{(const bf16*)(ws + WS_ACAT), (const bf16*)(ws + WS_WCAT), NTOK, DM, 1536}; pg8::StaticOrder S; S.init(NTOK, DM, G, bx);
        pg8::EpiMerge E{PROJ + COL_G, PROJ + COL_G + DM, INW, (bf16*)(ws + WS_MRG), DM, MERGE_MSCALE};
        pg8::gemm_phase<pg8::EpiMerge, pg8::StaticOrder, true, true, false, true, false, 8>(lds, g, S, E);
    }
    SEAM(5); STAMP();
    if (IN(6)) REP(6) {
#if defined(CHECK_ATTN)
        check_merge(args, gw, NGW, lane);
#endif
        pg8::Gemm g{(const bf16*)(ws + WS_MRG), (const bf16*)(ws + WS_WOUT), NTOK, DM, DM}; pg8::StaticOrder S; S.init(NTOK, DM, G, bx);
        pg8::EpiPre1 E{(const bf16*)args.out, (bf16*)(ws + WS_PRE1), DM};
        pg8::gemm_phase<pg8::EpiPre1, pg8::StaticOrder, true, true>(lds, g, S, E);
    }
    SEAM(6); STAMP();
    if (IN(7)) { p8_ln_route(args, lds, vcu, G, tid); }
    SEAM(7); STAMP();
    if (IN(8)) {
        const int total = expert_tables(args, lds, tid);
        pg8::Gemm g{(const bf16*)(ws + WS_H1B), (const bf16*)(ws + WS_WGU), total, NEXP * 2048, DM / 2, (const int*)(ws + WS_ETOK), (const LAS int*)(lds + L_CNT), (const LAS int*)(lds + L_OFF), ELIST};
        pg8::ExpertOrder S{(const LAS int*)(lds + L_RBX), total >> 8, G, bx, (PROBE_DUP == 8) ? 2 : 1};
        pg8::EpiSwiglu E{(unsigned char*)(ws + WS_HB), DEXP};
        pg8::gemm_phase<pg8::EpiSwiglu, pg8::ExpertOrder, true, true, true, false, true>(lds, g, S, E);
    }
    SEAM(8); STAMP();
    if (IN(9)) {
        const int total = expert_tables(args, lds, tid);
        pg8::Gemm g{(const bf16*)(ws + WS_HB), (const bf16*)(ws + WS_WD), total, NEXP * 2048, DEXP / 2};
        pg8::ExpertOrder S{(const LAS int*)(lds + L_RBX), total >> 8, G, bx, (PROBE_DUP == 9) ? 2 : 1};
        pg8::EpiDown E{(const int*)(ws + WS_ETOK), (const float*)(ws + WS_EW), (const LAS int*)(lds + L_CNT), (const LAS int*)(lds + L_OFF), ELIST, (bf16*)(ws + WS_Y), DM, NTOK};
        pg8::gemm_phase<pg8::EpiDown, pg8::ExpertOrder, true, true, false, false, true>(lds, g, S, E);
    }
    SEAM(9); STAMP();
    if (IN(10)) { p12_final(args, gw, NGW, lane); }
#if defined(LEAK_A)
    xcd_barrier(bar); STAMP();
    if (bx == 0 && tid == 0) { const unsigned dA = (unsigned)(tst[LEAK_A + 1] - tst[LEAK_A]), dB = (unsigned)(tst[LEAK_B + 1] - tst[LEAK_B]);
        __hip_atomic_store(ctl + 8, dA / 1000u, RLX_AGENT); __hip_atomic_store(ctl + 9, dB / 1000u, RLX_AGENT); }
    xcd_barrier(bar);
    { unsigned v1 = __hip_atomic_load(ctl + 8, RLX_AGENT), v2 = __hip_atomic_load(ctl + 9, RLX_AGENT); if (v1 > 99u) v1 = 99u; if (v2 > 99u) v2 = 99u;
      const int nz = (int)v1 * 160;
      for (int r = gw; r < nz; r += NGW) { GAS f32x4* o = (GAS f32x4*)(args.out + (size_t)r * DM) + lane;
#pragma unroll
          for (int j = 0; j < 8; ++j) o[64 * j] = (f32x4){0.f, 0.f, 0.f, 0.f}; }
      if (bx == 0 && tid == 0) args.out[(size_t)NTOK * DM - 1] = 100.f + 10.f * (float)v2; }
#endif
#undef IN
#undef SEAM
}

extern "C" void kernel_launch(void* const* d_in, const int* in_sizes, int n_in, void* d_out, int out_size, void* d_ws, size_t ws_size, hipStream_t stream) {
    static int grid = 0;
    if (grid == 0) {
        if (n_in != 31 || out_size != NTOK * DM || ws_size < WS_END) { fprintf(stderr, "kernel_launch: unexpected shapes: n_in %d out %d ws %zu (need >= %zu)\n", n_in, out_size, ws_size, (size_t)WS_END); grid = -1; return; }
        int dev = 0, cus = 0, per_cu = 0;
        if (hipGetDevice(&dev) != hipSuccess || hipDeviceGetAttribute(&cus, hipDeviceAttributeMultiprocessorCount, dev) != hipSuccess) { grid = -1; return; }
        if (hipFuncSetAttribute((const void*)fwd, hipFuncAttributeMaxDynamicSharedMemorySize, LDS_BYTES) != hipSuccess) { fprintf(stderr, "kernel_launch: hipFuncSetAttribute failed\n"); grid = -1; return; }
        if (hipOccupancyMaxActiveBlocksPerMultiprocessor(&per_cu, (const void*)fwd, NWAVES * 64, LDS_BYTES) != hipSuccess || per_cu < 1) fprintf(stderr, "kernel_launch: occupancy query reports %d\n", per_cu);
        (void)hipGetLastError();
        grid = cus;
    }
    if (grid < 0) return;
    if (hipMemsetAsync((char*)d_ws + WS_CTL, 0, CTL_ZERO_BYTES, stream) != hipSuccess) return;
    Args a{};
    for (int i = 0; i < 31; ++i) a.in[i] = (const float*)d_in[i];
    a.out = (float*)d_out; a.ws = (unsigned char*)d_ws;
#if MK_ONE_LAUNCH
    a.ph_lo = 0; a.ph_hi = N_PHASES;
    hipLaunchKernelGGL(fwd, dim3(grid), dim3(NWAVES * 64), LDS_BYTES, stream, a);
#else
    for (int p = 0; p < N_PHASES; ++p) { a.ph_lo = p; a.ph_hi = p + 1; hipLaunchKernelGGL(fwd, dim3(grid), dim3(NWAVES * 64), LDS_BYTES, stream, a); }
#endif
    const hipError_t le = hipPeekAtLastError();
    if (le != hipSuccess) fprintf(stderr, "kernel_launch: launch failed: %s\n", hipGetErrorName(le));
}
```

```cpp
#include <hip/hip_runtime.h>
#include <hip/hip_bf16.h>
#include <cstdio>
#include <cstdint>
#include <cmath>
namespace pg8 {
#define PG8_LAS __attribute__((address_space(3)))
typedef unsigned short bf16_t;
typedef short bf16x8 __attribute__((ext_vector_type(8)));
typedef float f32x4 __attribute__((ext_vector_type(4)));
typedef unsigned u32x4 __attribute__((ext_vector_type(4)));
constexpr int BM = 256, BK = 64, HALF = 128, HTB = HALF * BK * 2  , STAGE_BYTES = 8 * HTB, NXCD = 8, WGM = 8;

__host__ __device__ __forceinline__ int lds_byte(int r, int c) { const int st = (r >> 4) * 2 + (c >> 5), rr = r & 15, cc = c & 31, ob = rr * 64 + cc * 2; return st * 1024 + (ob ^ (((ob >> 9) & 1) << 5)); }
__host__ __device__ __forceinline__ void stage_rc(int b, int& R, int& C) { const int st = b / 1024, sb = b % 1024, swz = sb ^ (((sb >> 9) & 1) << 5); R = (st >> 1) * 16 + swz / 64; C = (st & 1) * 32 + (swz % 64) / 2; }
__host__ __device__ __forceinline__ int perm32(int rho) { const int n = rho >> 4, i = rho & 15; return 8 * (i >> 2) + 4 * n + (i & 3); }

struct Unit { int pm, pn; };
struct Gemm { const bf16_t* A; const bf16_t* Bt; int M, N, K;
              const int* etok; const PG8_LAS int* gcnt; const PG8_LAS int* goff; int elist; };

struct StaticOrder {
    int nM, nN, nwg, G, c;
    __host__ __device__ void init(int M, int N, int G_, int c_) { nM = M / BM; nN = N / BM; nwg = nM * nN; G = G_; c = c_; }
    __host__ __device__ bool next(int i, Unit& u) const {
        const long L = (long)i * G + c; if (L >= nwg) return false;
        int wgid = (int)L; { const int q = nwg / NXCD, r = nwg % NXCD, xcd = wgid % NXCD, off = wgid / NXCD; wgid = (xcd < r ? xcd * (q + 1) : r * (q + 1) + (xcd - r) * q) + off; }
        const int nig = WGM * nN, gid = wgid / nig, fm = gid * WGM, gsz = (nM - fm) < WGM ? (nM - fm) : WGM;
        u.pm = fm + ((wgid % nig) % gsz); u.pn = (wgid % nig) / gsz; return true;
    }
    __device__ __forceinline__ void a_ready(const Unit&) const {}
    __device__ __forceinline__ void done(const Unit&) const {}
};

__device__ __forceinline__ unsigned cvt_pk_bf16(float lo, float hi) { unsigned r; asm volatile("v_cvt_pk_bf16_f32 %0, %1, %2" : "=v"(r) : "v"(lo), "v"(hi)); return r; }
__device__ __forceinline__ float bflo(unsigned w) { return __uint_as_float(w << 16); }
__device__ __forceinline__ float bfhi(unsigned w) { return __uint_as_float(w & 0xffff0000u); }
__device__ __forceinline__ float sigm(float x) { return 1.f / (1.f + __expf(-x)); }
__device__ __forceinline__ u32x4 pack8(const f32x4 v0, const f32x4 v1) { u32x4 w; w.x = cvt_pk_bf16(v0[0], v0[1]); w.y = cvt_pk_bf16(v0[2], v0[3]); w.z = cvt_pk_bf16(v1[0], v1[1]); w.w = cvt_pk_bf16(v1[2], v1[3]); return w; }
__device__ __forceinline__ void unpack8(const u32x4 w, f32x4& v0, f32x4& v1) { v0 = (f32x4){bflo(w.x), bfhi(w.x), bflo(w.y), bfhi(w.y)}; v1 = (f32x4){bflo(w.z), bfhi(w.z), bflo(w.w), bfhi(w.w)}; }

struct EpiProj {
    static constexpr bool PERM = true, AFTER_DRAIN = false;
    bf16_t* O; int ldc; const float* bgate; int gate_pn0;
    __device__ __forceinline__ void operator()(const f32x4 (&acc)[2][2][4][2], const Unit& u, int wr, int wc, int fr, int fq) const {
        const int row0 = u.pm * BM + wr * 64 + fr, col0 = u.pn * BM + wc * 32 + 8 * fq;
        const bool gate = u.pn >= gate_pn0;
        f32x4 bv[2][2];
#pragma unroll
        for (int bj = 0; bj < 2; ++bj)
#pragma unroll
            for (int n = 0; n < 2; ++n) bv[bj][n] = gate ? *(const f32x4*)(bgate + (col0 - gate_pn0 * BM) + bj * HALF + 4 * n) : (f32x4){0.f, 0.f, 0.f, 0.f};
#pragma unroll
        for (int ai = 0; ai < 2; ++ai)
#pragma unroll
            for (int m = 0; m < 4; ++m) { bf16_t* rowp = O + (size_t)(row0 + ai * HALF + m * 16) * ldc + col0;
#pragma unroll
                for (int bj = 0; bj < 2; ++bj) { f32x4 v0 = acc[ai][bj][m][0] + bv[bj][0], v1 = acc[ai][bj][m][1] + bv[bj][1];
                    if (gate) {
#pragma unroll
                        for (int e = 0; e < 4; ++e) { v0[e] = sigm(v0[e]); v1[e] = sigm(v1[e]); } }
                    *(u32x4*)(rowp + bj * HALF) = pack8(v0, v1); } }
    }
};
struct EpiGate8 {
    static constexpr bool PERM = true, AFTER_DRAIN = false;
    bf16_t* O; int ldc; const float* bgate; int gate_col0;
    __device__ __forceinline__ void operator()(const f32x4 (&acc)[2][2][4][2], const Unit& u, int wr, int wc, int fr, int fq) const {
        const bool gate = u.pn >= 6;
        const int row0 = u.pm * BM + wr * 64 + fr, cl = wc * 32 + 8 * fq, col0 = (gate ? gate_col0 + (u.pn - 6) * BM : u.pn * BM) + cl, bcol = (gate ? (u.pn - 6) * BM : 0) + cl;
        f32x4 bv[2][2];
#pragma unroll
        for (int bj = 0; bj < 2; ++bj)
#pragma unroll
            for (int n = 0; n < 2; ++n) bv[bj][n] = gate ? *(const f32x4*)(bgate + bcol + bj * HALF + 4 * n) : (f32x4){0.f, 0.f, 0.f, 0.f};
#pragma unroll
        for (int ai = 0; ai < 2; ++ai)
#pragma unroll
            for (int m = 0; m < 4; ++m) { bf16_t* rowp = O + (size_t)(row0 + ai * HALF + m * 16) * ldc + col0;
#pragma unroll
                for (int bj = 0; bj < 2; ++bj) { f32x4 v0 = acc[ai][bj][m][0] * (1.f / 256.f) + bv[bj][0], v1 = acc[ai][bj][m][1] * (1.f / 256.f) + bv[bj][1];
                    if (gate) {
#pragma unroll
                        for (int e = 0; e < 4; ++e) { v0[e] = sigm(v0[e]); v1[e] = sigm(v1[e]); } }
                    *(u32x4*)(rowp + bj * HALF) = pack8(v0, v1); } }
    }
};
struct GateOrder {
    StaticOrder base; int G, c, split;
    __device__ __forceinline__ bool next(int i, Unit& u) const {
        int L;
        if (split == 0) { L = i * G + c; if (L >= base.nwg) return false; }
        else if (c < split) { if (i >= 3) return false; L = i * split + c; }
        else { if (i >= 5) return false; L = 3 * split + i * (G - split) + (c - split); }
        StaticOrder t = base; t.G = 1; t.c = L; return t.next(0, u);
    }
    __device__ __forceinline__ void a_ready(const Unit&) const {}
    __device__ __forceinline__ void done(const Unit&) const {}
};
struct EpiMerge {
    static constexpr bool PERM = true, AFTER_DRAIN = false;
    const bf16_t* Ga; const bf16_t* Gh; int ldg; bf16_t* O; int ldc; float mscale;
    __device__ __forceinline__ void mid(f32x4 (&acc)[2][2][4][2], const Unit& u, int wr, int wc, int fr, int fq) const {
        asm volatile("" : "+v"(fr), "+v"(fq));
        const int row0 = u.pm * BM + wr * 64 + fr, col0 = u.pn * BM + wc * 32 + 8 * fq;
#pragma unroll
        for (int ai = 0; ai < 2; ++ai)
#pragma unroll
            for (int m = 0; m < 4; ++m) { const size_t r = (size_t)(row0 + ai * HALF + m * 16);
#pragma unroll
                for (int bj = 0; bj < 2; ++bj) { const u32x4 aw = *(const u32x4*)(Ga + r * ldg + col0 + bj * HALF), hw = *(const u32x4*)(Gh + r * ldg + col0 + bj * HALF);
                    f32x4 a0, a1, h0, h1; unpack8(aw, a0, a1); unpack8(hw, h0, h1);
#pragma unroll
                    for (int e = 0; e < 4; ++e) { acc[ai][bj][m][0][e] *= a0[e] * mscale * __builtin_amdgcn_rcpf(fmaxf(h0[e], 1e-30f)); acc[ai][bj][m][1][e] *= a1[e] * mscale * __builtin_amdgcn_rcpf(fmaxf(h1[e], 1e-30f)); }
                    asm volatile("" : "+v"(acc[ai][bj][m][0]), "+v"(acc[ai][bj][m][1]) :: "memory"); } }
    }
    __device__ __forceinline__ void operator()(const f32x4 (&acc)[2][2][4][2], const Unit& u, int wr, int wc, int fr, int fq) const {
        const int row0 = u.pm * BM + wr * 64 + fr, col0 = u.pn * BM + wc * 32 + 8 * fq;
#pragma unroll
        for (int ai = 0; ai < 2; ++ai)
#pragma unroll
            for (int m = 0; m < 4; ++m) { const size_t r = (size_t)(row0 + ai * HALF + m * 16);
#pragma unroll
                for (int bj = 0; bj < 2; ++bj) { const u32x4 hw = *(const u32x4*)(Gh + r * ldg + col0 + bj * HALF); f32x4 h0, h1; unpack8(hw, h0, h1);
                    *(u32x4*)(O + r * ldc + col0 + bj * HALF) = pack8(acc[ai][bj][m][0] * h0, acc[ai][bj][m][1] * h1); } }
    }
};
struct EpiPre1 {
    static constexpr bool PERM = true, AFTER_DRAIN = false;
    const bf16_t* HA; bf16_t* O; int ldc;
    __device__ __forceinline__ void operator()(const f32x4 (&acc)[2][2][4][2], const Unit& u, int wr, int wc, int fr, int fq) const {
        const int row0 = u.pm * BM + wr * 64 + fr, col0 = u.pn * BM + wc * 32 + 8 * fq;
#pragma unroll
        for (int ai = 0; ai < 2; ++ai)
#pragma unroll
            for (int m = 0; m < 4; ++m) { const size_t r = (size_t)(row0 + ai * HALF + m * 16);
#pragma unroll
                for (int bj = 0; bj < 2; ++bj) { const u32x4 hw = *(const u32x4*)(HA + r * ldc + col0 + bj * HALF); f32x4 h0, h1; unpack8(hw, h0, h1);
                    *(u32x4*)(O + r * ldc + col0 + bj * HALF) = pack8(acc[ai][bj][m][0] + h0, acc[ai][bj][m][1] + h1); } }
    }
};
__device__ __forceinline__ unsigned pk4f8(float a, float b, float c, float d) { int w = 0; w = __builtin_amdgcn_cvt_pk_fp8_f32(a, b, w, false); w = __builtin_amdgcn_cvt_pk_fp8_f32(c, d, w, true); return (unsigned)w; }
struct EpiSwiglu {
    static constexpr bool PERM = true, AFTER_DRAIN = false;
    unsigned char* O; int ldc;
    __device__ __forceinline__ void operator()(const f32x4 (&acc)[2][2][4][2], const Unit& u, int wr, int wc, int fr, int fq) const {
        const int row0 = u.pm * BM + wr * 64 + fr, col0 = (u.pn & 7) * HALF + wc * 32 + 8 * fq; constexpr float S = 1.f / 256.f;
        typedef unsigned u32x2_ __attribute__((ext_vector_type(2)));
#pragma unroll
        for (int ai = 0; ai < 2; ++ai)
#pragma unroll
            for (int m = 0; m < 4; ++m) { f32x4 h[2];
#pragma unroll
                for (int n = 0; n < 2; ++n)
#pragma unroll
                    for (int e = 0; e < 4; ++e) { const float gg = acc[ai][0][m][n][e] * S; h[n][e] = gg * sigm(gg) * (acc[ai][1][m][n][e] * S); }
                *(u32x2_*)(O + (size_t)(row0 + ai * HALF + m * 16) * ldc + col0) = (u32x2_){pk4f8(h[0][0], h[0][1], h[0][2], h[0][3]), pk4f8(h[1][0], h[1][1], h[1][2], h[1][3])}; }
    }
};
struct EpiDown {
    static constexpr bool PERM = true, AFTER_DRAIN = false;
    const int* etok; const float* ew; const PG8_LAS int* cnt; const PG8_LAS int* off; int elist; bf16_t* Y; int ldc; int ntok;
    __device__ __forceinline__ void operator()(const f32x4 (&acc)[2][2][4][2], const Unit& u, int wr, int wc, int fr, int fq) const {
        const int e = u.pn >> 3, c = cnt[e], pos0 = u.pm * BM - off[e] + wr * 64 + fr, col0 = (u.pn & 7) * BM + wc * 32 + 8 * fq;
#pragma unroll
        for (int ai = 0; ai < 2; ++ai)
#pragma unroll
            for (int m = 0; m < 4; ++m) { const int pos = pos0 + ai * HALF + m * 16;
                if (pos < c) { const int ts = etok[e * elist + pos]; const float w = ew[e * elist + pos] * (1.f / 256.f);
                    bf16_t* yp = Y + ((size_t)(ts & 1) * ntok + (size_t)(ts >> 1)) * ldc + col0;
#pragma unroll
                    for (int bj = 0; bj < 2; ++bj) *(u32x4*)(yp + bj * HALF) = pack8(acc[ai][bj][m][0] * w, acc[ai][bj][m][1] * w); } }
    }
};
struct ExpertOrder {
    const PG8_LAS int* rbx; int nrb, G, c, rep;
    __device__ __forceinline__ bool next(int i, Unit& u) const {
        int L = i * G + c; if (L >= nrb * 8 * rep) return false;
        if (L >= nrb * 8) L -= nrb * 8;
        const int rb = L >> 3; u.pm = rb; u.pn = rbx[rb] * 8 + (L & 7); return true;
    }
    __device__ __forceinline__ void a_ready(const Unit&) const {}
    __device__ __forceinline__ void done(const Unit&) const {}
};
typedef int pg8_v4i __attribute__((ext_vector_type(4))); typedef int pg8_v8i __attribute__((ext_vector_type(8)));
template <class Epi, class Sched, bool ALIGN_EPI = false, bool SP2 = false, bool GATHER = false, bool MID = false, bool FP8 = false, int NF8 = 0>
__device__ __forceinline__ void gemm_phase(PG8_LAS unsigned char* lds, const Gemm g, const Sched& S, const Epi& E) {
    const int tid = threadIdx.x, wid = __builtin_amdgcn_readfirstlane(tid >> 6), lane = tid & 63, wr = wid >> 2, wc = wid & 3, fr = lane & 15, fq = lane >> 4;
    const int K = g.K, nt = K / BK;
    unsigned voffA[2], voffB[2]; int RA[2], CA[2];
#pragma unroll
    for (int i = 0; i < 2; ++i) { int R, C; stage_rc(tid * 16 + i * 8192, R, C); const int Rb = Epi::PERM ? ((R & ~31) + perm32(R & 31)) : R; RA[i] = R; CA[i] = C;
        voffA[i] = (unsigned)(R * K + C) * 2u; voffB[i] = (unsigned)(Rb * BK + C) * 2u; }
    const size_t kstep = (size_t)(BK * 2);
    const size_t hstep = (size_t)HALF * K * 2;
    const size_t tstep = 2 * hstep;
    const size_t kstepB = (size_t)BM * BK * 2, hstepB = (size_t)HALF * BK * 2, tstepB = (size_t)(K / BK) * kstepB;
    const unsigned ldsw = (unsigned)wid * 1024u;
    const int aoff = lds_byte(wr * 64 + fr, fq * 8), boff = lds_byte(wc * 32 + fr, fq * 8);
#define PG8_SA(b, h) (((b) * 2 + (h)) * HTB)
#define PG8_SB(b, h) ((4 + (b) * 2 + (h)) * HTB)
#define PG8_STAGE(bufoff, gbase, voff) do { _Pragma("unroll") for (int _i = 0; _i < 2; ++_i) \
        __builtin_amdgcn_global_load_lds((const unsigned*)((const char*)(gbase) + (voff)[_i]), (PG8_LAS unsigned*)(lds + (bufoff) + ldsw + _i * 8192), 16, 0, 0); } while (0)
#define PG8_GVOFF(u, v) do { const int e_ = (u).pn >> 3, c_ = g.gcnt[e_] - 1, bp_ = (u).pm * BM - g.goff[e_]; \
        _Pragma("unroll") for (int h_ = 0; h_ < 2; ++h_) _Pragma("unroll") for (int i_ = 0; i_ < 2; ++i_) { int p_ = bp_ + h_ * HALF + RA[i_]; p_ = p_ < c_ ? p_ : c_; \
            const int tk_ = g.etok[e_ * g.elist + p_] >> 1; (v)[h_][i_] = (unsigned)(tk_ * K + CA[i_]) * 2u; } } while (0)
#define PG8_STAGE_A(bufoff, base, h, nx) do { if constexpr (GATHER) { unsigned vv_[2]; vv_[0] = (nx) ? vAn[h][0] : vAc[h][0]; vv_[1] = (nx) ? vAn[h][1] : vAc[h][1]; PG8_STAGE(bufoff, base, vv_); } \
        else { PG8_STAGE(bufoff, (base) + (h) * hstep, voffA); } } while (0)
#define PG8_LDA(dst, b, h) do { _Pragma("unroll") for (int m = 0; m < 4; ++m) { if (f8_) { const pg8_v4i lo_ = *(const PG8_LAS pg8_v4i*)(lds + PG8_SA(b, h) + aoff + m * 2048), hi_ = *(const PG8_LAS pg8_v4i*)(lds + PG8_SA(b, h) + aoff + m * 2048 + 1024); \
        dst##_8[m] = __builtin_shufflevector(lo_, hi_, 0, 1, 2, 3, 4, 5, 6, 7); } else { _Pragma("unroll") for (int k = 0; k < 2; ++k) dst[m][k] = *(const PG8_LAS bf16x8*)(lds + PG8_SA(b, h) + aoff + m * 2048 + k * 1024); } } } while (0)
#define PG8_LDB(dst, b, h) do { _Pragma("unroll") for (int n = 0; n < 2; ++n) { if (f8_) { const pg8_v4i lo_ = *(const PG8_LAS pg8_v4i*)(lds + PG8_SB(b, h) + boff + n * 2048), hi_ = *(const PG8_LAS pg8_v4i*)(lds + PG8_SB(b, h) + boff + n * 2048 + 1024); \
        dst##_8[n] = __builtin_shufflevector(lo_, hi_, 0, 1, 2, 3, 4, 5, 6, 7); } else { _Pragma("unroll") for (int k = 0; k < 2; ++k) dst[n][k] = *(const PG8_LAS bf16x8*)(lds + PG8_SB(b, h) + boff + n * 2048 + k * 1024); } } } while (0)
#define PG8_MMA(ai, bj, At, Bt) do { __builtin_amdgcn_s_setprio(1); _Pragma("unroll") for (int m = 0; m < 4; ++m) _Pragma("unroll") for (int n = 0; n < 2; ++n) { \
        if (f8_) { asm volatile("v_mfma_f32_16x16x128_f8f6f4 %0, %1, %2, %0" : "+v"(acc[ai][bj][m][n]) : "v"(Bt##_8[n]), "v"(At##_8[m])); } \
        else { _Pragma("unroll") for (int k = 0; k < 2; ++k) acc[ai][bj][m][n] = __builtin_amdgcn_mfma_f32_16x16x32_bf16(Bt[n][k], At[m][k], acc[ai][bj][m][n], 0, 0, 0); } } \
        __builtin_amdgcn_s_setprio(0); } while (0)
#define PG8_WAIT_V(n) asm volatile("s_waitcnt vmcnt(" #n ")" ::: "memory")
#define PG8_WAIT_L(n) asm volatile("s_waitcnt lgkmcnt(" #n ")" ::: "memory")
#define PG8_BAR __builtin_amdgcn_s_barrier()
#define PG8_SCHED __builtin_amdgcn_sched_barrier(0)
    Unit cur, nxt; int ui = 0;
    if (!S.next(0, cur)) return;
    f32x4 acc[2][2][4][2];
#pragma unroll
    for (int a = 0; a < 2; ++a)
#pragma unroll
        for (int b = 0; b < 2; ++b)
#pragma unroll
            for (int m = 0; m < 4; ++m)
#pragma unroll
                for (int n = 0; n < 2; ++n) acc[a][b][m][n] = (f32x4){0.f, 0.f, 0.f, 0.f};
    bf16x8 At[4][2], B0[2][2], B1[2][2]; pg8_v8i At_8[4], B0_8[2], B1_8[2]; const int f8scale = 0x7F7F7F7F;
    unsigned vAc[2][2] = {{0u, 0u}, {0u, 0u}}, vAn[2][2] = {{0u, 0u}, {0u, 0u}};
    if constexpr (GATHER) PG8_GVOFF(cur, vAc);
    const char* cA = (const char*)g.A + (GATHER ? (size_t)0 : (size_t)cur.pm * tstep); const char* cB = (const char*)g.Bt + (size_t)cur.pn * tstepB;
    S.a_ready(cur);
    if constexpr (SP2) {
        PG8_STAGE(PG8_SB(0, 0), cB, voffB); PG8_STAGE(PG8_SB(0, 1), cB + hstepB, voffB); PG8_STAGE_A(PG8_SA(0, 0), cA, 0, false); PG8_STAGE_A(PG8_SA(0, 1), cA, 1, false);
        if (wr == 1) PG8_BAR;
        PG8_WAIT_V(2); PG8_BAR;
        PG8_STAGE(PG8_SB(1, 0), cB + kstepB, voffB); PG8_STAGE_A(PG8_SA(1, 0), cA + kstep, 0, false); PG8_STAGE(PG8_SB(1, 1), cB + hstepB + kstepB, voffB);
        PG8_WAIT_V(6); PG8_BAR;
    } else {
        PG8_STAGE(PG8_SB(0, 0), cB, voffB); PG8_STAGE_A(PG8_SA(0, 0), cA, 0, false); PG8_STAGE(PG8_SB(0, 1), cB + hstepB, voffB); PG8_STAGE_A(PG8_SA(0, 1), cA, 1, false);
        if (wr == 1) PG8_BAR;
        PG8_WAIT_V(4); PG8_BAR;
        PG8_STAGE(PG8_SB(1, 0), cB + kstepB, voffB); PG8_STAGE_A(PG8_SA(1, 0), cA + kstep, 0, false); PG8_STAGE(PG8_SB(1, 1), cB + hstepB + kstepB, voffB);
        PG8_WAIT_V(6); PG8_BAR;
    }
    for (;;) {
        const bool has_next = S.next(ui + 1, nxt);
        if constexpr (GATHER) { if (has_next) PG8_GVOFF(nxt, vAn); else { vAn[0][0] = vAc[0][0]; vAn[0][1] = vAc[0][1]; vAn[1][0] = vAc[1][0]; vAn[1][1] = vAc[1][1]; } }
        const char* nA = (has_next && !GATHER) ? (const char*)g.A + (size_t)nxt.pm * tstep : cA; const char* nB = has_next ? (const char*)g.Bt + (size_t)nxt.pn * tstepB : cB;
        if constexpr (NF8 > 0) {
#pragma unroll 1
        for (int t = 0; t < NF8; t += 2) { constexpr bool f8_ = true;
            const bool last = (t == nt - 2);
            if constexpr (MID) { if (t == (NF8 > 0 ? NF8 : nt / 2)) { if constexpr (NF8 > 0) asm volatile("s_nop 15\n\ts_nop 15" ::: "memory"); E.mid(acc, cur, wr, wc, fr, fq); } }
            const char* a1 = cA + (size_t)(t + 1) * kstep;
            const char* a2 = last ? nA : cA + (size_t)(t + 2) * kstep; const char* b2 = last ? nB : cB + (size_t)(t + 2) * kstepB;
            const char* a3 = a2 + kstep; const char* b3 = b2 + kstepB;
            if (last && has_next) S.a_ready(nxt);
            if constexpr (SP2) {
            PG8_LDB(B0, 0, 0); PG8_LDB(B1, 0, 1); PG8_SCHED; PG8_LDA(At, 0, 0); PG8_STAGE_A(PG8_SA(1, 1), a1, 1, false);
            PG8_WAIT_V(8); PG8_WAIT_L(0); PG8_BAR; PG8_MMA(0, 0, At, B0); PG8_MMA(0, 1, At, B1); PG8_BAR; PG8_SCHED;
            PG8_LDA(At, 0, 1); PG8_STAGE(PG8_SB(0, 0), b2, voffB); PG8_STAGE(PG8_SB(0, 1), b2 + hstepB, voffB); PG8_STAGE_A(PG8_SA(0, 0), a2, 0, last);
            PG8_WAIT_V(8); PG8_WAIT_L(0); PG8_BAR; PG8_MMA(1, 0, At, B0); PG8_MMA(1, 1, At, B1); PG8_BAR; PG8_SCHED;
            PG8_LDB(B0, 1, 0); PG8_LDB(B1, 1, 1); PG8_SCHED; PG8_LDA(At, 1, 0); PG8_STAGE_A(PG8_SA(0, 1), a2, 1, last);
            PG8_WAIT_V(8); PG8_WAIT_L(0); PG8_BAR; PG8_MMA(0, 0, At, B0); PG8_MMA(0, 1, At, B1); PG8_BAR; PG8_SCHED;
            PG8_LDA(At, 1, 1); PG8_STAGE(PG8_SB(1, 0), b3, voffB); PG8_STAGE(PG8_SB(1, 1), b3 + hstepB, voffB); PG8_STAGE_A(PG8_SA(1, 0), a3, 0, last);
            PG8_WAIT_V(8); PG8_WAIT_L(0); PG8_BAR; PG8_MMA(1, 0, At, B0); PG8_MMA(1, 1, At, B1); PG8_BAR; PG8_SCHED;
            } else {
            PG8_LDB(B0, 0, 0); PG8_SCHED; PG8_LDA(At, 0, 0); PG8_STAGE_A(PG8_SA(1, 1), a1, 1, false);
            PG8_WAIT_L(8); PG8_BAR; PG8_WAIT_L(0); PG8_MMA(0, 0, At, B0); PG8_BAR; PG8_SCHED;
            PG8_LDB(B1, 0, 1); PG8_STAGE(PG8_SB(0, 0), b2, voffB);
            PG8_BAR; PG8_WAIT_L(0); PG8_MMA(0, 1, At, B1); PG8_BAR;
            PG8_LDA(At, 0, 1); PG8_STAGE_A(PG8_SA(0, 0), a2, 0, last);
            PG8_BAR; PG8_WAIT_L(0); PG8_MMA(1, 0, At, B0); PG8_BAR; PG8_SCHED;
            PG8_STAGE(PG8_SB(0, 1), b2 + hstepB, voffB);
            PG8_WAIT_V(6); PG8_BAR; PG8_MMA(1, 1, At, B1); PG8_BAR;
            PG8_LDB(B0, 1, 0); PG8_SCHED; PG8_LDA(At, 1, 0); PG8_STAGE_A(PG8_SA(0, 1), a2, 1, last);
            PG8_WAIT_L(8); PG8_BAR; PG8_WAIT_L(0); PG8_MMA(0, 0, At, B0); PG8_BAR; PG8_SCHED;
            PG8_LDB(B1, 1, 1); PG8_STAGE(PG8_SB(1, 0), b3, voffB);
            PG8_BAR; PG8_WAIT_L(0); PG8_MMA(0, 1, At, B1); PG8_BAR;
            PG8_LDA(At, 1, 1); PG8_STAGE_A(PG8_SA(1, 0), a3, 0, last);
            PG8_BAR; PG8_WAIT_L(0); PG8_MMA(1, 0, At, B0); PG8_BAR; PG8_SCHED;
            PG8_STAGE(PG8_SB(1, 1), b3 + hstepB, voffB);
            PG8_WAIT_V(6); PG8_BAR; PG8_MMA(1, 1, At, B1); PG8_BAR;
            }
        }
#pragma unroll 1
        for (int t = NF8; t < nt; t += 2) { constexpr bool f8_ = false;
            const bool last = (t == nt - 2);
            if constexpr (MID) { if (t == (NF8 > 0 ? NF8 : nt / 2)) { if constexpr (NF8 > 0) asm volatile("s_nop 15\n\ts_nop 15" ::: "memory"); E.mid(acc, cur, wr, wc, fr, fq); } }
            const char* a1 = cA + (size_t)(t + 1) * kstep;
            const char* a2 = last ? nA : cA + (size_t)(t + 2) * kstep; const char* b2 = last ? nB : cB + (size_t)(t + 2) * kstepB;
            const char* a3 = a2 + kstep; const char* b3 = b2 + kstepB;
            if (last && has_next) S.a_ready(nxt);
            if constexpr (SP2) {
            PG8_LDB(B0, 0, 0); PG8_LDB(B1, 0, 1); PG8_SCHED; PG8_LDA(At, 0, 0); PG8_STAGE_A(PG8_SA(1, 1), a1, 1, false);
            PG8_WAIT_V(8); PG8_WAIT_L(0); PG8_BAR; PG8_MMA(0, 0, At, B0); PG8_MMA(0, 1, At, B1); PG8_BAR; PG8_SCHED;
            PG8_LDA(At, 0, 1); PG8_STAGE(PG8_SB(0, 0), b2, voffB); PG8_STAGE(PG8_SB(0, 1), b2 + hstepB, voffB); PG8_STAGE_A(PG8_SA(0, 0), a2, 0, last);
            PG8_WAIT_V(8); PG8_WAIT_L(0); PG8_BAR; PG8_MMA(1, 0, At, B0); PG8_MMA(1, 1, At, B1); PG8_BAR; PG8_SCHED;
            PG8_LDB(B0, 1, 0); PG8_LDB(B1, 1, 1); PG8_SCHED; PG8_LDA(At, 1, 0); PG8_STAGE_A(PG8_SA(0, 1), a2, 1, last);
            PG8_WAIT_V(8); PG8_WAIT_L(0); PG8_BAR; PG8_MMA(0, 0, At, B0); PG8_MMA(0, 1, At, B1); PG8_BAR; PG8_SCHED;
            PG8_LDA(At, 1, 1); PG8_STAGE(PG8_SB(1, 0), b3, voffB); PG8_STAGE(PG8_SB(1, 1), b3 + hstepB, voffB); PG8_STAGE_A(PG8_SA(1, 0), a3, 0, last);
            PG8_WAIT_V(8); PG8_WAIT_L(0); PG8_BAR; PG8_MMA(1, 0, At, B0); PG8_MMA(1, 1, At, B1); PG8_BAR; PG8_SCHED;
            } else {
            PG8_LDB(B0, 0, 0); PG8_SCHED; PG8_LDA(At, 0, 0); PG8_STAGE_A(PG8_SA(1, 1), a1, 1, false);
            PG8_WAIT_L(8); PG8_BAR; PG8_WAIT_L(0); PG8_MMA(0, 0, At, B0); PG8_BAR; PG8_SCHED;
            PG8_LDB(B1, 0, 1); PG8_STAGE(PG8_SB(0, 0), b2, voffB);
            PG8_BAR; PG8_WAIT_L(0); PG8_MMA(0, 1, At, B1); PG8_BAR;
            PG8_LDA(At, 0, 1); PG8_STAGE_A(PG8_SA(0, 0), a2, 0, last);
            PG8_BAR; PG8_WAIT_L(0); PG8_MMA(1, 0, At, B0); PG8_BAR; PG8_SCHED;
            PG8_STAGE(PG8_SB(0, 1), b2 + hstepB, voffB);
            PG8_WAIT_V(6); PG8_BAR; PG8_MMA(1, 1, At, B1); PG8_BAR;
            PG8_LDB(B0, 1, 0); PG8_SCHED; PG8_LDA(At, 1, 0); PG8_STAGE_A(PG8_SA(0, 1), a2, 1, last);
            PG8_WAIT_L(8); PG8_BAR; PG8_WAIT_L(0); PG8_MMA(0, 0, At, B0); PG8_BAR; PG8_SCHED;
            PG8_LDB(B1, 1, 1); PG8_STAGE(PG8_SB(1, 0), b3, voffB);
            PG8_BAR; PG8_WAIT_L(0); PG8_MMA(0, 1, At, B1); PG8_BAR;
            PG8_LDA(At, 1, 1); PG8_STAGE_A(PG8_SA(1, 0), a3, 0, last);
            PG8_BAR; PG8_WAIT_L(0); PG8_MMA(1, 0, At, B0); PG8_BAR; PG8_SCHED;
            PG8_STAGE(PG8_SB(1, 1), b3 + hstepB, voffB);
            PG8_WAIT_V(6); PG8_BAR; PG8_MMA(1, 1, At, B1); PG8_BAR;
            }
        }
        } else {
#pragma unroll 1
        for (int t = 0; t < nt; t += 2) { constexpr bool f8_ = FP8;
            const bool last = (t == nt - 2);
            if constexpr (MID) { if (t == (NF8 > 0 ? NF8 : nt / 2)) { if constexpr (NF8 > 0) asm volatile("s_nop 15\n\ts_nop 15" ::: "memory"); E.mid(acc, cur, wr, wc, fr, fq); } }
            const char* a1 = cA + (size_t)(t + 1) * kstep;
            const char* a2 = last ? nA : cA + (size_t)(t + 2) * kstep; const char* b2 = last ? nB : cB + (size_t)(t + 2) * kstepB;
            const char* a3 = a2 + kstep; const char* b3 = b2 + kstepB;
            if (last && has_next) S.a_ready(nxt);
            if constexpr (SP2) {
            PG8_LDB(B0, 0, 0); PG8_LDB(B1, 0, 1); PG8_SCHED; PG8_LDA(At, 0, 0); PG8_STAGE_A(PG8_SA(1, 1), a1, 1, false);
            PG8_WAIT_V(8); PG8_WAIT_L(0); PG8_BAR; PG8_MMA(0, 0, At, B0); PG8_MMA(0, 1, At, B1); PG8_BAR; PG8_SCHED;
            PG8_LDA(At, 0, 1); PG8_STAGE(PG8_SB(0, 0), b2, voffB); PG8_STAGE(PG8_SB(0, 1), b2 + hstepB, voffB); PG8_STAGE_A(PG8_SA(0, 0), a2, 0, last);
            PG8_WAIT_V(8); PG8_WAIT_L(0); PG8_BAR; PG8_MMA(1, 0, At, B0); PG8_MMA(1, 1, At, B1); PG8_BAR; PG8_SCHED;
            PG8_LDB(B0, 1, 0); PG8_LDB(B1, 1, 1); PG8_SCHED; PG8_LDA(At, 1, 0); PG8_STAGE_A(PG8_SA(0, 1), a2, 1, last);
            PG8_WAIT_V(8); PG8_WAIT_L(0); PG8_BAR; PG8_MMA(0, 0, At, B0); PG8_MMA(0, 1, At, B1); PG8_BAR; PG8_SCHED;
            PG8_LDA(At, 1, 1); PG8_STAGE(PG8_SB(1, 0), b3, voffB); PG8_STAGE(PG8_SB(1, 1), b3 + hstepB, voffB); PG8_STAGE_A(PG8_SA(1, 0), a3, 0, last);
            PG8_WAIT_V(8); PG8_WAIT_L(0); PG8_BAR; PG8_MMA(1, 0, At, B0); PG8_MMA(1, 1, At, B1); PG8_BAR; PG8_SCHED;
            } else {
            PG8_LDB(B0, 0, 0); PG8_SCHED; PG8_LDA(At, 0, 0); PG8_STAGE_A(PG8_SA(1, 1), a1, 1, false);
            PG8_WAIT_L(8); PG8_BAR; PG8_WAIT_L(0); PG8_MMA(0, 0, At, B0); PG8_BAR; PG8_SCHED;
            PG8_LDB(B1, 0, 1); PG8_STAGE(PG8_SB(0, 0), b2, voffB);
            PG8_BAR; PG8_WAIT_L(0); PG8_MMA(0, 1, At, B1); PG8_BAR;
            PG8_LDA(At, 0, 1); PG8_STAGE_A(PG8_SA(0, 0), a2, 0, last);
            PG8_BAR; PG8_WAIT_L(0); PG8_MMA(1, 0, At, B0); PG8_BAR; PG8_SCHED;
            PG8_STAGE(PG8_SB(0, 1), b2 + hstepB, voffB);
            PG8_WAIT_V(6); PG8_BAR; PG8_MMA(1, 1, At, B1); PG8_BAR;
            PG8_LDB(B0, 1, 0); PG8_SCHED; PG8_LDA(At, 1, 0); PG8_STAGE_A(PG8_SA(0, 1), a2, 1, last);
            PG8_WAIT_L(8); PG8_BAR; PG8_WAIT_L(0); PG8_MMA(0, 0, At, B0); PG8_BAR; PG8_SCHED;
            PG8_LDB(B1, 1, 1); PG8_STAGE(PG8_SB(1, 0), b3, voffB);
            PG8_BAR; PG8_WAIT_L(0); PG8_MMA(0, 1, At, B1); PG8_BAR;
            PG8_LDA(At, 1, 1); PG8_STAGE_A(PG8_SA(1, 0), a3, 0, last);
            PG8_BAR; PG8_WAIT_L(0); PG8_MMA(1, 0, At, B0); PG8_BAR; PG8_SCHED;
            PG8_STAGE(PG8_SB(1, 1), b3 + hstepB, voffB);
            PG8_WAIT_V(6); PG8_BAR; PG8_MMA(1, 1, At, B1); PG8_BAR;
            }
        }
        }
        if constexpr (ALIGN_EPI) { if (wr == 0) PG8_BAR; }
        if constexpr (FP8) asm volatile("s_nop 15\n\ts_nop 15" ::: "memory");
        if constexpr (!Epi::AFTER_DRAIN) { E(acc, cur, wr, wc, fr, fq); S.done(cur); }
        if (!has_next) break;
#pragma unroll
        for (int a = 0; a < 2; ++a)
#pragma unroll
            for (int b = 0; b < 2; ++b)
#pragma unroll
                for (int m = 0; m < 4; ++m)
#pragma unroll
                    for (int n = 0; n < 2; ++n) acc[a][b][m][n] = (f32x4){0.f, 0.f, 0.f, 0.f};
        cur = nxt; cA = nA; cB = nB; ++ui;
        if constexpr (GATHER) { vAc[0][0] = vAn[0][0]; vAc[0][1] = vAn[0][1]; vAc[1][0] = vAn[1][0]; vAc[1][1] = vAn[1][1]; }
        if constexpr (ALIGN_EPI) { if (wr == 1) PG8_BAR; }
    }
    PG8_WAIT_V(0);
    if constexpr (!ALIGN_EPI) { if (wr == 0) PG8_BAR; }
    PG8_BAR;
    if constexpr (Epi::AFTER_DRAIN) { E.fused(acc, cur, wr, wc, fr, fq, lds, wid, lane); S.done(cur); }
#undef PG8_SA
#undef PG8_SB
#undef PG8_STAGE
#undef PG8_GVOFF
#undef PG8_STAGE_A
#undef PG8_LDA
#undef PG8_LDB
#undef PG8_MMA
#undef PG8_WAIT_V
#undef PG8_WAIT_L
#undef PG8_BAR
#undef PG8_SCHED
}
}
namespace attn {
using bf16 = unsigned short;
constexpr int   D = 128, NW = 8, QBLK = 32, KVBLK = 64;
constexpr float SCALE = 0.088388347648318440f;
constexpr float THR = 1.2f;
constexpr int SDEPTH = 2;
constexpr int LDQ = 8704, LDK = 128, LDO = 3072;
constexpr size_t SHM_V = KVBLK * D  , SHM_K = KVBLK * D  , SHM_ATTN = 8 * SHM_V + 8 * SHM_K + NW * 64 * 4;
using bf16x8 = __attribute__((ext_vector_type(8))) short;
using s16x4  = __attribute__((ext_vector_type(4))) short;
using f32x16 = __attribute__((ext_vector_type(16))) float;
using f32x8  = __attribute__((ext_vector_type(8))) float;
using u32x4  = __attribute__((ext_vector_type(4))) unsigned;
#define KSWZ(row, colB) ((row) * 256 + ((colB) ^ (((row) & 7) << 4)))
#define SBAR() __builtin_amdgcn_sched_barrier(0)
__device__ __forceinline__ int crow(int r, int hi) { return (r & 3) + 8 * (r >> 2) + 4 * hi; }
__device__ __forceinline__ unsigned cvtpk(float lo, float hi) {
  unsigned r; asm volatile("v_cvt_pk_bf16_f32 %0, %1, %2" : "=v"(r) : "v"(lo), "v"(hi)); return r;
}
struct StageB { using T = bf16x8;
  __device__ static __forceinline__ T ld8(const bf16* p) { return *reinterpret_cast<const bf16x8*>(p); }
  __device__ static __forceinline__ bf16x8 tobf(T x) { return x; } };
__device__ __forceinline__ void partialSM(f32x16& p0, f32x16& p1, float& m_reg, float& mn, float& alpha) {
  constexpr float C = SCALE * 1.4426950408889634f;
  float pmax = p0[0]; for (int r = 1; r < 16; ++r) pmax = fmaxf(pmax, p0[r]); for (int r = 0; r < 16; ++r) pmax = fmaxf(pmax, p1[r]);
  { auto rr = __builtin_amdgcn_permlane32_swap(__float_as_uint(pmax), __float_as_uint(pmax), false, false);
    pmax = fmaxf(__uint_as_float(rr[0]), __uint_as_float(rr[1])); }
  if (__builtin_expect(__all(pmax - m_reg <= THR / SCALE), 1)) { mn = m_reg; alpha = 1.f; }
  else { mn = fmaxf(m_reg, pmax); alpha = __builtin_amdgcn_exp2f((m_reg - mn) * C); m_reg = mn; }
  float mnC = 7.f - mn * C;
  for (int r = 0; r < 16; ++r) p0[r] = fmaf(p0[r], C, mnC); for (int r = 0; r < 16; ++r) p1[r] = fmaf(p1[r], C, mnC);
  for (int r = 0; r < 16; ++r) p0[r] = __builtin_amdgcn_exp2f(p0[r]);
}
constexpr float THR2 = THR * 1.4426950408889634f;
__device__ __forceinline__ float max3f(float a, float b, float c) { float r; asm("v_max3_f32 %0, %1, %2, %3" : "=v"(r) : "v"(a), "v"(b), "v"(c)); return r; }
__device__ __forceinline__ float max2f(float a, float b) { float r; asm("v_max_f32 %0, %1, %2" : "=v"(r) : "v"(a), "v"(b)); return r; }
template <bool FIRST> __device__ __forceinline__ void partialSM2(f32x16& p0, f32x16& p1, f32x16& negm, float& alpha, int hi) {
  float pmax;
  if (FIRST) { float pma = max2f(p0[0], p0[1]), pmb = max2f(p1[0], p1[1]);
    for (int r = 2; r < 16; r += 2) { pma = max3f(pma, p0[r], p0[r + 1]); pmb = max3f(pmb, p1[r], p1[r + 1]); }
    pma = max2f(pma, pmb);
    auto rr = __builtin_amdgcn_permlane32_swap(__float_as_uint(pma), __float_as_uint(pma), false, false);
    pmax = max2f(__uint_as_float(rr[0]), __uint_as_float(rr[1])); }
  else {
    int ia = __float_as_int(p0[0]), ib = __float_as_int(p1[0]);
    for (int r = 1; r < 16; ++r) { ia = ia > __float_as_int(p0[r]) ? ia : __float_as_int(p0[r]); ib = ib > __float_as_int(p1[r]) ? ib : __float_as_int(p1[r]); }
    ia = ia > ib ? ia : ib;
    auto rr = __builtin_amdgcn_permlane32_swap((unsigned)ia, (unsigned)ia, false, false);
    const int i0 = (int)rr[0], i1 = (int)rr[1]; pmax = __int_as_float(i0 > i1 ? i0 : i1); }
  if (!FIRST && __builtin_expect(__all(pmax <= 7.f + THR2), 1)) alpha = 1.f;
  else { float d = pmax - 7.f; if (!FIRST) d = fmaxf(d, 0.f); alpha = FIRST ? 1.f : __builtin_amdgcn_exp2f(-d);
    const float one = hi ? 0.f : 1.f, nd = hi ? 0.f : -d;
    asm volatile("s_nop 3\n\t"
                 "v_mfma_f32_32x32x2_f32 %0, %3, %4, %0\n\t"
                 "v_mfma_f32_32x32x2_f32 %1, %3, %4, %1\n\t"
                 "v_mfma_f32_32x32x2_f32 %2, %3, %4, %2\n\t"
                 "s_nop 15\n\ts_nop 7" : "+v"(p0), "+v"(p1), "+v"(negm) : "v"(one), "v"(nd)); }
#if defined(PROBE_NOEXP)
  for (int r = 0; r < 16; ++r) p0[r] = __builtin_fmaf(__builtin_fabsf(p0[r]), 0.01f, 1.f);
#else
  for (int r = 0; r < 16; ++r) p0[r] = __builtin_amdgcn_exp2f(p0[r]);
#endif
}
__device__ __forceinline__ void finishSM(f32x16& p0, f32x16& p1, float alpha, float& l_reg, bf16x8& pa0, bf16x8& pa1, bf16x8& pa2, bf16x8& pa3) {
  for (int r = 0; r < 16; ++r) p1[r] = __builtin_amdgcn_exp2f(p1[r]);
  float ps = 0; for (int r = 0; r < 16; ++r) ps += p0[r]; for (int r = 0; r < 16; ++r) ps += p1[r];
  { auto rr = __builtin_amdgcn_permlane32_swap(__float_as_uint(ps), __float_as_uint(ps), false, false);
    ps = __uint_as_float(rr[0]) + __uint_as_float(rr[1]); }
  l_reg = l_reg * alpha + ps;
#define PK4(P, BASE, OUT) do { unsigned a0 = cvtpk(P[BASE + 0], P[BASE + 1]), a1 = cvtpk(P[BASE + 2], P[BASE + 3]);   \
    unsigned b0 = cvtpk(P[BASE + 4], P[BASE + 5]), b1 = cvtpk(P[BASE + 6], P[BASE + 7]);                              \
    auto r0 = __builtin_amdgcn_permlane32_swap(a0, b0, false, false); auto r1 = __builtin_amdgcn_permlane32_swap(a1, b1, false, false); \
    u32x4 w = {r0[0], r1[0], r0[1], r1[1]}; OUT = *reinterpret_cast<bf16x8*>(&w); } while (0)
  PK4(p0, 0, pa0); PK4(p0, 8, pa1); PK4(p1, 0, pa2); PK4(p1, 8, pa3);
#undef PK4
}
typedef int v8i_p __attribute__((ext_vector_type(8))); typedef int v4i_a __attribute__((ext_vector_type(4)));
__device__ __forceinline__ int pk4f8_(float a, float b, float c, float d) { int w = 0; w = __builtin_amdgcn_cvt_pk_fp8_f32(a, b, w, false); w = __builtin_amdgcn_cvt_pk_fp8_f32(c, d, w, true); return w; }
__device__ __forceinline__ void finishSM8(f32x16& p0, f32x16& p1, float alpha, float& l_reg, v8i_p& pa) {
  for (int r = 0; r < 16; ++r) p1[r] = __builtin_amdgcn_exp2f(p1[r]);
  float ps = 0; for (int r = 0; r < 16; ++r) ps += p0[r]; for (int r = 0; r < 16; ++r) ps += p1[r];
  { auto rr = __builtin_amdgcn_permlane32_swap(__float_as_uint(ps), __float_as_uint(ps), false, false);
    ps = __uint_as_float(rr[0]) + __uint_as_float(rr[1]); }
  l_reg = l_reg * alpha + ps;
  for (int i = 0; i < 4; ++i) { pa[i] = pk4f8_(p0[4 * i], p0[4 * i + 1], p0[4 * i + 2], p0[4 * i + 3]); pa[4 + i] = pk4f8_(p1[4 * i], p1[4 * i + 1], p1[4 * i + 2], p1[4 * i + 3]); }
}
__device__ __forceinline__ void finishSM8n(f32x16& p0, f32x16& p1, v8i_p& pa) {
#if defined(PROBE_NOEXP)
  for (int r = 0; r < 16; ++r) p1[r] = __builtin_fmaf(__builtin_fabsf(p1[r]), 0.01f, 1.f);
#else
  for (int r = 0; r < 16; ++r) p1[r] = __builtin_amdgcn_exp2f(p1[r]);
#endif
  for (int i = 0; i < 4; ++i) { int w = pa[i]; w = __builtin_amdgcn_cvt_pk_fp8_f32(p0[4 * i], p0[4 * i + 1], w, false); w = __builtin_amdgcn_cvt_pk_fp8_f32(p0[4 * i + 2], p0[4 * i + 3], w, true); pa[i] = w;
    int u = pa[4 + i]; u = __builtin_amdgcn_cvt_pk_fp8_f32(p1[4 * i], p1[4 * i + 1], u, false); u = __builtin_amdgcn_cvt_pk_fp8_f32(p1[4 * i + 2], p1[4 * i + 3], u, true); pa[4 + i] = u; }
}
__host__ __device__ __forceinline__ int vt_pos(int t) { const int c = t & 31; return 32 * ((c >> 2) & 1) + 16 * (t >> 5) + (c & 3) + 4 * (c >> 3); }
__device__ __forceinline__ void pv8(f32x16* o, const char* Vt, const v8i_p& pa, int r32, int hi) {
  const int sa = 0x78787878, sb = 0x7F7F7F7F;
#pragma unroll
  for (int g = 0; g < 2; ++g) { v8i_p b[2];
#pragma unroll
    for (int e = 0; e < 2; ++e) { const int d = 32 * (2 * g + e) + r32, sw = (d >> 2) & 3;
      const v4i_a lo = *reinterpret_cast<const v4i_a*>(Vt + d * 64 + (((2 * hi) ^ sw) << 4)), up = *reinterpret_cast<const v4i_a*>(Vt + d * 64 + (((2 * hi + 1) ^ sw) << 4));
      b[e] = __builtin_shufflevector(lo, up, 0, 1, 2, 3, 4, 5, 6, 7); }
    asm volatile("v_mfma_scale_f32_32x32x64_f8f6f4 %0, %2, %3, %0, %5, %6 op_sel_hi:[0,0,0]\n\t"
                 "v_mfma_scale_f32_32x32x64_f8f6f4 %1, %2, %4, %1, %5, %6 op_sel_hi:[0,0,0]"
                 : "+v"(o[2 * g]), "+v"(o[2 * g + 1]) : "v"(pa), "v"(b[0]), "v"(b[1]), "v"(sa), "v"(sb)); }
}
__device__ __forceinline__ void pv8n(f32x16* o, f32x16& lacc, const char* Vt, const v8i_p& pa, const v4i_a& ones4, int r32, int hi) {
  const int sa = 0x78787878, sb = 0x7F7F7F7F;
#pragma unroll
  for (int g = 0; g < 2; ++g) { v8i_p b[2];
#pragma unroll
    for (int e = 0; e < 2; ++e) { const int d = 32 * (2 * g + e) + r32, sw = (d >> 2) & 3;
      const v4i_a lo = *reinterpret_cast<const v4i_a*>(Vt + d * 64 + (((2 * hi) ^ sw) << 4)), up = *reinterpret_cast<const v4i_a*>(Vt + d * 64 + (((2 * hi + 1) ^ sw) << 4));
      b[e] = __builtin_shufflevector(lo, up, 0, 1, 2, 3, 4, 5, 6, 7); }
    if (g == 0) asm volatile("v_mfma_scale_f32_32x32x64_f8f6f4 %0, %2, %3, %0, %5, %6 op_sel_hi:[0,0,0]\n\t"
                 "v_mfma_scale_f32_32x32x64_f8f6f4 %1, %2, %4, %1, %5, %6 op_sel_hi:[0,0,0]"
                 : "+v"(o[0]), "+v"(o[1]) : "v"(pa), "v"(b[0]), "v"(b[1]), "v"(sa), "v"(sb));
    else        asm volatile("v_mfma_scale_f32_32x32x64_f8f6f4 %0, %3, %4, %0, %7, %8 op_sel_hi:[0,0,0]\n\t"
                 "v_mfma_scale_f32_32x32x64_f8f6f4 %1, %3, %5, %1, %7, %8 op_sel_hi:[0,0,0]\n\t"
                 "v_mfma_scale_f32_32x32x64_f8f6f4 %2, %3, %6, %2, %7, %8 op_sel_hi:[0,0,0] blgp:4"
                 : "+v"(o[2]), "+v"(o[3]), "+v"(lacc) : "v"(pa), "v"(b[0]), "v"(b[1]), "v"(ones4), "v"(sa), "v"(sb)); }
}
__device__ __forceinline__ void qkt(f32x16& p0, f32x16& p1, const bf16* Ks, const bf16x8* qr, int r32, int hi) {
  p0 = f32x16{}; p1 = f32x16{};
  for (int d0 = 0; d0 < 8; ++d0) { int cb = (d0 * 16 + hi * 8) * 2;
    bf16x8 b0 = *reinterpret_cast<const bf16x8*>((const char*)Ks + KSWZ(r32, cb));
    bf16x8 b1 = *reinterpret_cast<const bf16x8*>((const char*)Ks + KSWZ(32 + r32, cb));
    p0 = __builtin_amdgcn_mfma_f32_32x32x16_bf16(b0, qr[d0], p0, 0, 0, 0);
    p1 = __builtin_amdgcn_mfma_f32_32x32x16_bf16(b1, qr[d0], p1, 0, 0, 0); }
}
typedef int v4i_a __attribute__((ext_vector_type(4))); typedef int v8i_a __attribute__((ext_vector_type(8)));
__device__ __forceinline__ void qkt8(f32x16& p0, f32x16& p1, const char* Ks, const v8i_a (&q8)[2], int r32, int hi) {
  p0 = f32x16{}; p1 = f32x16{};
  const int sc = 0x7F7F7F7F;
#pragma unroll
  for (int s = 0; s < 2; ++s) { v8i_a a[2];
#pragma unroll
    for (int kh = 0; kh < 2; ++kh) { const int row = kh * 32 + r32, cb = 64 * s + 32 * hi, sw = (row & 7) << 4;
      const v4i_a lo = *reinterpret_cast<const v4i_a*>(Ks + row * 128 + (cb ^ sw)), up = *reinterpret_cast<const v4i_a*>(Ks + row * 128 + ((cb + 16) ^ sw));
      a[kh] = __builtin_shufflevector(lo, up, 0, 1, 2, 3, 4, 5, 6, 7); }
    if (s == 0) asm volatile("s_nop 3\n\t"
                 "v_mfma_scale_f32_32x32x64_f8f6f4 %0, %2, %4, %0, %5, %5 op_sel_hi:[0,0,0]\n\t"
                 "v_mfma_scale_f32_32x32x64_f8f6f4 %1, %3, %4, %1, %5, %5 op_sel_hi:[0,0,0]"
                 : "+v"(p0), "+v"(p1) : "v"(a[0]), "v"(a[1]), "v"(q8[0]), "v"(sc));
    else        asm volatile("v_mfma_scale_f32_32x32x64_f8f6f4 %0, %2, %4, %0, %5, %5 op_sel_hi:[0,0,0]\n\t"
                 "v_mfma_scale_f32_32x32x64_f8f6f4 %1, %3, %4, %1, %5, %5 op_sel_hi:[0,0,0]\n\t"
                 "s_nop 15\n\ts_nop 7"
                 : "+v"(p0), "+v"(p1) : "v"(a[0]), "v"(a[1]), "v"(q8[1]), "v"(sc)); }
}
__device__ __forceinline__ void qkt8n(f32x16& p0, f32x16& p1, const char* Ks, const v8i_a (&q8)[2], const f32x16& negm, int r32, int hi) {
  const int sk = 0x7F7F7F7F, sq = 0x7C7C7C7C;
#pragma unroll
  for (int s = 0; s < 2; ++s) { v8i_a a[2];
#pragma unroll
    for (int kh = 0; kh < 2; ++kh) { const int row = kh * 32 + r32, cb = 64 * s + 32 * hi, sw = (row & 7) << 4;
      const v4i_a lo = *reinterpret_cast<const v4i_a*>(Ks + row * 128 + (cb ^ sw)), up = *reinterpret_cast<const v4i_a*>(Ks + row * 128 + ((cb + 16) ^ sw));
      a[kh] = __builtin_shufflevector(lo, up, 0, 1, 2, 3, 4, 5, 6, 7); }
    if (s == 0) asm volatile("s_nop 3\n\t"
                 "v_mfma_scale_f32_32x32x64_f8f6f4 %0, %2, %4, %5, %6, %7 op_sel_hi:[0,0,0]\n\t"
                 "v_mfma_scale_f32_32x32x64_f8f6f4 %1, %3, %4, %5, %6, %7 op_sel_hi:[0,0,0]"
                 : "=&v"(p0), "=&v"(p1) : "v"(a[0]), "v"(a[1]), "v"(q8[0]), "v"(negm), "v"(sk), "v"(sq));
    else        asm volatile("v_mfma_scale_f32_32x32x64_f8f6f4 %0, %2, %4, %0, %5, %6 op_sel_hi:[0,0,0]\n\t"
                 "v_mfma_scale_f32_32x32x64_f8f6f4 %1, %3, %4, %1, %5, %6 op_sel_hi:[0,0,0]\n\t"
                 "s_nop 15\n\ts_nop 7"
                 : "+v"(p0), "+v"(p1) : "v"(a[0]), "v"(a[1]), "v"(q8[1]), "v"(sk), "v"(sq)); }
}
__device__ __forceinline__ void ldK8(v8i_a (&ka)[2][2], const char* Ks, int r32, int hi) {
#if defined(PROBE_LDSBCAST)
  r32 = 0; hi = 0;
#endif
#pragma unroll
  for (int s = 0; s < 2; ++s)
#pragma unroll
    for (int kh = 0; kh < 2; ++kh) { const int row = kh * 32 + r32, cb = 64 * s + 32 * hi, sw = ((row >> 1) & 7) << 4;
      const v4i_a lo = *reinterpret_cast<const v4i_a*>(Ks + row * 128 + (cb ^ sw)), up = *reinterpret_cast<const v4i_a*>(Ks + row * 128 + ((cb + 16) ^ sw));
      ka[s][kh] = __builtin_shufflevector(lo, up, 0, 1, 2, 3, 4, 5, 6, 7); }
}
__device__ __forceinline__ void ldV8one(v8i_p& b, const char* Vt, int blk, int r32, int hi) {
  const int d = 32 * blk + r32, sw = (d >> 2) & 3;
  const v4i_a lo = *reinterpret_cast<const v4i_a*>(Vt + d * 64 + (((2 * hi) ^ sw) << 4)), up = *reinterpret_cast<const v4i_a*>(Vt + d * 64 + (((2 * hi + 1) ^ sw) << 4));
  b = __builtin_shufflevector(lo, up, 0, 1, 2, 3, 4, 5, 6, 7);
}
__device__ __forceinline__ void ldV8(v8i_p (&b)[2], const char* Vt, int g, int r32, int hi) {
#if defined(PROBE_LDSBCAST)
  r32 = 0; hi = 0;
#endif
#pragma unroll
  for (int e = 0; e < 2; ++e) { const int d = 32 * (2 * g + e) + r32, sw = (d >> 2) & 3;
    const v4i_a lo = *reinterpret_cast<const v4i_a*>(Vt + d * 64 + (((2 * hi) ^ sw) << 4)), up = *reinterpret_cast<const v4i_a*>(Vt + d * 64 + (((2 * hi + 1) ^ sw) << 4));
    b[e] = __builtin_shufflevector(lo, up, 0, 1, 2, 3, 4, 5, 6, 7); }
}
template <bool TAILNOP> __device__ __forceinline__ void qk_mma(f32x16& p0, f32x16& p1, const v8i_a (&ka)[2][2], const v8i_a (&q8)[2], const f32x16& negm) {
  asm volatile("s_nop 3\n\t"
               "v_mfma_f32_32x32x64_f8f6f4 %0, %2, %4, %5\n\t"
               "v_mfma_f32_32x32x64_f8f6f4 %1, %3, %4, %5"
               : "=&v"(p0), "=&v"(p1) : "v"(ka[0][0]), "v"(ka[0][1]), "v"(q8[0]), "v"(negm));
#if defined(PROBE_DUPMFMA)
  for (int rep = 0; rep < 2; ++rep)
  asm volatile("v_mfma_f32_32x32x64_f8f6f4 %0, %2, %4, %5\n\t"
               "v_mfma_f32_32x32x64_f8f6f4 %1, %3, %4, %5"
               : "=&v"(p0), "=&v"(p1) : "v"(ka[0][0]), "v"(ka[0][1]), "v"(q8[0]), "v"(negm));
#endif
#if defined(PROBE_FEWMFMA)
  if (TAILNOP) asm volatile("s_nop 15\n\ts_nop 7" ::: "memory");
  return;
#endif
  if (TAILNOP) asm volatile("v_mfma_f32_32x32x64_f8f6f4 %0, %2, %4, %0\n\t"
               "v_mfma_f32_32x32x64_f8f6f4 %1, %3, %4, %1\n\t"
               "s_nop 15\n\ts_nop 7"
               : "+v"(p0), "+v"(p1) : "v"(ka[1][0]), "v"(ka[1][1]), "v"(q8[1]));
  else         asm volatile("v_mfma_f32_32x32x64_f8f6f4 %0, %2, %4, %0\n\t"
               "v_mfma_f32_32x32x64_f8f6f4 %1, %3, %4, %1"
               : "+v"(p0), "+v"(p1) : "v"(ka[1][0]), "v"(ka[1][1]), "v"(q8[1]));
}
__device__ __forceinline__ void pv_mma0(f32x16* o, const v8i_p& pa, const v8i_p (&b)[2]) {
  asm volatile("v_mfma_f32_32x32x64_f8f6f4 %0, %2, %3, %0\n\t"
               "v_mfma_f32_32x32x64_f8f6f4 %1, %2, %4, %1"
               : "+v"(o[0]), "+v"(o[1]) : "v"(pa), "v"(b[0]), "v"(b[1]));
}
__device__ __forceinline__ void pv_mma1(f32x16* o, f32x16& lacc, const v8i_p& pa, const v8i_p (&b)[2], const v4i_a& ones4) {
#if defined(PROBE_FEWMFMA)
  asm volatile("v_mfma_f32_32x32x64_f8f6f4 %2, %3, %6, %2 blgp:4"
               : "+v"(o[2]), "+v"(o[3]), "+v"(lacc) : "v"(pa), "v"(b[0]), "v"(b[1]), "v"(ones4));
  return;
#endif
  asm volatile("v_mfma_f32_32x32x64_f8f6f4 %0, %3, %4, %0\n\t"
               "v_mfma_f32_32x32x64_f8f6f4 %1, %3, %5, %1\n\t"
               "v_mfma_f32_32x32x64_f8f6f4 %2, %3, %6, %2 blgp:4"
               : "+v"(o[2]), "+v"(o[3]), "+v"(lacc) : "v"(pa), "v"(b[0]), "v"(b[1]), "v"(ones4));
}
__device__ __forceinline__ int v_st(int k, int c) { const int kk = (k & ~0xC) | ((k & 4) << 1) | ((k & 8) >> 1); return ((kk >> 3) * 4 + (c >> 5)) * 512 + ((kk & 7) * 32 + (c & 31)) * 2; }
__device__ __forceinline__ int v_rd_base(int lane) { return ((lane & 3) << 3) | (((lane >> 2) & 3) << 6) | (((lane >> 4) & 1) << 5) | (((lane >> 5) & 1) << 8); }
constexpr int v_rd_off(int d0, int ks, int half) { return d0 * 512 + ks * 4096 + half * 2048; }
template <int OFF> __device__ __forceinline__ s16x4 tr_read(int vb) {
  s16x4 r; asm volatile("ds_read_b64_tr_b16 %0, %1 offset:%2" : "=&v"(r) : "v"(vb), "i"(OFF) : "memory"); return r;
}
template <int D0> __device__ __forceinline__ void pv_one(f32x16& od, int vb, bf16x8 pa0, bf16x8 pa1, bf16x8 pa2, bf16x8 pa3) {
  const s16x4 l0 = tr_read<v_rd_off(D0, 0, 0)>(vb), h0 = tr_read<v_rd_off(D0, 0, 1)>(vb), l1 = tr_read<v_rd_off(D0, 1, 0)>(vb), h1 = tr_read<v_rd_off(D0, 1, 1)>(vb);
  const s16x4 l2 = tr_read<v_rd_off(D0, 2, 0)>(vb), h2 = tr_read<v_rd_off(D0, 2, 1)>(vb), l3 = tr_read<v_rd_off(D0, 3, 0)>(vb), h3 = tr_read<v_rd_off(D0, 3, 1)>(vb);
  asm volatile("s_waitcnt lgkmcnt(0)" ::: "memory"); SBAR();
#define PK(L, H) (bf16x8){L[0], L[1], L[2], L[3], H[0], H[1], H[2], H[3]}
  od = __builtin_amdgcn_mfma_f32_32x32x16_bf16(pa0, PK(l0, h0), od, 0, 0, 0);
  od = __builtin_amdgcn_mfma_f32_32x32x16_bf16(pa1, PK(l1, h1), od, 0, 0, 0);
  od = __builtin_amdgcn_mfma_f32_32x32x16_bf16(pa2, PK(l2, h2), od, 0, 0, 0);
  od = __builtin_amdgcn_mfma_f32_32x32x16_bf16(pa3, PK(l3, h3), od, 0, 0, 0);
#undef PK
}
__device__ __forceinline__ void pv_d0(f32x16* o, int vb, bf16x8 pa0, bf16x8 pa1, bf16x8 pa2, bf16x8 pa3) {
  pv_one<0>(o[0], vb, pa0, pa1, pa2, pa3); pv_one<1>(o[1], vb, pa0, pa1, pa2, pa3); pv_one<2>(o[2], vb, pa0, pa1, pa2, pa3); pv_one<3>(o[3], vb, pa0, pa1, pa2, pa3);
}

__device__ __forceinline__ void attn_dense_body(const bf16* __restrict__ Qb, const unsigned char* __restrict__ Kh, const unsigned char* __restrict__ Vh,
                                                unsigned char* __restrict__ Ob, int seq, char* lds) {
  using St = StageB; using SQ = StageB;
  int tid_ = threadIdx.x; asm volatile("v_mov_b32 %0, %0" : "+v"(tid_));
  const int tid = tid_, wid = tid >> 6, lane = tid & 63, r32 = lane & 31, hi = lane >> 5;
  bf16* V_lds = (bf16*)lds; bf16* K_lds = (bf16*)(lds + 8 * SHM_V);
  float* ws = (float*)(lds + 8 * SHM_V + 8 * SHM_K) + wid * 64; float* li_l = ws; float* al_l = ws + 32;
  f32x16 o[4] = {}, lacc = {}; v8i_a qr[2]; f32x16 negm; v8i_p pa = {}; v4i_a ones4;
  for (int i = 0; i < 4; ++i) ones4[i] = 0x22222222;
  { float seven; asm volatile("v_mov_b32 %0, 0x40e00000" : "=v"(seven)); for (int r = 0; r < 16; ++r) negm[r] = seven; }
  constexpr float QS = SCALE * 1.4426950408889634f;
#pragma unroll
  for (int s = 0; s < 2; ++s) { const bf16* qp = Qb + (long)(wid * QBLK + r32) * LDQ + 64 * s + 32 * hi; unsigned wq[16];
#pragma unroll
    for (int i = 0; i < 4; ++i) { const u32x4 w = *reinterpret_cast<const u32x4*>(qp + 8 * i); wq[4 * i] = w.x; wq[4 * i + 1] = w.y; wq[4 * i + 2] = w.z; wq[4 * i + 3] = w.w; }
#pragma unroll
    for (int i = 0; i < 8; ++i) { int d = 0; d = __builtin_amdgcn_cvt_pk_fp8_f32(QS * __uint_as_float(wq[2 * i] << 16), QS * __uint_as_float(wq[2 * i] & 0xffff0000u), d, false);
      d = __builtin_amdgcn_cvt_pk_fp8_f32(QS * __uint_as_float(wq[2 * i + 1] << 16), QS * __uint_as_float(wq[2 * i + 1] & 0xffff0000u), d, true); qr[s][i] = d; } }
  const int vst = (tid >> 2) * 64 + ((((tid & 3) ^ ((tid >> 4) & 3))) << 4);
  const int krow = tid >> 3, kch = tid & 7, kst = krow * 128 + ((kch * 16) ^ (((krow >> 1) & 7) << 4));
  const int widu = __builtin_amdgcn_readfirstlane(wid);
  PG8_LAS unsigned char* ldsA = (PG8_LAS unsigned char*)lds;
#define SDMA(b, k0) do { \
    __builtin_amdgcn_global_load_lds((const unsigned*)(Vh + (long)(k0) * 128 + vst), (PG8_LAS unsigned*)(ldsA + (b) * SHM_V + widu * 1024), 16, 0, 0); \
    __builtin_amdgcn_global_load_lds((const unsigned*)(Kh + (long)(k0) * 128 + kst), (PG8_LAS unsigned*)(ldsA + 8 * SHM_V + (b) * SHM_K + widu * 1024), 16, 0, 0); } while (0)
#define SWAIT() asm volatile("s_waitcnt vmcnt(0)" ::: "memory")
#define RESC(a) do { if (__any((a) < 1.f)) { if (hi == 0) al_l[r32] = (a); asm volatile("s_nop 15\n\ts_nop 15\n\ts_waitcnt lgkmcnt(0)" ::: "memory"); \
    for (int r = 0; r < 16; ++r) { const float a_ = al_l[crow(r, hi)]; for (int d = 0; d < 4; ++d) o[d][r] *= a_; lacc[r] *= a_; } } } while (0)
  f32x16 p0, p1; float al; const int NT = seq / KVBLK;
  const bool halfB = widu >= 4;
#define KB(i) ((const char*)K_lds + (i) * SHM_K)
#define VB(i) ((const char*)V_lds + (i) * SHM_V)
#define BAR() __builtin_amdgcn_s_barrier()
  SDMA(0, 0); SDMA(1, KVBLK); SDMA(2, 2 * KVBLK); SDMA(3, 3 * KVBLK); SWAIT(); BAR();
  if (halfB) { BAR(); __builtin_amdgcn_s_setprio(1); }
  v8i_a ka[2][2]; v8i_p vb[2];
  ldK8(ka, KB(0), r32, hi);
  qk_mma<true>(p0, p1, ka, qr, negm);
  BAR();
  SDMA(4, 4 * KVBLK);
  ldK8(ka, KB(1), r32, hi); ldV8(vb, VB(0), 0, r32, hi); SBAR();
  partialSM2<true>(p0, p1, negm, al, hi); finishSM8n(p0, p1, pa); SBAR(); BAR();
#pragma unroll 1
  for (int tau = 1; tau < NT; ++tau) {
    { v8i_p vc[2];
      qk_mma<false>(p0, p1, ka, qr, negm); SBAR();
      ldV8(vc, VB((tau - 1) & 7), 1, r32, hi); SBAR();
      pv_mma0(o, pa, vb); pv_mma1(o, lacc, pa, vc, ones4); SBAR(); }
    if (tau + 3 < NT) asm volatile("s_waitcnt vmcnt(2)" ::: "memory"); else asm volatile("s_waitcnt vmcnt(0)" ::: "memory");
    BAR();
    if (tau + 4 < NT) SDMA((tau + 4) & 7, (tau + 4) * KVBLK);
    if (tau + 1 < NT) ldK8(ka, KB((tau + 1) & 7), r32, hi);
    ldV8(vb, VB(tau & 7), 0, r32, hi); SBAR();
    partialSM2<false>(p0, p1, negm, al, hi);
    RESC(al);
    finishSM8n(p0, p1, pa); SBAR();
    BAR();
  }
  { v8i_p vc[2]; ldV8(vc, VB((NT - 1) & 7), 1, r32, hi); pv_mma0(o, pa, vb); pv_mma1(o, lacc, pa, vc, ones4); }
  if (!halfB) BAR();
  __builtin_amdgcn_s_setprio(0);
#undef BAR
#undef KB
#undef VB
  asm volatile("s_nop 15\n\ts_nop 15\n\ts_nop 15\n\ts_nop 15" ::: "memory");
  float rli[16];
#pragma unroll
  for (int r = 0; r < 16; ++r) rli[r] = __builtin_amdgcn_rcpf(lacc[r]);
  unsigned char* Ow = Ob + (long)(wid * QBLK) * LDO;
#pragma unroll
  for (int r = 0; r < 16; ++r) { int orow = crow(r, hi);
    for (int d0 = 0; d0 < 4; ++d0) { const int pk = __builtin_amdgcn_cvt_pk_fp8_f32(o[d0][r] * rli[r], 0.f, 0, false); Ow[(long)orow * LDO + d0 * 32 + r32] = (unsigned char)(pk & 0xff); } }
  __syncthreads();
#undef SDMA
#undef SWAIT
#undef RESC
}

}
#define GAS __attribute__((address_space(1)))
#define LAS __attribute__((address_space(3)))
typedef unsigned short bf16;
typedef unsigned v4u __attribute__((ext_vector_type(4)));
typedef float f32x4 __attribute__((ext_vector_type(4)));
typedef short bf16x8 __attribute__((ext_vector_type(8)));
typedef GAS unsigned gu32;
typedef GAS unsigned long long gu64;
#define RLX_AGENT __ATOMIC_RELAXED, __HIP_MEMORY_SCOPE_AGENT
#define LDS_WAIT() asm volatile("s_waitcnt lgkmcnt(0)" ::: "memory")
#define VM_WAIT() asm volatile("s_waitcnt vmcnt(0)" ::: "memory")
__device__ __forceinline__ unsigned long long rt() { return __builtin_amdgcn_s_memrealtime(); }
__device__ __forceinline__ unsigned f2bf(float f) { unsigned u = __builtin_bit_cast(unsigned, f); return (u + 0x7fffu + ((u >> 16) & 1u)) >> 16; }
__device__ __forceinline__ unsigned pk2(float lo, float hi) { unsigned r; asm volatile("v_cvt_pk_bf16_f32 %0, %1, %2" : "=v"(r) : "v"(lo), "v"(hi)); return r; }

#define XB_TMO      128
#define XB_XCNT(j)  (256  + 64 * (j))
#define XB_XSUB(j)  (1280 + 64 * (j))
#define XB_XGEN(j)  (2304 + 64 * (j))
#define XB_TOP      3328
#define XB_TOPGEN   3392
#define XCD_BAR_WORDS 3456
#define XB_SPIN_CAP (1u << 18)

__device__ __forceinline__ unsigned xb_ld(unsigned* p)              { return __hip_atomic_load(p, __ATOMIC_RELAXED, __HIP_MEMORY_SCOPE_AGENT); }
__device__ __forceinline__ unsigned xb_add(unsigned* p, unsigned v) { return __hip_atomic_fetch_add(p, v, __ATOMIC_RELAXED, __HIP_MEMORY_SCOPE_AGENT); }
__device__ __forceinline__ unsigned xb_xcc_id() { return (unsigned)__builtin_amdgcn_s_getreg((3 << 11) | 20) & 0xFu; }
#define XB_SPIN(cond, bar) do { unsigned _sp = 0; while (cond) { __builtin_amdgcn_s_sleep(1); \
    if ((++_sp & 255u) == 0u) { if (xb_ld(&(bar)[XB_TMO])) break; if (_sp > XB_SPIN_CAP) { atomicAdd(&(bar)[XB_TMO], 1u); break; } } } } while (0)

struct XcdBarrier {
    unsigned* bar; unsigned x;
    volatile LAS unsigned* st;
};

__device__ __forceinline__ XcdBarrier xcd_barrier_post(unsigned* bar, volatile LAS unsigned* st) {
    XcdBarrier b; b.bar = bar; b.x = xb_xcc_id(); b.st = st;
    if (threadIdx.x == 0) (void)xb_add(&bar[XB_XCNT(b.x)], 1u);
    return b;
}
__device__ __forceinline__ void xcd_barrier_complete(unsigned* bar, unsigned x, unsigned& nloc, unsigned& nx) {
    const unsigned G = gridDim.x * gridDim.y * gridDim.z;
    unsigned sum, cnt, mine, sp = 0u;
    for (;;) {
        sum = 0u; cnt = 0u; mine = 0u;
#pragma unroll
        for (unsigned j = 0; j < 16; ++j) { const unsigned c = xb_ld(&bar[XB_XCNT(j)]); sum += c; cnt += (c > 0u) ? 1u : 0u; mine = (j == x) ? c : mine; }
        if (sum == G) break;
        __builtin_amdgcn_s_sleep(1);
        if ((++sp & 255u) == 0u) { if (xb_ld(&bar[XB_TMO])) break; if (sp > XB_SPIN_CAP) { atomicAdd(&bar[XB_TMO], 1u); break; } }
    }
    nloc = mine > 0u ? mine : 1u; nx = cnt > 0u ? cnt : 1u;
}

__device__ __forceinline__ void xcd_barrier(const XcdBarrier& b) {
    asm volatile("s_waitcnt vmcnt(0)" ::: "memory");
    __syncthreads();
    if (threadIdx.x == 0) {
        unsigned* bar = b.bar;
        __builtin_amdgcn_s_waitcnt(0);
        unsigned nloc = b.st[0], nx = b.st[1];
        if (nloc == 0u) { xcd_barrier_complete(bar, b.x, nloc, nx); b.st[0] = nloc; b.st[1] = nx; }
        const unsigned old = xb_add(&bar[XB_XSUB(b.x)], 1u);
        const unsigned gen = old / nloc;
        if (old + 1u == (gen + 1u) * nloc) {
            __builtin_amdgcn_fence(__ATOMIC_RELEASE, "agent");
            asm volatile("s_waitcnt vmcnt(0)" ::: "memory");
            const unsigned og = xb_add(&bar[XB_TOP], 1u);
            const unsigned tg = og / nx;
            if (og + 1u == (tg + 1u) * nx) xb_add(&bar[XB_TOPGEN], 1u);
            else XB_SPIN(xb_ld(&bar[XB_TOPGEN]) == tg, bar);
            __builtin_amdgcn_fence(__ATOMIC_ACQUIRE, "agent");
            xb_add(&bar[XB_XGEN(b.x)], 1u);
            asm volatile("s_waitcnt vmcnt(0)" ::: "memory");
        } else {
            XB_SPIN(xb_ld(&bar[XB_XGEN(b.x)]) == gen, bar);
            __builtin_amdgcn_fence(__ATOMIC_ACQUIRE, "agent");
            asm volatile("s_waitcnt vmcnt(0)" ::: "memory");
        }
    }
    __syncthreads();
}
constexpr int NWAVES = 8;
constexpr int BATCH = 2, SEQ = 8192, DM = 2048, NTOK = BATCH * SEQ;
constexpr int INW = 8704, COL_Q = 0, COL_K = 1024, COL_V = 1280, COL_HY = 1536, COL_G = 4608;
constexpr int HW = 1024;
constexpr int NEXP = 32, DEXP = 1024;
constexpr int FHID = 64;
constexpr float LN_EPS = 1e-5f, QK_EPS = 1e-6f, FILTER_EPS = 1e-6f;
constexpr float ALPHA = 1.189207115002721f;
constexpr int MAXROWS = 2 * NTOK + NEXP * 256;
constexpr int ELIST = NTOK;

constexpr size_t MiB = 1u << 20;
constexpr size_t WS_CTL = 0, CTL_ZERO_BYTES = 1 * MiB;
constexpr size_t WS_STATS = 1 * MiB;
constexpr size_t WS_ROPEC = 2 * MiB, WS_ROPES = 4 * MiB;
constexpr size_t WS_H2 = 6 * MiB;
constexpr size_t WS_WRT = 8 * MiB;
constexpr size_t WS_ETOK = 9 * MiB;
constexpr size_t WS_EW = 11 * MiB;
constexpr size_t WS_META = 13 * MiB;
constexpr size_t WS_WIN = 16 * MiB;
constexpr size_t WS_WIN8 = 34 * MiB;
constexpr size_t WS_XN8 = 514 * MiB;
constexpr size_t WS_WCAT = 50 * MiB;
constexpr size_t WS_WOUT = 58 * MiB;
constexpr size_t WS_WGU = 66 * MiB;
constexpr size_t WS_WD = 322 * MiB;
constexpr size_t WS_XN = 450 * MiB;
constexpr size_t WS_ACAT = 450 * MiB;
constexpr size_t WS_KR = 514 * MiB;
constexpr size_t WS_MRG = 514 * MiB;
constexpr size_t WS_X0C = 546 * MiB;
constexpr size_t WS_Y = 450 * MiB;
constexpr size_t WS_ZT = 578 * MiB;
constexpr size_t WS_KT = 642 * MiB;
constexpr size_t WS_PROJ = 706 * MiB;
constexpr size_t WS_PRE1 = 706 * MiB;
constexpr size_t WS_H1B = 834 * MiB;
constexpr size_t WS_HB = 898 * MiB;
constexpr size_t WS_KC = 978 * MiB;
constexpr size_t WS_VC = 986 * MiB;
constexpr size_t WS_END = 994 * MiB;
constexpr int CW_TMO = 0, CW_CODE = 1;
constexpr int CW_BAR = 4096;
constexpr int CW_ECNT = 16384;

constexpr int LDS_BYTES = 147456;
constexpr int LDSCTL_OFF = 145408;
constexpr int L_MISC = LDSCTL_OFF;
constexpr int L_CNT = LDSCTL_OFF + 128;
constexpr int L_OFF = LDSCTL_OFF + 256;
constexpr int L_RBX = LDSCTL_OFF + 512;
constexpr int L_LB = LDSCTL_OFF + 1280;

struct Args { const float* in[31]; float* out; unsigned char* ws; int ph_lo, ph_hi; };
typedef unsigned long long u64;
typedef float f32x2 __attribute__((ext_vector_type(2)));
typedef unsigned u32x2 __attribute__((ext_vector_type(2)));

__device__ __forceinline__ float wave_sum(float v) {
#pragma unroll
    for (int o = 1; o < 64; o <<= 1) v += __shfl_xor(v, o);
    return v;
}
__device__ __forceinline__ float bf_lo(unsigned w) { return __uint_as_float(w << 16); }
__device__ __forceinline__ float bf_hi(unsigned w) { return __uint_as_float(w & 0xffff0000u); }
__device__ __forceinline__ float bf_1(bf16 b) { return __uint_as_float((unsigned)b << 16); }

constexpr int W_IN = 32 * 12, W_AO = 16 * 8, W_HY = 16 * 8, W_OUT = 32 * 8, W_GU = 32 * 32 * 8, W_D = 32 * 16 * 8;
constexpr int NWITEMS = W_IN + W_HY + W_OUT;
constexpr int W8_GU = 32 * 16 * 8, W8_D = 32 * 8 * 8, NW8 = W8_GU + W8_D, W8_IN = 22 * 16, W8_AO = 8 * 8;
struct ConvItem { const float* srcL; const float* srcR; bf16* dst; int N; };
__device__ __forceinline__ bf16* tile_ptr(bf16* base, int K, int rt, int kb) { return base + ((size_t)rt * (K >> 6) + kb) * 16384; }
__device__ __forceinline__ ConvItem conv_decode(const Args& a, int it) {
    unsigned char* ws = a.ws; ConvItem c; int r = it;
    if (r < W_IN) { const int kb = r / 12, nt = r % 12; c.N = INW; c.srcL = a.in[3] + (size_t)(kb * 64) * INW + COL_HY + nt * 256; c.srcR = c.srcL + 128; c.dst = tile_ptr((bf16*)(ws + WS_WIN), 2048, nt, kb); return c; } r -= W_IN;
    if (r < W_HY) { const int kb = r >> 3, nt = r & 7; c.N = 2048; c.srcL = a.in[18] + (size_t)(kb * 64) * 2048 + nt * 256; c.srcR = c.srcL + 128; c.dst = (bf16*)(ws + WS_WCAT + ((size_t)nt * 24 + 8 + kb) * 32768); return c; } r -= W_HY;
    { const int kb = r >> 3, nt = r & 7; c.N = 2048; c.srcL = a.in[19] + (size_t)(kb * 64) * 2048 + nt * 256; c.srcR = c.srcL + 128; c.dst = tile_ptr((bf16*)(ws + WS_WOUT), 2048, nt, kb); return c; }
}
__device__ __forceinline__ ConvItem conv_decode8(const Args& a, int it) {
    unsigned char* ws = a.ws; ConvItem c;
    if (it < W8_GU) { const int e = it >> 7, q = it & 127, kb = q >> 3, t = q & 7; c.N = 1024; const size_t off = (size_t)e * 2048 * 1024 + (size_t)(kb * 128) * 1024 + t * 128;
        c.srcL = a.in[26] + off; c.srcR = a.in[27] + off; c.dst = (bf16*)(ws + WS_WGU + ((size_t)(e * 8 + t) * 16 + kb) * 32768); return c; }
    if (it >= NW8 + W8_IN) { const int r = it - NW8 - W8_IN, kb = r >> 3, nt = r & 7; c.N = 2048; c.srcL = a.in[17] + (size_t)(kb * 128) * 2048 + nt * 256; c.srcR = c.srcL + 128;
        c.dst = (bf16*)(ws + WS_WCAT + ((size_t)nt * 24 + kb) * 32768); return c; }
    if (it >= NW8) { const int r = it - NW8, kb = r / 22, nt = r % 22; c.N = INW; c.srcL = a.in[3] + (size_t)(kb * 128) * INW + (nt < 6 ? nt * 256 : COL_G + (nt - 6) * 256); c.srcR = c.srcL + 128;
        c.dst = (bf16*)(ws + WS_WIN8 + ((size_t)nt * 16 + kb) * 32768); return c; }
    const int r = it - W8_GU, e = r >> 6, q = r & 63, kb = q >> 3, nt = q & 7; c.N = 2048;
    c.srcL = a.in[28] + (size_t)e * 1024 * 2048 + (size_t)(kb * 128) * 2048 + nt * 256; c.srcR = c.srcL + 128; c.dst = (bf16*)(ws + WS_WD + ((size_t)(e * 8 + nt) * 8 + kb) * 32768); return c;
}
__device__ __forceinline__ unsigned pk4_fp8(float a, float b, float c, float d) { int w = 0; w = __builtin_amdgcn_cvt_pk_fp8_f32(a, b, w, false); w = __builtin_amdgcn_cvt_pk_fp8_f32(c, d, w, true); return (unsigned)w; }
__device__ __forceinline__ void tr_load(f32x4 (&v)[8], const ConvItem& c, int wave, int lane, int row0 = 0) {
    const float* s = ((lane < 32) ? c.srcL : c.srcR) + 4 * (lane & 31);
#pragma unroll
    for (int i = 0; i < 8; ++i) v[i] = *(const GAS f32x4*)(s + (size_t)(row0 + wave * 8 + i) * c.N);
}
__device__ __forceinline__ void tr_write(const f32x4 (&v)[8], LAS float* scr, int wave, int lane) {
#pragma unroll
    for (int i = 0; i < 8; ++i) *(LAS f32x4*)(scr + (wave * 8 + i) * 256 + ((4 * lane) ^ (4 * wave))) = v[i];
}
__device__ __forceinline__ void tr_emit(const ConvItem& c, const LAS float* scr, int tid) {
    const int kc = tid & 7;
#pragma unroll
    for (int j = 0; j < 4; ++j) { const int n = (tid >> 3) + 64 * j; const LAS float* s = scr + (8 * kc) * 256 + (n ^ (4 * kc));
        v4u o; o.x = pk2(s[0 * 256], s[1 * 256]); o.y = pk2(s[2 * 256], s[3 * 256]); o.z = pk2(s[4 * 256], s[5 * 256]); o.w = pk2(s[6 * 256], s[7 * 256]);
        *(GAS v4u*)(c.dst + n * 64 + 8 * kc) = o; }
}
__device__ __forceinline__ void tr_emit8(const ConvItem& c, const LAS float* scr0, int tid) {
    const int kc = tid & 7; const LAS float* tile = scr0 + (kc >> 2) * (64 * 256); const int k0 = 16 * (kc & 3);
#pragma unroll
    for (int j = 0; j < 4; ++j) { const int n = (tid >> 3) + 64 * j; float f[16];
#pragma unroll
        for (int e = 0; e < 16; ++e) f[e] = tile[(k0 + e) * 256 + (n ^ (4 * ((k0 + e) >> 3)))] * 256.f;
        v4u o; o.x = pk4_fp8(f[0], f[1], f[2], f[3]); o.y = pk4_fp8(f[4], f[5], f[6], f[7]); o.z = pk4_fp8(f[8], f[9], f[10], f[11]); o.w = pk4_fp8(f[12], f[13], f[14], f[15]);
        *(GAS v4u*)((unsigned char*)c.dst + n * 128 + 16 * kc) = o; }
}
__device__ __forceinline__ void cv8_load(f32x4 (&v)[16], const ConvItem& c, int wave, int lane) {
    const float* s = ((lane < 32) ? c.srcL : c.srcR) + 4 * (lane & 31) + (size_t)(16 * wave) * c.N;
#pragma unroll
    for (int i = 0; i < 16; ++i) v[i] = *(const GAS f32x4*)(s + (size_t)i * c.N);
}
__device__ __forceinline__ void cv8_emit(const f32x4 (&v)[16], const ConvItem& c, LAS unsigned char* T, int wave, int lane) {
#pragma unroll
    for (int j = 0; j < 4; ++j) { v4u o;
        o.x = pk4_fp8(v[0][j] * 256.f, v[1][j] * 256.f, v[2][j] * 256.f, v[3][j] * 256.f);     o.y = pk4_fp8(v[4][j] * 256.f, v[5][j] * 256.f, v[6][j] * 256.f, v[7][j] * 256.f);
        o.z = pk4_fp8(v[8][j] * 256.f, v[9][j] * 256.f, v[10][j] * 256.f, v[11][j] * 256.f);  o.w = pk4_fp8(v[12][j] * 256.f, v[13][j] * 256.f, v[14][j] * 256.f, v[15][j] * 256.f);
        *(LAS v4u*)(T + (4 * lane + j) * 128 + 16 * (wave ^ (lane & 7))) = o; }
    LDS_WAIT(); __syncthreads();
#pragma unroll
    for (int q = 0; q < 4; ++q) { const int r = wave * 32 + q * 8 + (lane >> 3), ch = lane & 7;
        const v4u w = *(const LAS v4u*)(T + r * 128 + 16 * (ch ^ ((r >> 2) & 7)));
        *(GAS v4u*)((unsigned char*)c.dst + r * 128 + 16 * ch) = w; }
}
__device__ __forceinline__ void conv_items_fp8(const Args& a, LAS unsigned char* lds, int first, int last, int wg, int nwg, int tid) {
    const int wave = __builtin_amdgcn_readfirstlane(tid >> 6), lane = tid & 63;
    int it0 = first + wg, it1 = it0 + nwg, it2 = it1 + nwg;
    if (it0 >= last) return;
    f32x4 v0[16], v1[16], v2[16];
    ConvItem c0 = conv_decode8(a, it0), c1 = c0, c2 = c0;
    cv8_load(v0, c0, wave, lane);
    if (it1 < last) { c1 = conv_decode8(a, it1); cv8_load(v1, c1, wave, lane); }
    LAS unsigned char* T0 = lds; LAS unsigned char* T1 = lds + 32768;
    for (;;) {
        if (it2 < last) { c2 = conv_decode8(a, it2); cv8_load(v2, c2, wave, lane); }
        cv8_emit(v0, c0, T0, wave, lane);
        if (it1 >= last) break;
        it0 = it2 + nwg;
        if (it0 < last) { c0 = conv_decode8(a, it0); cv8_load(v0, c0, wave, lane); }
        cv8_emit(v1, c1, T1, wave, lane);
        if (it2 >= last) break;
        it1 = it0 + nwg;
        if (it1 < last) { c1 = conv_decode8(a, it1); cv8_load(v1, c1, wave, lane); }
        cv8_emit(v2, c2, T0, wave, lane);
        if (it0 >= last) break;
        it2 = it1 + nwg;
        { LAS unsigned char* t_ = T0; T0 = T1; T1 = t_; }
    }
    LDS_WAIT(); __syncthreads();
}
__device__ __forceinline__ void conv_items(const Args& a, LAS unsigned char* lds, int first, int last, int wg, int nwg, int tid) {
    LAS float* scr0 = (LAS float*)lds; LAS float* scr1 = scr0 + 64 * 256;
    const int wave = __builtin_amdgcn_readfirstlane(tid >> 6), lane = tid & 63;
    int it = first + wg;
    if (it >= last) return;
    f32x4 vA0[8], vA1[8], vB0[8], vB1[8];
    ConvItem cA0 = conv_decode(a, it), cA1 = cA0, cB0 = cA0, cB1 = cA0;
    bool hA1 = it + nwg < last, hB0 = false, hB1 = false;
    tr_load(vA0, cA0, wave, lane); if (hA1) { cA1 = conv_decode(a, it + nwg); tr_load(vA1, cA1, wave, lane); }
    for (;;) {
        int nx = it + 2 * nwg; hB0 = nx < last; hB1 = nx + nwg < last;
        if (hB0) { cB0 = conv_decode(a, nx); tr_load(vB0, cB0, wave, lane); } if (hB1) { cB1 = conv_decode(a, nx + nwg); tr_load(vB1, cB1, wave, lane); }
        tr_write(vA0, scr0, wave, lane); if (hA1) tr_write(vA1, scr1, wave, lane);
        LDS_WAIT(); __syncthreads();
        tr_emit(cA0, scr0, tid); if (hA1) tr_emit(cA1, scr1, tid);
        LDS_WAIT(); __syncthreads();
        if (!hB0) break;
        it = nx; nx = it + 2 * nwg; const bool h0 = nx < last; hA1 = nx + nwg < last;
        if (h0) { cA0 = conv_decode(a, nx); tr_load(vA0, cA0, wave, lane); } if (hA1) { cA1 = conv_decode(a, nx + nwg); tr_load(vA1, cA1, wave, lane); }
        tr_write(vB0, scr0, wave, lane); if (hB1) tr_write(vB1, scr1, wave, lane);
        LDS_WAIT(); __syncthreads();
        tr_emit(cB0, scr0, tid); if (hB1) tr_emit(cB1, scr1, tid);
        LDS_WAIT(); __syncthreads();
        if (!h0) break;
        it = nx;
    }
}
__device__ __forceinline__ void p0_prologue(const Args& a, LAS unsigned char* lds, int gw, int NGW, int wave, int lane) {
    unsigned char* ws = a.ws;
    conv_items(a, lds, 0, W_IN, gw / NWAVES, NGW / NWAVES, wave * 64 + lane); __syncthreads(); conv_items_fp8(a, lds, NW8, NW8 + W8_IN, gw / NWAVES, NGW / NWAVES, wave * 64 + lane); __syncthreads();
    {
        const float* g = a.in[1]; const float* b = a.in[2]; bf16* XN = (bf16*)(ws + WS_XN);
        for (int m = gw; m < NTOK; m += NGW) {
            const GAS f32x4* xr = (const GAS f32x4*)(a.in[0] + (size_t)m * DM) + lane;
            f32x4 v[8]; float s = 0.f;
#pragma unroll
            for (int j = 0; j < 8; ++j) { v[j] = xr[64 * j]; s += (v[j].x + v[j].y) + (v[j].z + v[j].w); }
            const float mean = wave_sum(s) * (1.f / DM); float s2 = 0.f;
#pragma unroll
            for (int j = 0; j < 8; ++j) { v[j] = v[j] - mean; s2 += (v[j].x * v[j].x + v[j].y * v[j].y) + (v[j].z * v[j].z + v[j].w * v[j].w); }
            const float rstd = 1.f / sqrtf(wave_sum(s2) * (1.f / DM) + LN_EPS);
            GAS u64* o8 = (GAS u64*)(XN + (size_t)m * DM) + lane; GAS u64* h8 = (GAS u64*)((bf16*)a.out + (size_t)m * DM) + lane; GAS unsigned* x8 = (GAS unsigned*)(ws + WS_XN8 + (size_t)m * DM) + lane;
#pragma unroll
            for (int j = 0; j < 8; ++j) { const f32x4 gg = *(const f32x4*)(g + 4 * lane + 256 * j), bb = *(const f32x4*)(b + 4 * lane + 256 * j); const f32x4 y = v[j] * rstd * gg + bb, ya = y * ALPHA;
                o8[64 * j] = (u64)pk2(y.x, y.y) | ((u64)pk2(y.z, y.w) << 32); h8[64 * j] = (u64)pk2(ya.x, ya.y) | ((u64)pk2(ya.z, ya.w) << 32); x8[64 * j] = pk4_fp8(y.x, y.y, y.z, y.w); }
        }
    }
    const int gt = gw * 64 + lane, NGT = NGW * 64;
    {
        float* WRT = (float*)(ws + WS_WRT); float* RC = WRT + 48 * 2048; const float* g1 = a.in[20]; const float* b1 = a.in[21];
        for (int i = gt; i < 48 * 2048; i += NGT) { const int col = i >> 11, k = i & 2047; float v = 0.f;
            if (col < 4) v = a.in[22][k * 4 + col]; else if (col < 36) v = a.in[24][k * 32 + (col - 4)];
            const float wv = v * g1[k]; WRT[i] = wv;
            unsigned uh = __float_as_uint(wv); uh += 0x7fffu + ((uh >> 16) & 1u); uh &= 0xffff0000u; const float rem = wv - __uint_as_float(uh);
            unsigned ul = __float_as_uint(rem); ul += 0x7fffu + ((ul >> 16) & 1u);
            ((unsigned short*)(ws + WS_WRT + 512 * 1024))[i] = (unsigned short)(uh >> 16); ((unsigned short*)(ws + WS_WRT + 768 * 1024))[i] = (unsigned short)(ul >> 16); }
        for (int col = gw; col < 48; col += NGW) { float s1 = 0.f, s2 = 0.f;
            if (col < 36) for (int k = lane; k < 2048; k += 64) { const float w = (col < 4) ? a.in[22][k * 4 + col] : a.in[24][k * 32 + (col - 4)]; s1 += g1[k] * w; s2 += b1[k] * w; }
            s1 = wave_sum(s1); s2 = wave_sum(s2);
            if (lane == 0) { RC[col] = s1; RC[48 + col] = s2 + ((col < 4) ? a.in[23][col] : (col < 36 ? a.in[25][col - 4] : 0.f)); } }
    }
    {
        float* rc = (float*)(ws + WS_ROPEC); float* rs = (float*)(ws + WS_ROPES);
        for (int i = gt; i < SEQ * 64; i += NGT) { const int t = i >> 6, f = i & 63; const int pos = (f < 32) ? (t >> 6) : (t & 63); const int fi = f & 31;
            const float inv = exp2f(-(float)fi * (13.287712379549449f / 32.0f));
            const float ang = (float)pos * inv;
            rc[i] = cosf(ang); rs[i] = sinf(ang); }
    }
    {
        const float* w1 = a.in[9]; const float* b1 = a.in[10]; const float* f1 = a.in[11]; const float* w2 = a.in[12]; const float* b2 = a.in[13]; const float* f2 = a.in[14];
        float* H2 = (float*)(ws + WS_H2);
        LAS float* fe = (LAS float*)(lds + 8 * 17408); LAS float* h1s = fe + 8 * 33;
        const int tid = wave * 64 + lane, p = tid >> 6, m = tid & 63;
        for (int blk = gw / NWAVES; blk < SEQ / 8; blk += NGW / NWAVES) {
            __syncthreads();
            if (tid < 8 * 33) { const int pp = tid / 33, i = tid % 33, j = blk * 8 + pp; float v;
                if (i == 0) v = (float)j / (float)(SEQ - 1);
                else { const int bi = (i - 1) & 15; const double band = 1e-4 + (double)bi * ((15.0 - 1e-4) / 15.0); const double ar = band * (6.283185307179586 * (double)j / (double)SEQ);
                    v = (i <= 16) ? (float)cos(ar) : (float)(-sin(ar)); }
                fe[tid] = v; }
            __syncthreads();
            { float acc = b1[m];
#pragma unroll
              for (int i = 0; i < 33; ++i) acc += fe[p * 33 + i] * w1[i * 64 + m];
              h1s[p * 64 + m] = sinf(f1[m] * acc); }
            __syncthreads();
            { float acc = b2[m];
#pragma unroll 16
              for (int i = 0; i < 64; ++i) acc += h1s[p * 64 + i] * w2[i * 64 + m];
              H2[(size_t)(blk * 8 + p) * 64 + m] = sinf(f2[m] * acc); }
        }
    }
}

__device__ __forceinline__ void p2_qk(const Args& a, int gw, int NGW, int lane) {
    bf16* PROJ = (bf16*)(a.ws + WS_PROJ); const float* rc = (const float*)(a.ws + WS_ROPEC); const float* rs = (const float*)(a.ws + WS_ROPES);
    unsigned short* KC8 = (unsigned short*)(a.ws + WS_KC);
    const float gq0 = a.in[5][2 * lane], gq1 = a.in[5][2 * lane + 1], gk0 = a.in[6][2 * lane], gk1 = a.in[6][2 * lane + 1];
    const int idx = (lane >> 5) * 32 + ((2 * lane) & 31); const float sgn = (lane & 16) ? 1.f : -1.f;
    for (int tok = gw; tok < NTOK; tok += NGW) {
        const int t = tok & (SEQ - 1);
        const float c0 = rc[t * 64 + idx], c1 = rc[t * 64 + idx + 1], s0 = rs[t * 64 + idx] * sgn, s1 = rs[t * 64 + idx + 1] * sgn;
        unsigned* row = (unsigned*)(PROJ + (size_t)tok * INW) + lane;
#pragma unroll
        for (int h = 0; h < 10; ++h) {
            const unsigned w = row[h * 64];
            float x0 = bf_lo(w), x1 = bf_hi(w);
            const float rn = rsqrtf(wave_sum(x0 * x0 + x1 * x1) * (1.f / 128.f) + QK_EPS);
            x0 *= rn * (h < 8 ? gq0 : gk0); x1 *= rn * (h < 8 ? gq1 : gk1);
            const float p0 = __shfl_xor(x0, 16), p1 = __shfl_xor(x1, 16);
            const unsigned o = pk2(x0 * c0 + p0 * s0, x1 * c1 + p1 * s1);
            if (h < 8) row[h * 64] = o;
            else { int d = 0; d = __builtin_amdgcn_cvt_pk_fp8_f32(x0 * c0 + p0 * s0, x1 * c1 + p1 * s1, d, false);
                   KC8[(((size_t)(tok >> 13) * 2 + (h - 8)) * SEQ + t) * 64 + lane] = (unsigned short)d; }
        }
    }
}
__device__ __forceinline__ void p2_vt8(const Args& a, LAS unsigned char* lds, int vcu, int G, int tid) {
    const bf16* PROJ = (const bf16*)(a.ws + WS_PROJ); unsigned char* VT8 = (unsigned char*)(a.ws + WS_VC);
    LAS unsigned char* tl = lds;
    for (int it = vcu; it < 2 * 2 * (SEQ / 64); it += G) {
        const int tile = it & 127, kvh = (it >> 7) & 1, b = it >> 8;
#if defined(BREAK_ATTN)
        const int t = tid >> 3, dc = tid & 7, pos = t;
#else
        const int t = tid >> 3, dc = tid & 7, pos = attn::vt_pos(t);
#endif
        const bf16* src = PROJ + (size_t)(b * SEQ + tile * 64 + t) * INW + COL_V + kvh * 128 + dc * 16;
        const v4u w0 = *(const v4u*)src, w1 = *(const v4u*)(src + 8);
        const unsigned ww[8] = {w0.x, w0.y, w0.z, w0.w, w1.x, w1.y, w1.z, w1.w};
#pragma unroll
        for (int i = 0; i < 8; ++i) { const int d2 = __builtin_amdgcn_cvt_pk_fp8_f32(bf_lo(ww[i]), bf_hi(ww[i]), 0, false);
            tl[(dc * 16 + 2 * i) * 64 + pos] = (unsigned char)(d2 & 0xff); tl[(dc * 16 + 2 * i + 1) * 64 + pos] = (unsigned char)((d2 >> 8) & 0xff); }
        __syncthreads();
        *(GAS v4u*)(VT8 + ((size_t)((b * 2 + kvh) * 128 + tile)) * 8192 + tid * 16) = *(const LAS v4u*)(tl + tid * 16);
        __syncthreads();
    }
}
#if defined(CHECK_ATTN)
#ifndef CHECK_TOL
#define CHECK_TOL 0.3f
#endif
__device__ __forceinline__ float wave_max(float v) {
#pragma unroll
    for (int o = 1; o < 64; o <<= 1) v = fmaxf(v, __shfl_xor(v, o));
    return v;
}
__device__ __forceinline__ void check_attn(const Args& a, int gw, int NGW, int lane) {
    const bf16* PROJ = (const bf16*)(a.ws + WS_PROJ); const unsigned char* O = (const unsigned char*)(a.ws + WS_ACAT); const float* rc = (const float*)(a.ws + WS_ROPEC); const float* rs = (const float*)(a.ws + WS_ROPES);
    gu32* ctl = (gu32*)(a.ws + WS_CTL);
    const float gk0 = a.in[6][2 * lane], gk1 = a.in[6][2 * lane + 1];
    const int idx = (lane >> 5) * 32 + ((2 * lane) & 31); const float sgn = (lane & 16) ? 1.f : -1.f;
    for (int s = gw; s < 2048; s += NGW) {
        const int b = s & 1, hq = (s >> 1) & 7, t = ((s >> 4) * 64 + 13 + 7 * hq) & (SEQ - 1), kvh = hq >> 2;
        const unsigned qw = *((const unsigned*)(PROJ + (size_t)(b * SEQ + t) * INW + hq * 128) + lane);
        const float q0 = bf_lo(qw), q1 = bf_hi(qw);
        float m = -1e30f, l = 0.f, a0 = 0.f, a1 = 0.f;
        for (int j = 0; j < SEQ; ++j) {
            const unsigned* row = (const unsigned*)(PROJ + (size_t)(b * SEQ + j) * INW);
            const unsigned kw = row[(COL_K >> 1) + kvh * 64 + lane], vw = row[(COL_V >> 1) + kvh * 64 + lane];
            float x0 = bf_lo(kw), x1 = bf_hi(kw);
            const float rn = rsqrtf(wave_sum(x0 * x0 + x1 * x1) * (1.f / 128.f) + QK_EPS);
            x0 *= rn * gk0; x1 *= rn * gk1;
            const float p0 = __shfl_xor(x0, 16), p1 = __shfl_xor(x1, 16);
            const float k0 = x0 * rc[j * 64 + idx] + p0 * rs[j * 64 + idx] * sgn, k1 = x1 * rc[j * 64 + idx + 1] + p1 * rs[j * 64 + idx + 1] * sgn;
            const float sc = wave_sum(q0 * k0 + q1 * k1) * 0.088388347648318440f;
            const float mn = fmaxf(m, sc), al = expf(m - mn), p = expf(sc - mn);
            l = l * al + p; a0 = a0 * al + p * bf_lo(vw); a1 = a1 * al + p * bf_hi(vw); m = mn;
        }
        const float r0 = a0 / l, r1 = a1 / l;
        const int ow = (int)*((const unsigned short*)(O + (size_t)(b * SEQ + t) * 3072 + hq * 128) + lane);
        const float o0 = __builtin_amdgcn_cvt_f32_fp8(ow, 0), o1 = __builtin_amdgcn_cvt_f32_fp8(ow, 1);
        const float err = wave_max(fmaxf(fabsf(r0 - o0), fabsf(r1 - o1))), mag = wave_max(fmaxf(fabsf(r0), fabsf(r1)));
        if (lane == 0 && !(err <= CHECK_TOL * mag + 1e-4f)) __hip_atomic_store(ctl + 12, 1u, RLX_AGENT);
    }
}
__device__ __forceinline__ void check_merge(const Args& a, int gw, int NGW, int lane) {
    const unsigned char* AC = (const unsigned char*)(a.ws + WS_ACAT); const bf16* PROJ = (const bf16*)(a.ws + WS_PROJ); const bf16* MRG = (const bf16*)(a.ws + WS_MRG);
    const float* wa = a.in[17]; const float* wh = a.in[18]; gu32* ctl = (gu32*)(a.ws + WS_CTL);
    for (int s = gw; s < 2048; s += NGW) {
        const int r = (s * 8 + 5) & (NTOK - 1), c = ((s * 37) & 31) * 64 + lane;
        const unsigned char* row = AC + (size_t)r * 3072; const bf16* ah = (const bf16*)(row + 1024);
        float ya = 0.f, yh = 0.f;
        for (int k = 0; k < 1024; ++k) { ya += __builtin_amdgcn_cvt_f32_fp8((int)row[k], 0) * wa[(size_t)k * 2048 + c]; yh += bf_1(ah[k]) * wh[(size_t)k * 2048 + c]; }
        const float ga = bf_1(PROJ[(size_t)r * INW + COL_G + c]), gh = bf_1(PROJ[(size_t)r * INW + COL_G + DM + c]);
        const float est = (bf_1(MRG[(size_t)r * DM + c]) - gh * yh) / fmaxf(ga, 1e-6f);
        const float s1 = wave_sum(est * ya), s2 = wave_sum(ya * ya);
        if (lane == 0 && !(s1 >= 0.7f * s2 && s1 <= 1.4f * s2)) __hip_atomic_store(ctl + 12, 1u, RLX_AGENT);
    }
}
#endif
__device__ __forceinline__ void p2_conv(const Args& a, LAS unsigned char* lds, int vcu, int G, int tid) {
    const bf16* PROJ = (const bf16*)(a.ws + WS_PROJ); bf16* X0C = (bf16*)(a.ws + WS_X0C); float* ZT = (float*)(a.ws + WS_ZT);
    const float* cw = a.in[7]; const float* cb = a.in[8];
    LAS float* zt = (LAS float*)lds;
    const int cg = tid & 15, tr = tid >> 4;
    for (int it = vcu; it < 1024; it += G) {
        const int tokblk = it >> 3, chblk = it & 7, ch = chblk * 128 + cg * 8;
        const int T0 = tokblk * 128, tb = T0 + tr * 4, sb = tb & (SEQ - 1);
        float res[3][4][8];
#pragma unroll
        for (int p = 0; p < 3; ++p) {
            const int col = p * 1024 + ch;
            float w0[8], w1[8], w2[8], bs[8];
#pragma unroll
            for (int q = 0; q < 2; ++q) { const f32x4 a0 = *(const f32x4*)(cw + col + 4 * q), a1 = *(const f32x4*)(cw + 3072 + col + 4 * q), a2 = *(const f32x4*)(cw + 6144 + col + 4 * q), bb = *(const f32x4*)(cb + col + 4 * q);
#pragma unroll
                for (int e = 0; e < 4; ++e) { w0[4 * q + e] = a0[e]; w1[4 * q + e] = a1[e]; w2[4 * q + e] = a2[e]; bs[4 * q + e] = bb[e]; } }
            const bf16* src = PROJ + (size_t)tb * INW + COL_HY + col;
            float in[6][8];
#pragma unroll
            for (int i = 0; i < 6; ++i) { const int s = sb + i - 1; v4u w = (v4u){0u, 0u, 0u, 0u};
                if (s >= 0 && s < SEQ) w = *(const v4u*)(src + (long)(i - 1) * INW);
                in[i][0] = bf_lo(w.x); in[i][1] = bf_hi(w.x); in[i][2] = bf_lo(w.y); in[i][3] = bf_hi(w.y); in[i][4] = bf_lo(w.z); in[i][5] = bf_hi(w.z); in[i][6] = bf_lo(w.w); in[i][7] = bf_hi(w.w); }
#pragma unroll
            for (int i = 0; i < 4; ++i)
#pragma unroll
                for (int e = 0; e < 8; ++e) res[p][i][e] = bs[e] + w0[e] * in[i][e] + w1[e] * in[i + 1][e] + w2[e] * in[i + 2][e];
        }
#pragma unroll
        for (int i = 0; i < 4; ++i) { v4u o; o.x = pk2(res[0][i][0], res[0][i][1]); o.y = pk2(res[0][i][2], res[0][i][3]); o.z = pk2(res[0][i][4], res[0][i][5]); o.w = pk2(res[0][i][6], res[0][i][7]);
            *(v4u*)(X0C + (size_t)(tb + i) * HW + ch) = o;
            const int t = tr * 4 + i, tp = t + (t >> 5);
#pragma unroll
            for (int e = 0; e < 8; ++e) zt[(cg * 8 + e) * 133 + tp] = res[2][i][e] * res[1][i][e]; }
        __syncthreads();
        { const int c2 = tid >> 2, seg = tid & 3, b = T0 >> 13, s0 = T0 & (SEQ - 1);
          float* dst = ZT + ((size_t)(chblk * 128 + c2) * 2 + b) * SEQ + s0 + seg * 32; const LAS float* zs = zt + c2 * 133 + seg * 33;
#pragma unroll
          for (int k = 0; k < 8; ++k) { f32x4 v; v.x = zs[4 * k]; v.y = zs[4 * k + 1]; v.z = zs[4 * k + 2]; v.w = zs[4 * k + 3]; *(f32x4*)(dst + 4 * k) = v; } }
        __syncthreads();
    }
}
__device__ __forceinline__ void p2_filter(const Args& a, LAS unsigned char* lds, int first, int stride, int tid) {
    typedef short bf8_t __attribute__((ext_vector_type(8))); typedef float f16_t __attribute__((ext_vector_type(16)));
    const float* H2 = (const float*)(a.ws + WS_H2); const float* w3 = a.in[15]; float* KT = (float*)(a.ws + WS_KT);
    LAS float* tf = (LAS float*)lds; LAS float* tbk = tf + 128 * 65;
    const int lane = tid & 63, wave = tid >> 6, r32 = lane & 31, hi = lane >> 5, half = wave >> 2, cl = 32 * (wave & 3) + r32;
    const float min_decay = -3.0701134573253944f, max_decay = -15.350567286626972f;
    for (int it = first; it < 1024; it += stride) {
        const int jblk = it >> 3, chblk = it & 7, j0 = jblk * 64, ch = chblk * 128 + cl;
        f16_t acc0 = {}, acc1 = {};
#pragma unroll
        for (int s = 0; s < 4; ++s) {
            const int k0 = 16 * s + 8 * hi;
            unsigned bw[4];
#pragma unroll
            for (int q = 0; q < 4; ++q) bw[q] = pk2(w3[(size_t)(k0 + 2 * q) * 2048 + half * 1024 + ch], w3[(size_t)(k0 + 2 * q + 1) * 2048 + half * 1024 + ch]);
            const v4u bq = (v4u){bw[0], bw[1], bw[2], bw[3]}; const bf8_t bfr = __builtin_bit_cast(bf8_t, bq);
#pragma unroll
            for (int mt = 0; mt < 2; ++mt) { const float* hp = H2 + (size_t)(j0 + 32 * mt + r32) * 64 + k0; const f32x4 h0 = *(const f32x4*)hp, h1 = *(const f32x4*)(hp + 4);
                const v4u aq = (v4u){pk2(h0.x, h0.y), pk2(h0.z, h0.w), pk2(h1.x, h1.y), pk2(h1.z, h1.w)}; const bf8_t afr = __builtin_bit_cast(bf8_t, aq);
                if (mt == 0) acc0 = __builtin_amdgcn_mfma_f32_32x32x16_bf16(afr, bfr, acc0, 0, 0, 0); else acc1 = __builtin_amdgcn_mfma_f32_32x32x16_bf16(afr, bfr, acc1, 0, 0, 0); }
        }
        const float delta = fabsf(min_decay + (max_decay - min_decay) * ((float)ch / 1023.f));
        LAS float* dstt = half ? tbk : tf;
#pragma unroll
        for (int r = 0; r < 16; ++r) { const int jj = (r & 3) + 8 * (r >> 2) + 4 * hi;
            dstt[cl * 65 + jj] = acc0[r] * expf(-((float)(j0 + jj) / (float)(SEQ - 1)) * delta);
            dstt[cl * 65 + 32 + jj] = acc1[r] * expf(-((float)(j0 + 32 + jj) / (float)(SEQ - 1)) * delta); }
        __syncthreads();
        { const int c2 = tid >> 2, seg = tid & 3; float* dst = KT + (size_t)(chblk * 128 + c2) * 16384;
#pragma unroll
          for (int k = 0; k < 16; ++k) { const int jj = seg * 16 + k, j = j0 + jj; dst[j] = tf[c2 * 65 + jj];
              if (j == 0) dst[8192] = 0.f; else dst[16384 - j] = tbk[c2 * 65 + jj]; } }
        __syncthreads();
    }
}

__device__ __forceinline__ void p4_conv_direct(const Args& a, LAS unsigned char* lds, int vcu, int G, int tid) {
    const float* KT = (const float*)(a.ws + WS_KT); float* ZT = (float*)(a.ws + WS_ZT); const float* dbias = a.in[16];
    LAS float* kk = (LAS float*)lds;
    LAS float* zz = kk + 17408;
    LAS float* red = zz + 16384;
    const int lane = tid & 63, wave = tid >> 6;
    for (int ch = vcu; ch < HW; ch += G) {
        float ss = 0.f;
        for (int i = tid; i < 16384; i += 512) { const float v = KT[(size_t)ch * 16384 + i]; ss += v * v; kk[i + (i >> 4)] = v; }
        for (int i = tid; i < 16384; i += 512) zz[i] = ZT[(size_t)ch * 16384 + i];
        ss = wave_sum(ss); if (lane == 0) red[wave] = ss;
        __syncthreads();
        float tot = 0.f;
#pragma unroll
        for (int w = 0; w < 8; ++w) tot += red[w];
        const float scale = rsqrtf(tot + FILTER_EPS), db = dbias[ch];
        const int t0 = tid * 16;
        float acc0[16], acc1[16];
#pragma unroll
        for (int i = 0; i < 16; ++i) { acc0[i] = 0.f; acc1[i] = 0.f; }
        for (int s0 = 0; s0 < SEQ; s0 += 16) {
            float kw[31];
#pragma unroll
            for (int q = 0; q < 31; ++q) { const int idx = (t0 - s0 - 15 + q) & 16383; kw[q] = kk[idx + (idx >> 4)]; }
#pragma unroll
            for (int jj = 0; jj < 16; ++jj) { const float z0 = zz[s0 + jj], z1 = zz[SEQ + s0 + jj];
#pragma unroll
                for (int i = 0; i < 16; ++i) { acc0[i] += kw[i - jj + 15] * z0; acc1[i] += kw[i - jj + 15] * z1; } }
        }
        float* y0 = ZT + (size_t)ch * 16384 + t0; float* y1 = y0 + SEQ;
#pragma unroll
        for (int i = 0; i < 16; ++i) { y0[i] = acc0[i] * scale + db * zz[t0 + i]; y1[i] = acc1[i] * scale + db * zz[SEQ + t0 + i]; }
        __syncthreads();
    }
}

__device__ __forceinline__ void p5_ah(const Args& a, LAS unsigned char* lds, int vcu, int G, int tid) {
    const float* YT = (const float*)(a.ws + WS_ZT); const bf16* X0C = (const bf16*)(a.ws + WS_X0C); bf16* AH = (bf16*)(a.ws + WS_ACAT + 1024);
    LAS float* yt = (LAS float*)lds;
    for (int it = vcu; it < 2048; it += G) {
        const int tokblk = it >> 3, chblk = it & 7, T0 = tokblk * 64, b = T0 >> 13, s0 = T0 & (SEQ - 1);
        { const int c2 = tid >> 2, seg = tid & 3; const float* src = YT + ((size_t)(chblk * 128 + c2) * 2 + b) * SEQ + s0 + seg * 16;
#pragma unroll
          for (int k = 0; k < 4; ++k) { const f32x4 v = *(const f32x4*)(src + 4 * k); yt[c2 * 65 + seg * 16 + 4 * k] = v.x; yt[c2 * 65 + seg * 16 + 4 * k + 1] = v.y; yt[c2 * 65 + seg * 16 + 4 * k + 2] = v.z; yt[c2 * 65 + seg * 16 + 4 * k + 3] = v.w; } }
        __syncthreads();
        { const int t = tid >> 3, cs = tid & 7; const size_t off = (size_t)(T0 + t) * HW + chblk * 128 + cs * 16;
          const v4u xa = *(const v4u*)(X0C + off), xb = *(const v4u*)(X0C + off + 8);
          const unsigned xw[8] = {xa.x, xa.y, xa.z, xa.w, xb.x, xb.y, xb.z, xb.w}; unsigned ow[8];
#pragma unroll
          for (int k = 0; k < 8; ++k) ow[k] = pk2(bf_lo(xw[k]) * yt[(cs * 16 + 2 * k) * 65 + t], bf_hi(xw[k]) * yt[(cs * 16 + 2 * k + 1) * 65 + t]);
          const size_t offo = (size_t)(T0 + t) * 1536 + chblk * 128 + cs * 16;
          *(v4u*)(AH + offo) = (v4u){ow[0], ow[1], ow[2], ow[3]}; *(v4u*)(AH + offo + 8) = (v4u){ow[4], ow[5], ow[6], ow[7]}; }
        __syncthreads();
    }
}

typedef float f32x4m __attribute__((ext_vector_type(4)));
__device__ __forceinline__ void p8_ln_route(const Args& a, LAS unsigned char* lds, int vcu, int G, int tid) {
    const bf16* PRE = (const bf16*)(a.ws + WS_PRE1); bf16* H1B = (bf16*)(a.ws + WS_H1B); const float* g = a.in[20]; const float* bt = a.in[21];
    const float* WRT = (const float*)(a.ws + WS_WRT); const float* RC = WRT + 48 * 2048;
    int* ETOK = (int*)(a.ws + WS_ETOK); float* EW = (float*)(a.ws + WS_EW); gu32* ctl = (gu32*)(a.ws + WS_CTL);
    LAS float* lg = (LAS float*)lds;
    LAS int* lcnt = (LAS int*)(lds + 32768); LAS int* lbase = (LAS int*)(lds + 32768 + 128); LAS float* rstat = (LAS float*)(lds + 32768 + 256);
    const int lane = tid & 63, wave = tid >> 6;
    for (int it = vcu; it < NTOK / 64; it += G) {
        const int r0 = it * 64;
        if (tid < 32) lcnt[tid] = 0;
        {
            const int wq = wave & 3, kh = wave >> 2;
            f32x4 acc0 = {0.f, 0.f, 0.f, 0.f}, acc1 = acc0, acc2 = acc0;
            typedef short rt_bf16x8 __attribute__((ext_vector_type(8)));
            const bf16* ap = PRE + (size_t)(r0 + wq * 16 + (lane & 15)) * DM + kh * 1024 + 8 * (lane >> 4);
            const bf16* bh = (const bf16*)(a.ws + WS_WRT + 512 * 1024) + (size_t)(lane & 15) * DM + kh * 1024 + 8 * (lane >> 4);
            const bf16* bl = (const bf16*)(a.ws + WS_WRT + 768 * 1024) + (size_t)(lane & 15) * DM + kh * 1024 + 8 * (lane >> 4);
#pragma unroll 4
            for (int k0 = 0; k0 < DM / 2; k0 += 32) {
                const rt_bf16x8 av = *(const rt_bf16x8*)(ap + k0);
                const rt_bf16x8 h0 = *(const rt_bf16x8*)(bh + k0), h1 = *(const rt_bf16x8*)(bh + 16 * DM + k0), h2 = *(const rt_bf16x8*)(bh + 32 * DM + k0);
                const rt_bf16x8 l0 = *(const rt_bf16x8*)(bl + k0), l1 = *(const rt_bf16x8*)(bl + 16 * DM + k0), l2 = *(const rt_bf16x8*)(bl + 32 * DM + k0);
                acc0 = __builtin_amdgcn_mfma_f32_16x16x32_bf16(av, h0, acc0, 0, 0, 0); acc1 = __builtin_amdgcn_mfma_f32_16x16x32_bf16(av, h1, acc1, 0, 0, 0); acc2 = __builtin_amdgcn_mfma_f32_16x16x32_bf16(av, h2, acc2, 0, 0, 0);
                acc0 = __builtin_amdgcn_mfma_f32_16x16x32_bf16(av, l0, acc0, 0, 0, 0); acc1 = __builtin_amdgcn_mfma_f32_16x16x32_bf16(av, l1, acc1, 0, 0, 0); acc2 = __builtin_amdgcn_mfma_f32_16x16x32_bf16(av, l2, acc2, 0, 0, 0);
            }
#pragma unroll
            for (int r = 0; r < 4; ++r) { LAS float* p = lg + kh * (64 * 48) + (wq * 16 + (lane >> 4) * 4 + r) * 48 + (lane & 15); p[0] = acc0[r]; p[16] = acc1[r]; p[32] = acc2[r]; }
        }
        for (int i = 0; i < 8; ++i) { const int rl = wave * 8 + i, r = r0 + rl;
            const GAS u32x2* xr = (const GAS u32x2*)(PRE + (size_t)r * DM) + lane; f32x4 v[8]; float s = 0.f;
#pragma unroll
            for (int j = 0; j < 8; ++j) { const u32x2 w = xr[64 * j]; v[j] = (f32x4){bf_lo(w.x), bf_hi(w.x), bf_lo(w.y), bf_hi(w.y)}; s += (v[j].x + v[j].y) + (v[j].z + v[j].w); }
            const float mean = wave_sum(s) * (1.f / DM); float s2 = 0.f;
#pragma unroll
            for (int j = 0; j < 8; ++j) { v[j] = v[j] - mean; s2 += (v[j].x * v[j].x + v[j].y * v[j].y) + (v[j].z * v[j].z + v[j].w * v[j].w); }
            const float rstd = 1.f / sqrtf(wave_sum(s2) * (1.f / DM) + LN_EPS);
            if (lane == 0) { rstat[2 * rl] = mean; rstat[2 * rl + 1] = rstd; }
            GAS unsigned* ob = (GAS unsigned*)((unsigned char*)H1B + (size_t)r * DM) + lane;
#pragma unroll
            for (int j = 0; j < 8; ++j) { const f32x4 gg = *(const f32x4*)(g + 4 * lane + 256 * j), bb = *(const f32x4*)(bt + 4 * lane + 256 * j); const f32x4 y = v[j] * rstd * gg + bb;
                ob[64 * j] = pk4_fp8(y.x, y.y, y.z, y.w); }
        }
        __syncthreads();
        int e0 = 0, e1 = 0, p0 = 0, p1 = 0; float w0 = 0.f, w1 = 0.f;
        if (tid < 64) {
            const LAS float* L = lg + tid * 48; const float mean = rstat[2 * tid], rstd = rstat[2 * tid + 1];
#define LOGIT(col) (rstd * ((L[col] + L[64 * 48 + (col)]) - mean * RC[col]) + RC[48 + (col)])
            float c[4]; int grp = 0; float cm;
#pragma unroll
            for (int i = 0; i < 4; ++i) c[i] = LOGIT(i);
            cm = c[0];
#pragma unroll
            for (int i = 1; i < 4; ++i) if (c[i] > cm) { cm = c[i]; grp = i; }
            float den = 0.f;
#pragma unroll
            for (int i = 0; i < 4; ++i) den += expf(c[i] - cm);
            const float pg = 1.f / den;
            float f[8];
#pragma unroll
            for (int i = 0; i < 8; ++i) f[i] = LOGIT(4 + grp * 8 + i);
#undef LOGIT
            int i0 = 0; float f0 = f[0];
#pragma unroll
            for (int i = 1; i < 8; ++i) if (f[i] > f0) { f0 = f[i]; i0 = i; }
            int i1 = -1; float f1 = -3.0e38f;
#pragma unroll
            for (int i = 0; i < 8; ++i) if (i != i0 && f[i] > f1) { f1 = f[i]; i1 = i; }
            const float q0 = 1.f / (1.f + expf(f1 - f0));
            w0 = pg * q0; w1 = pg * (1.f - q0); e0 = grp * 8 + i0; e1 = grp * 8 + i1;
            p0 = __hip_atomic_fetch_add(lcnt + e0, 1, __ATOMIC_RELAXED, __HIP_MEMORY_SCOPE_WORKGROUP); p1 = __hip_atomic_fetch_add(lcnt + e1, 1, __ATOMIC_RELAXED, __HIP_MEMORY_SCOPE_WORKGROUP);
        }
        __syncthreads();
        if (tid < 32) { const int n = lcnt[tid]; lbase[tid] = n ? (int)__hip_atomic_fetch_add(ctl + CW_ECNT + 64 * tid, (unsigned)n, RLX_AGENT) : 0; }
        __syncthreads();
        if (tid < 64) { const int tok = r0 + tid; const int q0 = lbase[e0] + p0, q1 = lbase[e1] + p1;
            ETOK[e0 * ELIST + q0] = tok * 2; EW[e0 * ELIST + q0] = w0; ETOK[e1 * ELIST + q1] = tok * 2 + 1; EW[e1 * ELIST + q1] = w1; }
        __syncthreads();
    }
}
__device__ __forceinline__ int expert_tables(const Args& a, LAS unsigned char* lds, int tid) {
    LAS int* cnt = (LAS int*)(lds + L_CNT); LAS int* off = (LAS int*)(lds + L_OFF); LAS int* rbx = (LAS int*)(lds + L_RBX);
    gu32* ctl = (gu32*)(a.ws + WS_CTL);
    __syncthreads();
    if (tid < 32) cnt[tid] = (int)__hip_atomic_load(ctl + CW_ECNT + 64 * tid, RLX_AGENT);
    __syncthreads();
    if (tid == 0) { int o = 0; for (int e = 0; e < 32; ++e) { off[e] = o; const int nb = (cnt[e] + 255) >> 8; for (int k = 0; k < nb; ++k) rbx[(o >> 8) + k] = e; o += nb << 8; } off[32] = o; }
    __syncthreads();
    return off[32];
}
__device__ __forceinline__ void p12_final(const Args& a, int gw, int NGW, int lane) {
    const bf16* PRE = (const bf16*)(a.ws + WS_PRE1); const bf16* Y = (const bf16*)(a.ws + WS_Y); const float* g1 = a.in[20]; const float* b1 = a.in[21]; const float* g = a.in[29]; const float* bt = a.in[30];
#if defined(CHECK_ATTN)
    const bool bad = __hip_atomic_load((gu32*)(a.ws + WS_CTL) + 12, RLX_AGENT) != 0u;
#endif
    for (int r = gw; r < NTOK; r += NGW) {
        const GAS u32x2* xr = (const GAS u32x2*)(PRE + (size_t)r * DM) + lane; const GAS u32x2* y0 = (const GAS u32x2*)(Y + (size_t)r * DM) + lane; const GAS u32x2* y1 = (const GAS u32x2*)(Y + ((size_t)NTOK + r) * DM) + lane;
        GAS f32x4* orow = (GAS f32x4*)(a.out + (size_t)r * DM) + lane;
        f32x4 v[8]; u32x2 ya[8], yb[8]; float s = 0.f;
#pragma unroll
        for (int j = 0; j < 8; ++j) { const u32x2 w = xr[64 * j]; v[j] = (f32x4){bf_lo(w.x), bf_hi(w.x), bf_lo(w.y), bf_hi(w.y)}; ya[j] = y0[64 * j]; yb[j] = y1[64 * j]; s += (v[j].x + v[j].y) + (v[j].z + v[j].w); }
        const float mean1 = wave_sum(s) * (1.f / DM); float q = 0.f;
#pragma unroll
        for (int j = 0; j < 8; ++j) { v[j] = v[j] - mean1; q += (v[j].x * v[j].x + v[j].y * v[j].y) + (v[j].z * v[j].z + v[j].w * v[j].w); }
        const float rstd1 = 1.f / sqrtf(wave_sum(q) * (1.f / DM) + LN_EPS) * ALPHA;
        s = 0.f;
#pragma unroll
        for (int j = 0; j < 8; ++j) { const f32x4 gg = *(const f32x4*)(g1 + 4 * lane + 256 * j), bb = *(const f32x4*)(b1 + 4 * lane + 256 * j);
            v[j] = v[j] * rstd1 * gg + bb * ALPHA + (f32x4){bf_lo(ya[j].x), bf_hi(ya[j].x), bf_lo(ya[j].y), bf_hi(ya[j].y)} + (f32x4){bf_lo(yb[j].x), bf_hi(yb[j].x), bf_lo(yb[j].y), bf_hi(yb[j].y)};
            s += (v[j].x + v[j].y) + (v[j].z + v[j].w); }
        const float mean = wave_sum(s) * (1.f / DM); float s2 = 0.f;
#pragma unroll
        for (int j = 0; j < 8; ++j) { v[j] = v[j] - mean; s2 += (v[j].x * v[j].x + v[j].y * v[j].y) + (v[j].z * v[j].z + v[j].w * v[j].w); }
        const float rstd = 1.f / sqrtf(wave_sum(s2) * (1.f / DM) + LN_EPS);
#pragma unroll
        for (int j = 0; j < 8; ++j) { const f32x4 gg = *(const f32x4*)(g + 4 * lane + 256 * j), bb = *(const f32x4*)(bt + 4 * lane + 256 * j); f32x4 ov = v[j] * rstd * gg + bb;
#if defined(CHECK_ATTN)
            if (bad) ov = (f32x4){__builtin_nanf(""), __builtin_nanf(""), __builtin_nanf(""), __builtin_nanf("")};
#endif
            orow[64 * j] = ov; }
    }
}
__device__ __forceinline__ f32x2 cmul(const f32x2 a, const f32x2 b) { return (f32x2){a.x * b.x - a.y * b.y, a.x * b.y + a.y * b.x}; }
template <int DIR> __device__ __forceinline__ void dft4(f32x2& a0, f32x2& a1, f32x2& a2, f32x2& a3) {
    const f32x2 t0 = a0 + a2, t1 = a0 - a2, t2 = a1 + a3, t3 = a1 - a3;
    a0 = t0 + t2; a2 = t0 - t2;
    if (DIR < 0) { a1 = (f32x2){t1.x + t3.y, t1.y - t3.x}; a3 = (f32x2){t1.x - t3.y, t1.y + t3.x}; }
    else         { a1 = (f32x2){t1.x - t3.y, t1.y + t3.x}; a3 = (f32x2){t1.x + t3.y, t1.y - t3.x}; }
}
template <int DIR> __device__ __forceinline__ void fft16(f32x2 (&v)[16], f32x2 (&o)[16]) {
    constexpr float C[10] = {1.f, 0.92387953251128674f, 0.70710678118654752f, 0.38268343236508977f, 0.f, -0.38268343236508977f, -0.70710678118654752f, -0.92387953251128674f, -1.f, -0.92387953251128674f};
    constexpr float S[10] = {0.f, 0.38268343236508977f, 0.70710678118654752f, 0.92387953251128674f, 1.f, 0.92387953251128674f, 0.70710678118654752f, 0.38268343236508977f, 0.f, -0.38268343236508977f};
#pragma unroll
    for (int j0 = 0; j0 < 4; ++j0) dft4<DIR>(v[j0], v[j0 + 4], v[j0 + 8], v[j0 + 12]);
#pragma unroll
    for (int j0 = 1; j0 < 4; ++j0)
#pragma unroll
        for (int k1 = 1; k1 < 4; ++k1) { const int m = j0 * k1; v[j0 + 4 * k1] = cmul(v[j0 + 4 * k1], (f32x2){C[m], (float)DIR * S[m]}); }
#pragma unroll
    for (int k1 = 0; k1 < 4; ++k1) dft4<DIR>(v[4 * k1], v[4 * k1 + 1], v[4 * k1 + 2], v[4 * k1 + 3]);
#pragma unroll
    for (int k1 = 0; k1 < 4; ++k1)
#pragma unroll
        for (int k2 = 0; k2 < 4; ++k2) o[k1 + 4 * k2] = v[4 * k1 + k2];
}
template <int DIR> __device__ __forceinline__ void tw_apply(f32x2 (&v)[16], float frac2) {
    const float s = __builtin_amdgcn_sinf(frac2 * 0.5f), c = __builtin_amdgcn_cosf(frac2 * 0.5f);
    const f32x2 w1 = (f32x2){c, (float)DIR * s};
    const f32x2 w2 = cmul(w1, w1), w3 = cmul(w2, w1), w4 = cmul(w2, w2);
    v[1] = cmul(v[1], w1); v[2] = cmul(v[2], w2); v[3] = cmul(v[3], w3); v[4] = cmul(v[4], w4);
    const f32x2 w5 = cmul(w4, w1), w6 = cmul(w3, w3), w7 = cmul(w4, w3), w8 = cmul(w4, w4);
    v[5] = cmul(v[5], w5); v[6] = cmul(v[6], w6); v[7] = cmul(v[7], w7); v[8] = cmul(v[8], w8);
    v[9] = cmul(v[9], cmul(w8, w1)); v[10] = cmul(v[10], cmul(w5, w5)); v[11] = cmul(v[11], cmul(w8, w3)); v[12] = cmul(v[12], cmul(w6, w6));
    v[13] = cmul(v[13], cmul(w8, w5)); v[14] = cmul(v[14], cmul(w7, w7)); v[15] = cmul(v[15], cmul(w8, w7));
}
__device__ __forceinline__ float dpp_x1(float v) { return __int_as_float(__builtin_amdgcn_update_dpp(0, __float_as_int(v), 0xB1, 0xF, 0xF, true)); }
__device__ __forceinline__ float dpp_x2(float v) { return __int_as_float(__builtin_amdgcn_update_dpp(0, __float_as_int(v), 0x4E, 0xF, 0xF, true)); }
__device__ __forceinline__ void quad_fwd(f32x2& v, int b) {
    const bool hi = (b & 2) != 0, odd = (b & 1) != 0; const float s2 = hi ? -1.f : 1.f, sg = odd ? -1.f : 1.f;
    const f32x2 p = (f32x2){dpp_x2(v.x), dpp_x2(v.y)};
    const f32x2 t = (f32x2){p.x + s2 * v.x, p.y + s2 * v.y};
    const f32x2 q = (f32x2){dpp_x1(t.x), dpp_x1(t.y)};
    const f32x2 base = odd ? q : t, oth = odd ? t : q;
    const float ax = sg * (hi ? oth.y : oth.x), ay = (hi ? -sg : sg) * (hi ? oth.x : oth.y);
    v = (f32x2){base.x + ax, base.y + ay};
}
__device__ __forceinline__ void quad_inv(f32x2& v, int b) {
    const bool hi = (b & 2) != 0, odd = (b & 1) != 0; const float s2 = hi ? -1.f : 1.f;
    const f32x2 q = (f32x2){dpp_x1(v.x), dpp_x1(v.y)};
    const f32x2 sm = v + q, d = q - v;
    const f32x2 o = odd ? (hi ? (f32x2){-d.y, d.x} : d) : sm;
    const f32x2 p = (f32x2){dpp_x2(o.x), dpp_x2(o.y)};
    v = (f32x2){p.x + s2 * o.x, p.y + s2 * o.y};
}
__device__ __forceinline__ int padi(int i) { return i + ((i >> 6) << 2); }
__device__ __forceinline__ void fft_fwd_tail(LAS f32x2* L, int tid, f32x2 (&R)[2][16]) {
    asm volatile("v_mov_b32 %0, %1" : "=v"(tid) : "v"(tid));
#pragma unroll 1
    for (int h = 0; h < 2; ++h) { const int beta = tid + 512 * h, k1 = beta >> 6, b = beta & 63; f32x2 v[16], o[16];
#pragma unroll
        for (int j = 0; j < 16; ++j) v[j] = L[padi(k1 * 1024 + b + 64 * j)];
        fft16<-1>(v, o); tw_apply<-1>(o, (float)b * (1.f / 512.f));
#pragma unroll
        for (int k = 0; k < 16; ++k) L[padi(k1 * 1024 + b + 64 * k)] = o[k]; }
    __syncthreads();
#pragma unroll
    for (int h = 0; h < 2; ++h) { const int beta = tid + 512 * h, q = beta >> 2, b = beta & 3; f32x2 v[16];
#pragma unroll
        for (int j = 0; j < 16; ++j) v[j] = L[padi(64 * q + b + 4 * j)];
        fft16<-1>(v, R[h]); tw_apply<-1>(R[h], (float)b * (1.f / 32.f));
#pragma unroll
        for (int k = 0; k < 16; ++k) quad_fwd(R[h][k], b);
        __builtin_amdgcn_sched_barrier(0); }
}
__device__ __forceinline__ void p4_conv_fft(const Args& a, LAS unsigned char* lds, int vcu, int G, int tid_) {
    const float* KT = (const float*)(a.ws + WS_KT); float* ZT = (float*)(a.ws + WS_ZT); const float* dbias = a.in[16];
    LAS f32x2* L = (LAS f32x2*)lds;
    LAS float* red = (LAS float*)(lds + 139264);
    f32x2* KRa = (f32x2*)(a.ws + WS_KR) + (size_t)blockIdx.x * 16384;
    f32x2* KRb = (f32x2*)(a.ws + WS_WIN) + (size_t)blockIdx.x * 16384;
    const int lane = tid_ & 63, wave = tid_ >> 6;
    for (int pc = vcu; pc < HW; pc += 2 * G) {
        const int chA = pc, chB = pc + G; const bool hasB = chB < HW;
        const float* kpa = KT + (size_t)chA * 16384; const float* kpb = KT + (size_t)(hasB ? chB : chA) * 16384;
        int tid; asm volatile("v_mov_b32 %0, %1" : "=v"(tid) : "v"(tid_));
        f32x2 R[2][16];
        float ssa = 0.f, ssb = 0.f;
#pragma unroll 1
        for (int h = 0; h < 2; ++h) { const int beta = tid + 512 * h; f32x2 v[16], o[16];
#pragma unroll
            for (int j = 0; j < 16; ++j) { const float xa = kpa[beta + 1024 * j]; float xb = kpb[beta + 1024 * j]; xb = hasB ? xb : 0.f; ssa += xa * xa; ssb += xb * xb; v[j] = (f32x2){xa, xb}; }
            fft16<-1>(v, o); tw_apply<-1>(o, (float)beta * (1.f / 8192.f));
#pragma unroll
            for (int k = 0; k < 16; ++k) L[padi(beta + 1024 * k)] = o[k]; }
        ssa = wave_sum(ssa); ssb = wave_sum(ssb); if (lane == 0) { red[wave] = ssa; red[8 + wave] = ssb; }
        __syncthreads();
        fft_fwd_tail(L, tid, R);
        __syncthreads();
        asm volatile("v_mov_b32 %0, %1" : "=v"(tid) : "v"(tid_));
#pragma unroll
        for (int h = 0; h < 2; ++h) { const int beta = tid + 512 * h, q = beta >> 2, bp = beta & 3, rev = ((bp & 1) << 1) | (bp >> 1), s0 = rev + 4 * (q & 15) + 64 * (q >> 4);
#pragma unroll
            for (int k = 0; k < 16; ++k) L[s0 + 1024 * k] = R[h][k]; }
        __syncthreads();
        { float ta = 0.f, tb = 0.f;
#pragma unroll
          for (int w = 0; w < 8; ++w) { ta += red[w]; tb += red[8 + w]; }
          const float sA = rsqrtf(ta + FILTER_EPS) * (0.5f / 16384.f), dA = dbias[chA] * (1.f / 16384.f);
          const float sB = rsqrtf(tb + FILTER_EPS) * (0.5f / 16384.f), dB = dbias[hasB ? chB : chA] * (1.f / 16384.f);
#pragma unroll
          for (int h = 0; h < 2; ++h) { const int beta = tid + 512 * h, q = beta >> 2, bp = beta & 3, rev = ((bp & 1) << 1) | (bp >> 1), f0 = (q >> 4) + 16 * (q & 15) + 4096 * rev;
#pragma unroll
              for (int k = 0; k < 16; ++k) { const int g = (16384 - (f0 + 256 * k)) & 16383, sg = ((g >> 12) & 3) | (((g >> 4) & 15) << 2) | ((g & 15) << 6) | (((g >> 8) & 15) << 10);
                  const f32x2 Q = L[sg], P = R[h][k];
                  KRa[(h * 16 + k) * 512 + tid] = (f32x2){(P.x + Q.x) * sA + dA, (P.y - Q.y) * sA};
                  KRb[(h * 16 + k) * 512 + tid] = (f32x2){(P.y + Q.y) * sB + dB, (Q.x - P.x) * sB}; } } }
        __syncthreads();
#pragma unroll 1
        for (int sel = 0; sel < (hasB ? 2 : 1); ++sel) {
        const int ch = sel ? chB : chA; const f32x2* KRg = sel ? KRb : KRa;
        float* z0 = ZT + (size_t)ch * 16384; float* z1 = z0 + SEQ;
        asm volatile("v_mov_b32 %0, %1" : "=v"(tid) : "v"(tid_));
#pragma unroll 1
        for (int h = 0; h < 2; ++h) { const int beta = tid + 512 * h; f32x2 v[16], o[16];
#pragma unroll
            for (int j = 0; j < 8; ++j) v[j] = (f32x2){z0[beta + 1024 * j], z1[beta + 1024 * j]};
#pragma unroll
            for (int j = 8; j < 16; ++j) v[j] = (f32x2){0.f, 0.f};
            fft16<-1>(v, o); tw_apply<-1>(o, (float)beta * (1.f / 8192.f));
#pragma unroll
            for (int k = 0; k < 16; ++k) L[padi(beta + 1024 * k)] = o[k]; }
        __syncthreads();
        fft_fwd_tail(L, tid, R);
        asm volatile("v_mov_b32 %0, %1" : "=v"(tid) : "v"(tid_));
#pragma unroll
        for (int h = 0; h < 2; ++h) { const int beta = tid + 512 * h, q = beta >> 2, b = beta & 3; f32x2 o[16];
#pragma unroll
            for (int k = 0; k < 16; ++k) { R[h][k] = cmul(R[h][k], KRg[(h * 16 + k) * 512 + tid]); quad_inv(R[h][k], b); }
            tw_apply<1>(R[h], (float)b * (1.f / 32.f)); fft16<1>(R[h], o);
#pragma unroll
            for (int j = 0; j < 16; ++j) L[padi(64 * q + b + 4 * j)] = o[j];
            __builtin_amdgcn_sched_barrier(0); }
        __syncthreads();
        asm volatile("v_mov_b32 %0, %1" : "=v"(tid) : "v"(tid_));
#pragma unroll 1
        for (int h = 0; h < 2; ++h) { const int beta = tid + 512 * h, k1 = beta >> 6, b = beta & 63; f32x2 v[16], o[16];
#pragma unroll
            for (int k = 0; k < 16; ++k) v[k] = L[padi(k1 * 1024 + b + 64 * k)];
            tw_apply<1>(v, (float)b * (1.f / 512.f)); fft16<1>(v, o);
#pragma unroll
            for (int j = 0; j < 16; ++j) L[padi(k1 * 1024 + b + 64 * j)] = o[j]; }
        __syncthreads();
        asm volatile("v_mov_b32 %0, %1" : "=v"(tid) : "v"(tid_));
#pragma unroll 1
        for (int h = 0; h < 2; ++h) { const int beta = tid + 512 * h; f32x2 v[16], o[16];
#pragma unroll
            for (int k = 0; k < 16; ++k) v[k] = L[padi(beta + 1024 * k)];
            tw_apply<1>(v, (float)beta * (1.f / 8192.f)); fft16<1>(v, o);
#pragma unroll
            for (int j = 0; j < 8; ++j) { z0[beta + 1024 * j] = o[j].x; z1[beta + 1024 * j] = o[j].y; } }
        __syncthreads();
        }
    }
}
#ifndef MK_ONE_LAUNCH
#define MK_ONE_LAUNCH 1
#endif
constexpr int N_PHASES = 11;
#if defined(BREAK_MERGE)
constexpr float MERGE_MSCALE = 1.f / 64.f;
#else
constexpr float MERGE_MSCALE = 1.f / 256.f;
#endif
__global__ void __launch_bounds__(NWAVES * 64, 2) fwd(Args args) {
    extern __shared__ __attribute__((aligned(16))) unsigned char lds_raw[];
    LAS unsigned char* lds = (LAS unsigned char*)lds_raw;
    const int tid = threadIdx.x, lane = tid & 63, wave = __builtin_amdgcn_readfirstlane(tid >> 6);
    const int G = gridDim.x, bx = blockIdx.x, vcu = (G % 8 == 0) ? (bx % 8) * (G / 8) + bx / 8 : bx;
    const int gw = vcu * NWAVES + wave, NGW = G * NWAVES;
    unsigned char* ws = args.ws;
    gu32* ctl = (gu32*)(ws + WS_CTL);
    for (int u = tid; u < (LDS_BYTES - LDSCTL_OFF) / 4; u += NWAVES * 64) ((LAS unsigned*)(lds + LDSCTL_OFF))[u] = 0u;
    __syncthreads();
    XcdBarrier bar; bar.bar = (unsigned*)(ctl + CW_BAR); bar.x = 0; bar.st = nullptr;
    if (MK_ONE_LAUNCH) bar = xcd_barrier_post((unsigned*)(ctl + CW_BAR), (volatile LAS unsigned*)(lds + L_MISC) + 8);
    const int lo = args.ph_lo, hi = args.ph_hi;
#ifndef PHMASK
#define PHMASK 0xFFFF
#endif
#define IN(k) (((PHMASK >> (k)) & 1) && lo <= (k) && (k) < hi)
#ifndef PROBE_DUP
#define PROBE_DUP -1
#endif
#ifndef PROBE_MASK
#define PROBE_MASK 0
#endif
#define REP(k) for (int rep_ = 0; rep_ < ((PROBE_DUP == (k) || ((PROBE_MASK >> (k)) & 1)) ? 2 : 1); ++rep_)
#define SEAM(k) do { if (MK_ONE_LAUNCH && IN(k) && IN((k) + 1)) xcd_barrier(bar); } while (0)

    bf16* PROJ = (bf16*)(ws + WS_PROJ);
#if defined(LEAK_A)
    LAS unsigned long long* tst = (LAS unsigned long long*)(lds + LDSCTL_OFF + 1536);
    int n_st = 0;
#define STAMP() do { if (bx == 0 && tid == 0) tst[n_st] = __builtin_amdgcn_s_memrealtime(); ++n_st; } while (0)
    STAMP();
#else
#define STAMP() do { } while (0)
#endif
    if (IN(0)) REP(0) { p0_prologue(args, lds, gw, NGW, wave, lane); __syncthreads(); }
    SEAM(0); STAMP();
    if (IN(1)) {
        {
            pg8::Gemm g{(const bf16*)(ws + WS_XN), (const bf16*)(ws + WS_WIN), NTOK, 3 * HW, DM}; pg8::StaticOrder S; S.init(NTOK, 3 * HW, G, bx);
            pg8::EpiProj E{PROJ + COL_HY, INW, args.in[4], 1 << 30};
            pg8::gemm_phase<pg8::EpiProj, pg8::StaticOrder, true, true>(lds, g, S, E);
        }
        {
            pg8::Gemm g{(const bf16*)(ws + WS_XN8), (const bf16*)(ws + WS_WIN8), NTOK, 22 * 256, DM / 2};
            pg8::GateOrder S; S.base.init(NTOK, 22 * 256, G, bx); S.G = G; S.c = bx; S.split = 0;
            pg8::EpiGate8 E{PROJ, INW, args.in[4], COL_G};
            pg8::gemm_phase<pg8::EpiGate8, pg8::GateOrder, true, true, false, false, true>(lds, g, S, E);
        }
        __syncthreads(); p2_filter(args, lds, bx, G, tid);
    }
    SEAM(1); STAMP();
    if (IN(2)) { p2_qk(args, gw, NGW, lane); p2_vt8(args, lds, vcu, G, tid); REP(2) { p2_conv(args, lds, vcu, G, tid); } }
    SEAM(2); STAMP();
    if (IN(3)) {
        const int grp = bx % 3;
#define CONV_SLOT(s) do { if (grp == (s)) { for (int rp_ = 0; rp_ < ((PROBE_DUP == 33) ? 2 : 1); ++rp_) { conv_items(args, lds, W_IN, NWITEMS, vcu, G, threadIdx.x); __syncthreads(); conv_items_fp8(args, lds, 0, NW8, vcu, G, threadIdx.x); __syncthreads(); conv_items_fp8(args, lds, NW8 + W8_IN, NW8 + W8_IN + W8_AO, vcu, G, threadIdx.x); __syncthreads(); } } } while (0)
#define ATTN_UNIT(uu) do { const int u = (uu); if (u < BATCH * 8 * 32) { \
            int b = u >> 8, x = u & 255, kvh = (x & 7) >> 2, within = (x & 3) + 4 * (x >> 3); \
            if (G == 256) { const int c_ = x & 7, j_ = (x >> 3) + 32 * (u >> 8);     \
                b = c_ >> 2; kvh = (c_ >> 1) & 1; within = j_ + 64 * (c_ & 1); } \
            const int hq = kvh * 4 + (within >> 5), qb = within & 31; \
            const bf16* Qb = PROJ + (size_t)(b * SEQ + qb * 256) * INW + COL_Q + hq * 128; \
            const unsigned char* Kh = (const unsigned char*)(ws + WS_KC) + (size_t)(b * 2 + kvh) * SEQ * 128; \
            const unsigned char* Vh = (const unsigned char*)(ws + WS_VC) + (size_t)(b * 2 + kvh) * SEQ * 128; \
            unsigned char* Ob = (unsigned char*)(ws + WS_ACAT) + (size_t)(b * SEQ + qb * 256) * 3072 + hq * 128; \
            attn::attn_dense_body(Qb, Kh, Vh, Ob, SEQ, (char*)lds_raw); } } while (0)
#if PROBE_DUP == 34
        CONV_SLOT(0); ATTN_UNIT(bx); ATTN_UNIT(bx); CONV_SLOT(1); ATTN_UNIT(bx + G); ATTN_UNIT(bx + G); CONV_SLOT(2);
#else
        CONV_SLOT(0); ATTN_UNIT(bx); CONV_SLOT(1); ATTN_UNIT(bx + G); CONV_SLOT(2);
#endif
        for (int u2 = bx + 2 * G; u2 < BATCH * 8 * 32; u2 += G) ATTN_UNIT(u2);
#undef CONV_SLOT
#undef ATTN_UNIT
        p4_conv_fft(args, lds, vcu, G, tid);
    }
    SEAM(3); STAMP();
    if (IN(4)) {
#if defined(CHECK_ATTN)
        check_attn(args, gw, NGW, lane);
#endif
        p5_ah(args, lds, vcu, G, tid); }
    SEAM(4); STAMP();
    if (IN(5)) {
        pg8::Gemm g{(const bf16*)(ws + WS_ACAT), (const bf16*)(ws + WS_WCAT), NTOK, DM, 1536}; pg8::StaticOrder S; S.init(NTOK, DM, G, bx);
        pg8::EpiMerge E{PROJ + COL_G, PROJ + COL_G + DM, INW, (bf16*)(ws + WS_MRG), DM, MERGE_MSCALE};
        pg8::gemm_phase<pg8::EpiMerge, pg8::StaticOrder, true, true, false, true, false, 8>(lds, g, S, E);
    }
    SEAM(5); STAMP();
    if (IN(6)) REP(6) {
#if defined(CHECK_ATTN)
        check_merge(args, gw, NGW, lane);
#endif
        pg8::Gemm g{(const bf16*)(ws + WS_MRG), (const bf16*)(ws + WS_WOUT), NTOK, DM, DM}; pg8::StaticOrder S; S.init(NTOK, DM, G, bx);
        pg8::EpiPre1 E{(const bf16*)args.out, (bf16*)(ws + WS_PRE1), DM};
        pg8::gemm_phase<pg8::EpiPre1, pg8::StaticOrder, true, true>(lds, g, S, E);
    }
    SEAM(6); STAMP();
    if (IN(7)) { p8_ln_route(args, lds, vcu, G, tid); }
    SEAM(7); STAMP();
    if (IN(8)) {
        const int total = expert_tables(args, lds, tid);
        pg8::Gemm g{(const bf16*)(ws + WS_H1B), (const bf16*)(ws + WS_WGU), total, NEXP * 2048, DM / 2, (const int*)(ws + WS_ETOK), (const LAS int*)(lds + L_CNT), (const LAS int*)(lds + L_OFF), ELIST};
        pg8::ExpertOrder S{(const LAS int*)(lds + L_RBX), total >> 8, G, bx, (PROBE_DUP == 8) ? 2 : 1};
        pg8::EpiSwiglu E{(unsigned char*)(ws + WS_HB), DEXP};
        pg8::gemm_phase<pg8::EpiSwiglu, pg8::ExpertOrder, true, true, true, false, true>(lds, g, S, E);
    }
    SEAM(8); STAMP();
    if (IN(9)) {
        const int total = expert_tables(args, lds, tid);
        pg8::Gemm g{(const bf16*)(ws + WS_HB), (const bf16*)(ws + WS_WD), total, NEXP * 2048, DEXP / 2};
        pg8::ExpertOrder S{(const LAS int*)(lds + L_RBX), total >> 8, G, bx, (PROBE_DUP == 9) ? 2 : 1};
        pg8::EpiDown E{(const int*)(ws + WS_ETOK), (const float*)(ws + WS_EW), (const LAS int*)(lds + L_CNT), (const LAS int*)(lds + L_OFF), ELIST, (bf16*)(ws + WS_Y), DM, NTOK};
        pg8::gemm_phase<pg8::EpiDown, pg8::ExpertOrder, true, true, false, false, true>(lds, g, S, E);
    }
    SEAM(9); STAMP();
    if (IN(10)) { p12_final(args, gw, NGW, lane); }
#if defined(LEAK_A)
    xcd_barrier(bar); STAMP();
    if (bx == 0 && tid == 0) { const unsigned dA = (unsigned)(tst[LEAK_A + 1] - tst[LEAK_A]), dB = (unsigned)(tst[LEAK_B + 1] - tst[LEAK_B]);
        __hip_atomic_store(ctl + 8, dA / 1000u, RLX_AGENT); __hip_atomic_store(ctl + 9, dB / 1000u, RLX_AGENT); }
    xcd_barrier(bar);
    { unsigned v1 = __hip_atomic_load(ctl + 8, RLX_AGENT), v2 = __hip_atomic_load(ctl + 9, RLX_AGENT); if (v1 > 99u) v1 = 99u; if (v2 > 99u) v2 = 99u;
      const int nz = (int)v1 * 160;
      for (int r = gw; r < nz; r += NGW) { GAS f32x4* o = (GAS f32x4*)(args.out + (size_t)r * DM) + lane;
#pragma unroll
          for (int j = 0; j < 8; ++j) o[64 * j] = (f32x4){0.f, 0.f, 0.f, 0.f}; }
      if (bx == 0 && tid == 0) args.out[(size_t)NTOK * DM - 1] = 100.f + 10.f * (float)v2; }
#endif
#undef IN
#undef SEAM
}

extern "C" void kernel_launch(void* const* d_in, const int* in_sizes, int n_in, void* d_out, int out_size, void* d_ws, size_t ws_size, hipStream_t stream) {
    static int grid = 0;
    if (grid == 0) {
        if (n_in != 31 || out_size != NTOK * DM || ws_size < WS_END) { fprintf(stderr, "kernel_launch: unexpected shapes: n_in %d out %d ws %zu (need >= %zu)\n", n_in, out_size, ws_size, (size_t)WS_END); grid = -1; return; }
        int dev = 0, cus = 0, per_cu = 0;
        if (hipGetDevice(&dev) != hipSuccess || hipDeviceGetAttribute(&cus, hipDeviceAttributeMultiprocessorCount, dev) != hipSuccess) { grid = -1; return; }
        if (hipFuncSetAttribute((const void*)fwd, hipFuncAttributeMaxDynamicSharedMemorySize, LDS_BYTES) != hipSuccess) { fprintf(stderr, "kernel_launch: hipFuncSetAttribute failed\n"); grid = -1; return; }
        if (hipOccupancyMaxActiveBlocksPerMultiprocessor(&per_cu, (const void*)fwd, NWAVES * 64, LDS_BYTES) != hipSuccess || per_cu < 1) fprintf(stderr, "kernel_launch: occupancy query reports %d\n", per_cu);
        (void)hipGetLastError();
        grid = cus;
    }
    if (grid < 0) return;
    if (hipMemsetAsync((char*)d_ws + WS_CTL, 0, CTL_ZERO_BYTES, stream) != hipSuccess) return;
    Args a{};
    for (int i = 0; i < 31; ++i) a.in[i] = (const float*)d_in[i];
    a.out = (float*)d_out; a.ws = (unsigned char*)d_ws;
#if MK_ONE_LAUNCH
    a.ph_lo = 0; a.ph_hi = N_PHASES;
    hipLaunchKernelGGL(fwd, dim3(grid), dim3(NWAVES * 64), LDS_BYTES, stream, a);
#else
    for (int p = 0; p < N_PHASES; ++p) { a.ph_lo = p; a.ph_hi = p + 1; hipLaunchKernelGGL(fwd, dim3(grid), dim3(NWAVES * 64), LDS_BYTES, stream, a); }
#endif
    const hipError_t le = hipPeekAtLastError();
    if (le != hipSuccess) fprintf(stderr, "kernel_launch: launch failed: %s\n", hipGetErrorName(le));
}
```

```cpp
#include <hip/hip_runtime.h>
#include <hip/hip_bf16.h>
#include <cstdio>
#include <cstdint>
#include <cmath>
namespace pg8 {
#define PG8_LAS __attribute__((address_space(3)))
typedef unsigned short bf16_t;
typedef short bf16x8 __attribute__((ext_vector_type(8)));
typedef float f32x4 __attribute__((ext_vector_type(4)));
typedef unsigned u32x4 __attribute__((ext_vector_type(4)));
constexpr int BM = 256, BK = 64, HALF = 128, HTB = HALF * BK * 2  , STAGE_BYTES = 8 * HTB, NXCD = 8, WGM = 8;

__host__ __device__ __forceinline__ int lds_byte(int r, int c) { const int st = (r >> 4) * 2 + (c >> 5), rr = r & 15, cc = c & 31, ob = rr * 64 + cc * 2; return st * 1024 + (ob ^ (((ob >> 9) & 1) << 5)); }
__host__ __device__ __forceinline__ void stage_rc(int b, int& R, int& C) { const int st = b / 1024, sb = b % 1024, swz = sb ^ (((sb >> 9) & 1) << 5); R = (st >> 1) * 16 + swz / 64; C = (st & 1) * 32 + (swz % 64) / 2; }
__host__ __device__ __forceinline__ int perm32(int rho) { const int n = rho >> 4, i = rho & 15; return 8 * (i >> 2) + 4 * n + (i & 3); }

struct Unit { int pm, pn; };
struct Gemm { const bf16_t* A; const bf16_t* Bt; int M, N, K;
              const int* etok; const PG8_LAS int* gcnt; const PG8_LAS int* goff; int elist; };

struct StaticOrder {
    int nM, nN, nwg, G, c;
    __host__ __device__ void init(int M, int N, int G_, int c_) { nM = M / BM; nN = N / BM; nwg = nM * nN; G = G_; c = c_; }
    __host__ __device__ bool next(int i, Unit& u) const {
        const long L = (long)i * G + c; if (L >= nwg) return false;
        int wgid = (int)L; { const int q = nwg / NXCD, r = nwg % NXCD, xcd = wgid % NXCD, off = wgid / NXCD; wgid = (xcd < r ? xcd * (q + 1) : r * (q + 1) + (xcd - r) * q) + off; }
        const int nig = WGM * nN, gid = wgid / nig, fm = gid * WGM, gsz = (nM - fm) < WGM ? (nM - fm) : WGM;
        u.pm = fm + ((wgid % nig) % gsz); u.pn = (wgid % nig) / gsz; return true;
    }
    __device__ __forceinline__ void a_ready(const Unit&) const {}
    __device__ __forceinline__ void done(const Unit&) const {}
};

__device__ __forceinline__ unsigned cvt_pk_bf16(float lo, float hi) { unsigned r; asm volatile("v_cvt_pk_bf16_f32 %0, %1, %2" : "=v"(r) : "v"(lo), "v"(hi)); return r; }
__device__ __forceinline__ float bflo(unsigned w) { return __uint_as_float(w << 16); }
__device__ __forceinline__ float bfhi(unsigned w) { return __uint_as_float(w & 0xffff0000u); }
__device__ __forceinline__ float sigm(float x) { return __builtin_amdgcn_rcpf(1.f + __builtin_amdgcn_exp2f(x * -1.4426950408889634f)); }
__device__ __forceinline__ u32x4 pack8(const f32x4 v0, const f32x4 v1) { u32x4 w; w.x = cvt_pk_bf16(v0[0], v0[1]); w.y = cvt_pk_bf16(v0[2], v0[3]); w.z = cvt_pk_bf16(v1[0], v1[1]); w.w = cvt_pk_bf16(v1[2], v1[3]); return w; }
__device__ __forceinline__ void unpack8(const u32x4 w, f32x4& v0, f32x4& v1) { v0 = (f32x4){bflo(w.x), bfhi(w.x), bflo(w.y), bfhi(w.y)}; v1 = (f32x4){bflo(w.z), bfhi(w.z), bflo(w.w), bfhi(w.w)}; }

struct EpiProj {
    static constexpr bool PERM = true, AFTER_DRAIN = false;
    bf16_t* O; int ldc; const float* bgate; int gate_pn0; float sc;
    __device__ __forceinline__ void operator()(const f32x4 (&acc)[2][2][4][2], const Unit& u, int wr, int wc, int fr, int fq) const {
        const int row0 = u.pm * BM + wr * 64 + fr, col0 = u.pn * BM + wc * 32 + 8 * fq;
        const bool gate = u.pn >= gate_pn0;
        f32x4 bv[2][2];
#pragma unroll
        for (int bj = 0; bj < 2; ++bj)
#pragma unroll
            for (int n = 0; n < 2; ++n) bv[bj][n] = gate ? *(const f32x4*)(bgate + (col0 - gate_pn0 * BM) + bj * HALF + 4 * n) : (f32x4){0.f, 0.f, 0.f, 0.f};
#pragma unroll
        for (int ai = 0; ai < 2; ++ai)
#pragma unroll
            for (int m = 0; m < 4; ++m) { bf16_t* rowp = O + (size_t)(row0 + ai * HALF + m * 16) * ldc + col0;
#pragma unroll
                for (int bj = 0; bj < 2; ++bj) { f32x4 v0 = acc[ai][bj][m][0] * sc + bv[bj][0], v1 = acc[ai][bj][m][1] * sc + bv[bj][1];
                    if (gate) {
#pragma unroll
                        for (int e = 0; e < 4; ++e) { v0[e] = sigm(v0[e]); v1[e] = sigm(v1[e]); } }
                    *(u32x4*)(rowp + bj * HALF) = pack8(v0, v1); } }
    }
};
struct EpiGate8 {
    static constexpr bool PERM = true, AFTER_DRAIN = false;
    bf16_t* O; int ldc; const float* bgate; int gate_col0;
    __device__ __forceinline__ void operator()(const f32x4 (&acc)[2][2][4][2], const Unit& u, int wr, int wc, int fr, int fq) const {
        const bool gate = u.pn >= 6;
        const int row0 = u.pm * BM + wr * 64 + fr, cl = wc * 32 + 8 * fq, col0 = (gate ? gate_col0 + (u.pn - 6) * BM : u.pn * BM) + cl, bcol = (gate ? (u.pn - 6) * BM : 0) + cl;
        f32x4 bv[2][2];
#pragma unroll
        for (int bj = 0; bj < 2; ++bj)
#pragma unroll
            for (int n = 0; n < 2; ++n) bv[bj][n] = gate ? *(const f32x4*)(bgate + bcol + bj * HALF + 4 * n) : (f32x4){0.f, 0.f, 0.f, 0.f};
#pragma unroll
        for (int ai = 0; ai < 2; ++ai)
#pragma unroll
            for (int m = 0; m < 4; ++m) { bf16_t* rowp = O + (size_t)(row0 + ai * HALF + m * 16) * ldc + col0;
#pragma unroll
                for (int bj = 0; bj < 2; ++bj) { f32x4 v0 = acc[ai][bj][m][0] * (1.f / 256.f) + bv[bj][0], v1 = acc[ai][bj][m][1] * (1.f / 256.f) + bv[bj][1];
                    if (gate) {
#pragma unroll
                        for (int e = 0; e < 4; ++e) { v0[e] = sigm(v0[e]); v1[e] = sigm(v1[e]); } }
                    *(u32x4*)(rowp + bj * HALF) = pack8(v0, v1); } }
    }
};
struct GateOrder {
    StaticOrder base; int G, c, split;
    __device__ __forceinline__ bool next(int i, Unit& u) const {
        int L;
        if (split == 0) { L = i * G + c; if (L >= base.nwg) return false; }
        else if (c < split) { if (i >= 3) return false; L = i * split + c; }
        else { if (i >= 5) return false; L = 3 * split + i * (G - split) + (c - split); }
        StaticOrder t = base; t.G = 1; t.c = L; return t.next(0, u);
    }
    __device__ __forceinline__ void a_ready(const Unit&) const {}
    __device__ __forceinline__ void done(const Unit&) const {}
};
struct EpiMerge {
    static constexpr bool PERM = true, AFTER_DRAIN = false;
    const bf16_t* Ga; const bf16_t* Gh; int ldg; bf16_t* O; int ldc; float mscale;
    __device__ __forceinline__ void mid(f32x4 (&acc)[2][2][4][2], const Unit& u, int wr, int wc, int fr, int fq) const {
        asm volatile("" : "+v"(fr), "+v"(fq));
        const int row0 = u.pm * BM + wr * 64 + fr, col0 = u.pn * BM + wc * 32 + 8 * fq;
#pragma unroll
        for (int ai = 0; ai < 2; ++ai)
#pragma unroll
            for (int m = 0; m < 4; ++m) { const size_t r = (size_t)(row0 + ai * HALF + m * 16);
#pragma unroll
                for (int bj = 0; bj < 2; ++bj) { const u32x4 aw = *(const u32x4*)(Ga + r * ldg + col0 + bj * HALF), hw = *(const u32x4*)(Gh + r * ldg + col0 + bj * HALF);
                    f32x4 a0, a1, h0, h1; unpack8(aw, a0, a1); unpack8(hw, h0, h1);
#pragma unroll
                    for (int e = 0; e < 4; ++e) { acc[ai][bj][m][0][e] *= a0[e] * mscale * __builtin_amdgcn_rcpf(fmaxf(h0[e], 1e-30f)); acc[ai][bj][m][1][e] *= a1[e] * mscale * __builtin_amdgcn_rcpf(fmaxf(h1[e], 1e-30f)); }
                    asm volatile("" : "+v"(acc[ai][bj][m][0]), "+v"(acc[ai][bj][m][1]) :: "memory"); } }
    }
    __device__ __forceinline__ void operator()(const f32x4 (&acc)[2][2][4][2], const Unit& u, int wr, int wc, int fr, int fq) const {
        const int row0 = u.pm * BM + wr * 64 + fr, col0 = u.pn * BM + wc * 32 + 8 * fq;
#pragma unroll
        for (int ai = 0; ai < 2; ++ai)
#pragma unroll
            for (int m = 0; m < 4; ++m) { const size_t r = (size_t)(row0 + ai * HALF + m * 16);
#pragma unroll
                for (int bj = 0; bj < 2; ++bj) { const u32x4 hw = *(const u32x4*)(Gh + r * ldg + col0 + bj * HALF); f32x4 h0, h1; unpack8(hw, h0, h1);
                    *(u32x4*)(O + r * ldc + col0 + bj * HALF) = pack8(acc[ai][bj][m][0] * h0, acc[ai][bj][m][1] * h1); } }
    }
};
struct EpiPre1 {
    static constexpr bool PERM = true, AFTER_DRAIN = false;
    const bf16_t* HA; bf16_t* O; int ldc;
    __device__ __forceinline__ void operator()(const f32x4 (&acc)[2][2][4][2], const Unit& u, int wr, int wc, int fr, int fq) const {
        const int row0 = u.pm * BM + wr * 64 + fr, col0 = u.pn * BM + wc * 32 + 8 * fq;
#pragma unroll
        for (int ai = 0; ai < 2; ++ai)
#pragma unroll
            for (int m = 0; m < 4; ++m) { const size_t r = (size_t)(row0 + ai * HALF + m * 16);
#pragma unroll
                for (int bj = 0; bj < 2; ++bj) { const u32x4 hw = *(const u32x4*)(HA + r * ldc + col0 + bj * HALF); f32x4 h0, h1; unpack8(hw, h0, h1);
                    *(u32x4*)(O + r * ldc + col0 + bj * HALF) = pack8(acc[ai][bj][m][0] + h0, acc[ai][bj][m][1] + h1); } }
    }
};
__device__ __forceinline__ unsigned pk4f8(float a, float b, float c, float d) { int w = 0; w = __builtin_amdgcn_cvt_pk_fp8_f32(a, b, w, false); w = __builtin_amdgcn_cvt_pk_fp8_f32(c, d, w, true); return (unsigned)w; }
struct EpiSwiglu {
    static constexpr bool PERM = true, AFTER_DRAIN = false;
    unsigned char* O; int ldc;
    __device__ __forceinline__ void operator()(const f32x4 (&acc)[2][2][4][2], const Unit& u, int wr, int wc, int fr, int fq) const {
        const int row0 = u.pm * BM + wr * 64 + fr, col0 = (u.pn & 7) * HALF + wc * 32 + 8 * fq; constexpr float S = 1.f / 256.f;
        typedef unsigned u32x2_ __attribute__((ext_vector_type(2)));
#pragma unroll
        for (int ai = 0; ai < 2; ++ai)
#pragma unroll
            for (int m = 0; m < 4; ++m) { f32x4 h[2];
#pragma unroll
                for (int n = 0; n < 2; ++n)
#pragma unroll
                    for (int e = 0; e < 4; ++e) { const float gg = acc[ai][0][m][n][e] * S; h[n][e] = gg * sigm(gg) * (acc[ai][1][m][n][e] * S); }
                *(u32x2_*)(O + (size_t)(row0 + ai * HALF + m * 16) * ldc + col0) = (u32x2_){pk4f8(h[0][0], h[0][1], h[0][2], h[0][3]), pk4f8(h[1][0], h[1][1], h[1][2], h[1][3])}; }
    }
};
struct EpiDown {
    static constexpr bool PERM = true, AFTER_DRAIN = false;
    const int* etok; const float* ew; const PG8_LAS int* cnt; const PG8_LAS int* off; int elist; bf16_t* Y; int ldc; int ntok;
    __device__ __forceinline__ void operator()(const f32x4 (&acc)[2][2][4][2], const Unit& u, int wr, int wc, int fr, int fq) const {
        const int e = u.pn >> 3, c = cnt[e], pos0 = u.pm * BM - off[e] + wr * 64 + fr, col0 = (u.pn & 7) * BM + wc * 32 + 8 * fq;
#pragma unroll
        for (int ai = 0; ai < 2; ++ai)
#pragma unroll
            for (int m = 0; m < 4; ++m) { const int pos = pos0 + ai * HALF + m * 16;
                if (pos < c) { const int ts = etok[e * elist + pos]; const float w = ew[e * elist + pos] * (1.f / 256.f);
                    bf16_t* yp = Y + ((size_t)(ts & 1) * ntok + (size_t)(ts >> 1)) * ldc + col0;
#pragma unroll
                    for (int bj = 0; bj < 2; ++bj) *(u32x4*)(yp + bj * HALF) = pack8(acc[ai][bj][m][0] * w, acc[ai][bj][m][1] * w); } }
    }
};
struct ExpertOrder {
    const PG8_LAS int* rbx; int nrb, G, c, rep;
    __device__ __forceinline__ bool next(int i, Unit& u) const {
        int L = i * G + c; if (L >= nrb * 8 * rep) return false;
        if (L >= nrb * 8) L -= nrb * 8;
        const int rb = L >> 3; u.pm = rb; u.pn = rbx[rb] * 8 + (L & 7); return true;
    }
    __device__ __forceinline__ void a_ready(const Unit&) const {}
    __device__ __forceinline__ void done(const Unit&) const {}
};
typedef int pg8_v4i __attribute__((ext_vector_type(4))); typedef int pg8_v8i __attribute__((ext_vector_type(8)));
template <class Epi, class Sched, bool ALIGN_EPI = false, bool SP2 = false, bool GATHER = false, bool MID = false, bool FP8 = false, int NF8 = 0>
__device__ __forceinline__ void gemm_phase(PG8_LAS unsigned char* lds, const Gemm g, const Sched& S, const Epi& E) {
    const int tid = threadIdx.x, wid = __builtin_amdgcn_readfirstlane(tid >> 6), lane = tid & 63, wr = wid >> 2, wc = wid & 3, fr = lane & 15, fq = lane >> 4;
    const int K = g.K, nt = K / BK;
    unsigned voffA[2], voffB[2]; int RA[2], CA[2];
#pragma unroll
    for (int i = 0; i < 2; ++i) { int R, C; stage_rc(tid * 16 + i * 8192, R, C); const int Rb = Epi::PERM ? ((R & ~31) + perm32(R & 31)) : R; RA[i] = R; CA[i] = C;
        voffA[i] = (unsigned)(R * K + C) * 2u; voffB[i] = (unsigned)(Rb * BK + C) * 2u; }
    const size_t kstep = (size_t)(BK * 2);
    const size_t hstep = (size_t)HALF * K * 2;
    const size_t tstep = 2 * hstep;
    const size_t kstepB = (size_t)BM * BK * 2, hstepB = (size_t)HALF * BK * 2, tstepB = (size_t)(K / BK) * kstepB;
    const unsigned ldsw = (unsigned)wid * 1024u;
    const int aoff = lds_byte(wr * 64 + fr, fq * 8), boff = lds_byte(wc * 32 + fr, fq * 8);
#define PG8_SA(b, h) (((b) * 2 + (h)) * HTB)
#define PG8_SB(b, h) ((4 + (b) * 2 + (h)) * HTB)
#define PG8_STAGE(bufoff, gbase, voff) do { _Pragma("unroll") for (int _i = 0; _i < 2; ++_i) \
        __builtin_amdgcn_global_load_lds((const unsigned*)((const char*)(gbase) + (voff)[_i]), (PG8_LAS unsigned*)(lds + (bufoff) + ldsw + _i * 8192), 16, 0, 0); } while (0)
#define PG8_GVOFF(u, v) do { const int e_ = (u).pn >> 3, c_ = g.gcnt[e_] - 1, bp_ = (u).pm * BM - g.goff[e_]; \
        _Pragma("unroll") for (int h_ = 0; h_ < 2; ++h_) _Pragma("unroll") for (int i_ = 0; i_ < 2; ++i_) { int p_ = bp_ + h_ * HALF + RA[i_]; p_ = p_ < c_ ? p_ : c_; \
            const int tk_ = g.etok[e_ * g.elist + p_] >> 1; (v)[h_][i_] = (unsigned)(tk_ * K + CA[i_]) * 2u; } } while (0)
#define PG8_STAGE_A(bufoff, base, h, nx) do { if constexpr (GATHER) { unsigned vv_[2]; vv_[0] = (nx) ? vAn[h][0] : vAc[h][0]; vv_[1] = (nx) ? vAn[h][1] : vAc[h][1]; PG8_STAGE(bufoff, base, vv_); } \
        else { PG8_STAGE(bufoff, (base) + (h) * hstep, voffA); } } while (0)
#define PG8_LDA(dst, b, h) do { _Pragma("unroll") for (int m = 0; m < 4; ++m) { if (f8_) { const pg8_v4i lo_ = *(const PG8_LAS pg8_v4i*)(lds + PG8_SA(b, h) + aoff + m * 2048), hi_ = *(const PG8_LAS pg8_v4i*)(lds + PG8_SA(b, h) + aoff + m * 2048 + 1024); \
        dst##_8[m] = __builtin_shufflevector(lo_, hi_, 0, 1, 2, 3, 4, 5, 6, 7); } else { _Pragma("unroll") for (int k = 0; k < 2; ++k) dst[m][k] = *(const PG8_LAS bf16x8*)(lds + PG8_SA(b, h) + aoff + m * 2048 + k * 1024); } } } while (0)
#define PG8_LDB(dst, b, h) do { _Pragma("unroll") for (int n = 0; n < 2; ++n) { if (f8_) { const pg8_v4i lo_ = *(const PG8_LAS pg8_v4i*)(lds + PG8_SB(b, h) + boff + n * 2048), hi_ = *(const PG8_LAS pg8_v4i*)(lds + PG8_SB(b, h) + boff + n * 2048 + 1024); \
        dst##_8[n] = __builtin_shufflevector(lo_, hi_, 0, 1, 2, 3, 4, 5, 6, 7); } else { _Pragma("unroll") for (int k = 0; k < 2; ++k) dst[n][k] = *(const PG8_LAS bf16x8*)(lds + PG8_SB(b, h) + boff + n * 2048 + k * 1024); } } } while (0)
#define PG8_MMA(ai, bj, At, Bt) do { __builtin_amdgcn_s_setprio(1); _Pragma("unroll") for (int m = 0; m < 4; ++m) _Pragma("unroll") for (int n = 0; n < 2; ++n) { \
        if (f8_) { asm volatile("v_mfma_f32_16x16x128_f8f6f4 %0, %1, %2, %0" : "+v"(acc[ai][bj][m][n]) : "v"(Bt##_8[n]), "v"(At##_8[m])); } \
        else { _Pragma("unroll") for (int k = 0; k < 2; ++k) acc[ai][bj][m][n] = __builtin_amdgcn_mfma_f32_16x16x32_bf16(Bt[n][k], At[m][k], acc[ai][bj][m][n], 0, 0, 0); } } \
        __builtin_amdgcn_s_setprio(0); } while (0)
#define PG8_WAIT_V(n) asm volatile("s_waitcnt vmcnt(" #n ")" ::: "memory")
#define PG8_WAIT_L(n) asm volatile("s_waitcnt lgkmcnt(" #n ")" ::: "memory")
#define PG8_BAR __builtin_amdgcn_s_barrier()
#define PG8_SCHED __builtin_amdgcn_sched_barrier(0)
    Unit cur, nxt; int ui = 0;
    if (!S.next(0, cur)) return;
    f32x4 acc[2][2][4][2];
#pragma unroll
    for (int a = 0; a < 2; ++a)
#pragma unroll
        for (int b = 0; b < 2; ++b)
#pragma unroll
            for (int m = 0; m < 4; ++m)
#pragma unroll
                for (int n = 0; n < 2; ++n) acc[a][b][m][n] = (f32x4){0.f, 0.f, 0.f, 0.f};
    bf16x8 At[4][2], B0[2][2], B1[2][2]; pg8_v8i At_8[4], B0_8[2], B1_8[2]; const int f8scale = 0x7F7F7F7F;
    unsigned vAc[2][2] = {{0u, 0u}, {0u, 0u}}, vAn[2][2] = {{0u, 0u}, {0u, 0u}};
    if constexpr (GATHER) PG8_GVOFF(cur, vAc);
    const char* cA = (const char*)g.A + (GATHER ? (size_t)0 : (size_t)cur.pm * tstep); const char* cB = (const char*)g.Bt + (size_t)cur.pn * tstepB;
    S.a_ready(cur);
    if constexpr (SP2) {
        PG8_STAGE(PG8_SB(0, 0), cB, voffB); PG8_STAGE(PG8_SB(0, 1), cB + hstepB, voffB); PG8_STAGE_A(PG8_SA(0, 0), cA, 0, false); PG8_STAGE_A(PG8_SA(0, 1), cA, 1, false);
        if (wr == 1) PG8_BAR;
        PG8_WAIT_V(2); PG8_BAR;
        PG8_STAGE(PG8_SB(1, 0), cB + kstepB, voffB); PG8_STAGE_A(PG8_SA(1, 0), cA + kstep, 0, false); PG8_STAGE(PG8_SB(1, 1), cB + hstepB + kstepB, voffB);
        PG8_WAIT_V(6); PG8_BAR;
    } else {
        PG8_STAGE(PG8_SB(0, 0), cB, voffB); PG8_STAGE_A(PG8_SA(0, 0), cA, 0, false); PG8_STAGE(PG8_SB(0, 1), cB + hstepB, voffB); PG8_STAGE_A(PG8_SA(0, 1), cA, 1, false);
        if (wr == 1) PG8_BAR;
        PG8_WAIT_V(4); PG8_BAR;
        PG8_STAGE(PG8_SB(1, 0), cB + kstepB, voffB); PG8_STAGE_A(PG8_SA(1, 0), cA + kstep, 0, false); PG8_STAGE(PG8_SB(1, 1), cB + hstepB + kstepB, voffB);
        PG8_WAIT_V(6); PG8_BAR;
    }
    for (;;) {
        const bool has_next = S.next(ui + 1, nxt);
        if constexpr (GATHER) { if (has_next) PG8_GVOFF(nxt, vAn); else { vAn[0][0] = vAc[0][0]; vAn[0][1] = vAc[0][1]; vAn[1][0] = vAc[1][0]; vAn[1][1] = vAc[1][1]; } }
        const char* nA = (has_next && !GATHER) ? (const char*)g.A + (size_t)nxt.pm * tstep : cA; const char* nB = has_next ? (const char*)g.Bt + (size_t)nxt.pn * tstepB : cB;
        if constexpr (NF8 > 0) {
#pragma unroll 1
        for (int t = 0; t < NF8; t += 2) { constexpr bool f8_ = true;
            const bool last = (t == nt - 2);
            if constexpr (MID) { if (t == (NF8 > 0 ? NF8 : nt / 2)) { if constexpr (NF8 > 0) asm volatile("s_nop 15\n\ts_nop 15" ::: "memory"); E.mid(acc, cur, wr, wc, fr, fq); } }
            const char* a1 = cA + (size_t)(t + 1) * kstep;
            const char* a2 = last ? nA : cA + (size_t)(t + 2) * kstep; const char* b2 = last ? nB : cB + (size_t)(t + 2) * kstepB;
            const char* a3 = a2 + kstep; const char* b3 = b2 + kstepB;
            if (last && has_next) S.a_ready(nxt);
            if constexpr (SP2) {
            PG8_LDB(B0, 0, 0); PG8_LDB(B1, 0, 1); PG8_SCHED; PG8_LDA(At, 0, 0); PG8_STAGE_A(PG8_SA(1, 1), a1, 1, false);
            PG8_WAIT_V(8); PG8_WAIT_L(0); PG8_BAR; PG8_MMA(0, 0, At, B0); PG8_MMA(0, 1, At, B1); PG8_BAR; PG8_SCHED;
            PG8_LDA(At, 0, 1); PG8_STAGE(PG8_SB(0, 0), b2, voffB); PG8_STAGE(PG8_SB(0, 1), b2 + hstepB, voffB); PG8_STAGE_A(PG8_SA(0, 0), a2, 0, last);
            PG8_WAIT_V(8); PG8_WAIT_L(0); PG8_BAR; PG8_MMA(1, 0, At, B0); PG8_MMA(1, 1, At, B1); PG8_BAR; PG8_SCHED;
            PG8_LDB(B0, 1, 0); PG8_LDB(B1, 1, 1); PG8_SCHED; PG8_LDA(At, 1, 0); PG8_STAGE_A(PG8_SA(0, 1), a2, 1, last);
            PG8_WAIT_V(8); PG8_WAIT_L(0); PG8_BAR; PG8_MMA(0, 0, At, B0); PG8_MMA(0, 1, At, B1); PG8_BAR; PG8_SCHED;
            PG8_LDA(At, 1, 1); PG8_STAGE(PG8_SB(1, 0), b3, voffB); PG8_STAGE(PG8_SB(1, 1), b3 + hstepB, voffB); PG8_STAGE_A(PG8_SA(1, 0), a3, 0, last);
            PG8_WAIT_V(8); PG8_WAIT_L(0); PG8_BAR; PG8_MMA(1, 0, At, B0); PG8_MMA(1, 1, At, B1); PG8_BAR; PG8_SCHED;
            } else {
            PG8_LDB(B0, 0, 0); PG8_SCHED; PG8_LDA(At, 0, 0); PG8_STAGE_A(PG8_SA(1, 1), a1, 1, false);
            PG8_WAIT_L(8); PG8_BAR; PG8_WAIT_L(0); PG8_MMA(0, 0, At, B0); PG8_BAR; PG8_SCHED;
            PG8_LDB(B1, 0, 1); PG8_STAGE(PG8_SB(0, 0), b2, voffB);
            PG8_BAR; PG8_WAIT_L(0); PG8_MMA(0, 1, At, B1); PG8_BAR;
            PG8_LDA(At, 0, 1); PG8_STAGE_A(PG8_SA(0, 0), a2, 0, last);
            PG8_BAR; PG8_WAIT_L(0); PG8_MMA(1, 0, At, B0); PG8_BAR; PG8_SCHED;
            PG8_STAGE(PG8_SB(0, 1), b2 + hstepB, voffB);
            PG8_WAIT_V(6); PG8_BAR; PG8_MMA(1, 1, At, B1); PG8_BAR;
            PG8_LDB(B0, 1, 0); PG8_SCHED; PG8_LDA(At, 1, 0); PG8_STAGE_A(PG8_SA(0, 1), a2, 1, last);
            PG8_WAIT_L(8); PG8_BAR; PG8_WAIT_L(0); PG8_MMA(0, 0, At, B0); PG8_BAR; PG8_SCHED;
            PG8_LDB(B1, 1, 1); PG8_STAGE(PG8_SB(1, 0), b3, voffB);
            PG8_BAR; PG8_WAIT_L(0); PG8_MMA(0, 1, At, B1); PG8_BAR;
            PG8_LDA(At, 1, 1); PG8_STAGE_A(PG8_SA(1, 0), a3, 0, last);
            PG8_BAR; PG8_WAIT_L(0); PG8_MMA(1, 0, At, B0); PG8_BAR; PG8_SCHED;
            PG8_STAGE(PG8_SB(1, 1), b3 + hstepB, voffB);
            PG8_WAIT_V(6); PG8_BAR; PG8_MMA(1, 1, At, B1); PG8_BAR;
            }
        }
#pragma unroll 1
        for (int t = NF8; t < nt; t += 2) { constexpr bool f8_ = false;
            const bool last = (t == nt - 2);
            if constexpr (MID) { if (t == (NF8 > 0 ? NF8 : nt / 2)) { if constexpr (NF8 > 0) asm volatile("s_nop 15\n\ts_nop 15" ::: "memory"); E.mid(acc, cur, wr, wc, fr, fq); } }
            const char* a1 = cA + (size_t)(t + 1) * kstep;
            const char* a2 = last ? nA : cA + (size_t)(t + 2) * kstep; const char* b2 = last ? nB : cB + (size_t)(t + 2) * kstepB;
            const char* a3 = a2 + kstep; const char* b3 = b2 + kstepB;
            if (last && has_next) S.a_ready(nxt);
            if constexpr (SP2) {
            PG8_LDB(B0, 0, 0); PG8_LDB(B1, 0, 1); PG8_SCHED; PG8_LDA(At, 0, 0); PG8_STAGE_A(PG8_SA(1, 1), a1, 1, false);
            PG8_WAIT_V(8); PG8_WAIT_L(0); PG8_BAR; PG8_MMA(0, 0, At, B0); PG8_MMA(0, 1, At, B1); PG8_BAR; PG8_SCHED;
            PG8_LDA(At, 0, 1); PG8_STAGE(PG8_SB(0, 0), b2, voffB); PG8_STAGE(PG8_SB(0, 1), b2 + hstepB, voffB); PG8_STAGE_A(PG8_SA(0, 0), a2, 0, last);
            PG8_WAIT_V(8); PG8_WAIT_L(0); PG8_BAR; PG8_MMA(1, 0, At, B0); PG8_MMA(1, 1, At, B1); PG8_BAR; PG8_SCHED;
            PG8_LDB(B0, 1, 0); PG8_LDB(B1, 1, 1); PG8_SCHED; PG8_LDA(At, 1, 0); PG8_STAGE_A(PG8_SA(0, 1), a2, 1, last);
            PG8_WAIT_V(8); PG8_WAIT_L(0); PG8_BAR; PG8_MMA(0, 0, At, B0); PG8_MMA(0, 1, At, B1); PG8_BAR; PG8_SCHED;
            PG8_LDA(At, 1, 1); PG8_STAGE(PG8_SB(1, 0), b3, voffB); PG8_STAGE(PG8_SB(1, 1), b3 + hstepB, voffB); PG8_STAGE_A(PG8_SA(1, 0), a3, 0, last);
            PG8_WAIT_V(8); PG8_WAIT_L(0); PG8_BAR; PG8_MMA(1, 0, At, B0); PG8_MMA(1, 1, At, B1); PG8_BAR; PG8_SCHED;
            } else {
            PG8_LDB(B0, 0, 0); PG8_SCHED; PG8_LDA(At, 0, 0); PG8_STAGE_A(PG8_SA(1, 1), a1, 1, false);
            PG8_WAIT_L(8); PG8_BAR; PG8_WAIT_L(0); PG8_MMA(0, 0, At, B0); PG8_BAR; PG8_SCHED;
            PG8_LDB(B1, 0, 1); PG8_STAGE(PG8_SB(0, 0), b2, voffB);
            PG8_BAR; PG8_WAIT_L(0); PG8_MMA(0, 1, At, B1); PG8_BAR;
            PG8_LDA(At, 0, 1); PG8_STAGE_A(PG8_SA(0, 0), a2, 0, last);
            PG8_BAR; PG8_WAIT_L(0); PG8_MMA(1, 0, At, B0); PG8_BAR; PG8_SCHED;
            PG8_STAGE(PG8_SB(0, 1), b2 + hstepB, voffB);
            PG8_WAIT_V(6); PG8_BAR; PG8_MMA(1, 1, At, B1); PG8_BAR;
            PG8_LDB(B0, 1, 0); PG8_SCHED; PG8_LDA(At, 1, 0); PG8_STAGE_A(PG8_SA(0, 1), a2, 1, last);
            PG8_WAIT_L(8); PG8_BAR; PG8_WAIT_L(0); PG8_MMA(0, 0, At, B0); PG8_BAR; PG8_SCHED;
            PG8_LDB(B1, 1, 1); PG8_STAGE(PG8_SB(1, 0), b3, voffB);
            PG8_BAR; PG8_WAIT_L(0); PG8_MMA(0, 1, At, B1); PG8_BAR;
            PG8_LDA(At, 1, 1); PG8_STAGE_A(PG8_SA(1, 0), a3, 0, last);
            PG8_BAR; PG8_WAIT_L(0); PG8_MMA(1, 0, At, B0); PG8_BAR; PG8_SCHED;
            PG8_STAGE(PG8_SB(1, 1), b3 + hstepB, voffB);
            PG8_WAIT_V(6); PG8_BAR; PG8_MMA(1, 1, At, B1); PG8_BAR;
            }
        }
        } else {
#pragma unroll 1
        for (int t = 0; t < nt; t += 2) { constexpr bool f8_ = FP8;
            const bool last = (t == nt - 2);
            if constexpr (MID) { if (t == (NF8 > 0 ? NF8 : nt / 2)) { if constexpr (NF8 > 0) asm volatile("s_nop 15\n\ts_nop 15" ::: "memory"); E.mid(acc, cur, wr, wc, fr, fq); } }
            const char* a1 = cA + (size_t)(t + 1) * kstep;
            const char* a2 = last ? nA : cA + (size_t)(t + 2) * kstep; const char* b2 = last ? nB : cB + (size_t)(t + 2) * kstepB;
            const char* a3 = a2 + kstep; const char* b3 = b2 + kstepB;
            if (last && has_next) S.a_ready(nxt);
            if constexpr (SP2) {
            PG8_LDB(B0, 0, 0); PG8_LDB(B1, 0, 1); PG8_SCHED; PG8_LDA(At, 0, 0); PG8_STAGE_A(PG8_SA(1, 1), a1, 1, false);
            PG8_WAIT_V(8); PG8_WAIT_L(0); PG8_BAR; PG8_MMA(0, 0, At, B0); PG8_MMA(0, 1, At, B1); PG8_BAR; PG8_SCHED;
            PG8_LDA(At, 0, 1); PG8_STAGE(PG8_SB(0, 0), b2, voffB); PG8_STAGE(PG8_SB(0, 1), b2 + hstepB, voffB); PG8_STAGE_A(PG8_SA(0, 0), a2, 0, last);
            PG8_WAIT_V(8); PG8_WAIT_L(0); PG8_BAR; PG8_MMA(1, 0, At, B0); PG8_MMA(1, 1, At, B1); PG8_BAR; PG8_SCHED;
            PG8_LDB(B0, 1, 0); PG8_LDB(B1, 1, 1); PG8_SCHED; PG8_LDA(At, 1, 0); PG8_STAGE_A(PG8_SA(0, 1), a2, 1, last);
            PG8_WAIT_V(8); PG8_WAIT_L(0); PG8_BAR; PG8_MMA(0, 0, At, B0); PG8_MMA(0, 1, At, B1); PG8_BAR; PG8_SCHED;
            PG8_LDA(At, 1, 1); PG8_STAGE(PG8_SB(1, 0), b3, voffB); PG8_STAGE(PG8_SB(1, 1), b3 + hstepB, voffB); PG8_STAGE_A(PG8_SA(1, 0), a3, 0, last);
            PG8_WAIT_V(8); PG8_WAIT_L(0); PG8_BAR; PG8_MMA(1, 0, At, B0); PG8_MMA(1, 1, At, B1); PG8_BAR; PG8_SCHED;
            } else {
            PG8_LDB(B0, 0, 0); PG8_SCHED; PG8_LDA(At, 0, 0); PG8_STAGE_A(PG8_SA(1, 1), a1, 1, false);
            PG8_WAIT_L(8); PG8_BAR; PG8_WAIT_L(0); PG8_MMA(0, 0, At, B0); PG8_BAR; PG8_SCHED;
            PG8_LDB(B1, 0, 1); PG8_STAGE(PG8_SB(0, 0), b2, voffB);
            PG8_BAR; PG8_WAIT_L(0); PG8_MMA(0, 1, At, B1); PG8_BAR;
            PG8_LDA(At, 0, 1); PG8_STAGE_A(PG8_SA(0, 0), a2, 0, last);
            PG8_BAR; PG8_WAIT_L(0); PG8_MMA(1, 0, At, B0); PG8_BAR; PG8_SCHED;
            PG8_STAGE(PG8_SB(0, 1), b2 + hstepB, voffB);
            PG8_WAIT_V(6); PG8_BAR; PG8_MMA(1, 1, At, B1); PG8_BAR;
            PG8_LDB(B0, 1, 0); PG8_SCHED; PG8_LDA(At, 1, 0); PG8_STAGE_A(PG8_SA(0, 1), a2, 1, last);
            PG8_WAIT_L(8); PG8_BAR; PG8_WAIT_L(0); PG8_MMA(0, 0, At, B0); PG8_BAR; PG8_SCHED;
            PG8_LDB(B1, 1, 1); PG8_STAGE(PG8_SB(1, 0), b3, voffB);
            PG8_BAR; PG8_WAIT_L(0); PG8_MMA(0, 1, At, B1); PG8_BAR;
            PG8_LDA(At, 1, 1); PG8_STAGE_A(PG8_SA(1, 0), a3, 0, last);
            PG8_BAR; PG8_WAIT_L(0); PG8_MMA(1, 0, At, B0); PG8_BAR; PG8_SCHED;
            PG8_STAGE(PG8_SB(1, 1), b3 + hstepB, voffB);
            PG8_WAIT_V(6); PG8_BAR; PG8_MMA(1, 1, At, B1); PG8_BAR;
            }
        }
        }
        if constexpr (ALIGN_EPI) { if (wr == 0) PG8_BAR; }
        if constexpr (FP8) asm volatile("s_nop 15\n\ts_nop 15" ::: "memory");
        if constexpr (!Epi::AFTER_DRAIN) { E(acc, cur, wr, wc, fr, fq); S.done(cur); }
        if (!has_next) break;
#pragma unroll
        for (int a = 0; a < 2; ++a)
#pragma unroll
            for (int b = 0; b < 2; ++b)
#pragma unroll
                for (int m = 0; m < 4; ++m)
#pragma unroll
                    for (int n = 0; n < 2; ++n) acc[a][b][m][n] = (f32x4){0.f, 0.f, 0.f, 0.f};
        cur = nxt; cA = nA; cB = nB; ++ui;
        if constexpr (GATHER) { vAc[0][0] = vAn[0][0]; vAc[0][1] = vAn[0][1]; vAc[1][0] = vAn[1][0]; vAc[1][1] = vAn[1][1]; }
        if constexpr (ALIGN_EPI) { if (wr == 1) PG8_BAR; }
    }
    PG8_WAIT_V(0);
    if constexpr (!ALIGN_EPI) { if (wr == 0) PG8_BAR; }
    PG8_BAR;
    if constexpr (Epi::AFTER_DRAIN) { E.fused(acc, cur, wr, wc, fr, fq, lds, wid, lane); S.done(cur); }
#undef PG8_SA
#undef PG8_SB
#undef PG8_STAGE
#undef PG8_GVOFF
#undef PG8_STAGE_A
#undef PG8_LDA
#undef PG8_LDB
#undef PG8_MMA
#undef PG8_WAIT_V
#undef PG8_WAIT_L
#undef PG8_BAR
#undef PG8_SCHED
}
}
namespace attn {
using bf16 = unsigned short;
constexpr int   D = 128, NW = 8, QBLK = 32, KVBLK = 64;
constexpr float SCALE = 0.088388347648318440f;
constexpr float THR = 1.2f;
constexpr int SDEPTH = 2;
constexpr int LDQ = 8704, LDK = 128, LDO = 3072;
constexpr size_t SHM_V = KVBLK * D  , SHM_K = KVBLK * D  , SHM_ATTN = 8 * SHM_V + 8 * SHM_K + NW * 64 * 4;
using bf16x8 = __attribute__((ext_vector_type(8))) short;
using s16x4  = __attribute__((ext_vector_type(4))) short;
using f32x16 = __attribute__((ext_vector_type(16))) float;
using f32x8  = __attribute__((ext_vector_type(8))) float;
using u32x4  = __attribute__((ext_vector_type(4))) unsigned;
#define KSWZ(row, colB) ((row) * 256 + ((colB) ^ (((row) & 7) << 4)))
#define SBAR() __builtin_amdgcn_sched_barrier(0)
__device__ __forceinline__ int crow(int r, int hi) { return (r & 3) + 8 * (r >> 2) + 4 * hi; }
__device__ __forceinline__ unsigned cvtpk(float lo, float hi) {
  unsigned r; asm volatile("v_cvt_pk_bf16_f32 %0, %1, %2" : "=v"(r) : "v"(lo), "v"(hi)); return r;
}
struct StageB { using T = bf16x8;
  __device__ static __forceinline__ T ld8(const bf16* p) { return *reinterpret_cast<const bf16x8*>(p); }
  __device__ static __forceinline__ bf16x8 tobf(T x) { return x; } };
__device__ __forceinline__ void partialSM(f32x16& p0, f32x16& p1, float& m_reg, float& mn, float& alpha) {
  constexpr float C = SCALE * 1.4426950408889634f;
  float pmax = p0[0]; for (int r = 1; r < 16; ++r) pmax = fmaxf(pmax, p0[r]); for (int r = 0; r < 16; ++r) pmax = fmaxf(pmax, p1[r]);
  { auto rr = __builtin_amdgcn_permlane32_swap(__float_as_uint(pmax), __float_as_uint(pmax), false, false);
    pmax = fmaxf(__uint_as_float(rr[0]), __uint_as_float(rr[1])); }
  if (__builtin_expect(__all(pmax - m_reg <= THR / SCALE), 1)) { mn = m_reg; alpha = 1.f; }
  else { mn = fmaxf(m_reg, pmax); alpha = __builtin_amdgcn_exp2f((m_reg - mn) * C); m_reg = mn; }
  float mnC = 7.f - mn * C;
  for (int r = 0; r < 16; ++r) p0[r] = fmaf(p0[r], C, mnC); for (int r = 0; r < 16; ++r) p1[r] = fmaf(p1[r], C, mnC);
  for (int r = 0; r < 16; ++r) p0[r] = __builtin_amdgcn_exp2f(p0[r]);
}
constexpr float THR2 = THR * 1.4426950408889634f;
__device__ __forceinline__ float max3f(float a, float b, float c) { float r; asm("v_max3_f32 %0, %1, %2, %3" : "=v"(r) : "v"(a), "v"(b), "v"(c)); return r; }
__device__ __forceinline__ float max2f(float a, float b) { float r; asm("v_max_f32 %0, %1, %2" : "=v"(r) : "v"(a), "v"(b)); return r; }
template <bool FIRST> __device__ __forceinline__ void partialSM2(f32x16& p0, f32x16& p1, f32x16& negm, float& alpha, int hi) {
  float pmax;
  if (FIRST) { float pma = max2f(p0[0], p0[1]), pmb = max2f(p1[0], p1[1]);
    for (int r = 2; r < 16; r += 2) { pma = max3f(pma, p0[r], p0[r + 1]); pmb = max3f(pmb, p1[r], p1[r + 1]); }
    pma = max2f(pma, pmb);
    auto rr = __builtin_amdgcn_permlane32_swap(__float_as_uint(pma), __float_as_uint(pma), false, false);
    pmax = max2f(__uint_as_float(rr[0]), __uint_as_float(rr[1])); }
  else {
    int ia = __float_as_int(p0[0]), ib = __float_as_int(p1[0]);
    for (int r = 1; r < 16; ++r) { ia = ia > __float_as_int(p0[r]) ? ia : __float_as_int(p0[r]); ib = ib > __float_as_int(p1[r]) ? ib : __float_as_int(p1[r]); }
    ia = ia > ib ? ia : ib;
    auto rr = __builtin_amdgcn_permlane32_swap((unsigned)ia, (unsigned)ia, false, false);
    const int i0 = (int)rr[0], i1 = (int)rr[1]; pmax = __int_as_float(i0 > i1 ? i0 : i1); }
  if (!FIRST && __builtin_expect(__all(pmax <= 7.f + THR2), 1)) alpha = 1.f;
  else { float d = pmax - 7.f; if (!FIRST) d = fmaxf(d, 0.f); alpha = FIRST ? 1.f : __builtin_amdgcn_exp2f(-d);
    const float one = hi ? 0.f : 1.f, nd = hi ? 0.f : -d;
    asm volatile("s_nop 3\n\t"
                 "v_mfma_f32_32x32x2_f32 %0, %3, %4, %0\n\t"
                 "v_mfma_f32_32x32x2_f32 %1, %3, %4, %1\n\t"
                 "v_mfma_f32_32x32x2_f32 %2, %3, %4, %2\n\t"
                 "s_nop 15\n\ts_nop 7" : "+v"(p0), "+v"(p1), "+v"(negm) : "v"(one), "v"(nd)); }
#if defined(PROBE_NOEXP)
  for (int r = 0; r < 16; ++r) p0[r] = __builtin_fmaf(__builtin_fabsf(p0[r]), 0.01f, 1.f);
#else
  for (int r = 0; r < 16; ++r) p0[r] = __builtin_amdgcn_exp2f(p0[r]);
#endif
}
__device__ __forceinline__ void finishSM(f32x16& p0, f32x16& p1, float alpha, float& l_reg, bf16x8& pa0, bf16x8& pa1, bf16x8& pa2, bf16x8& pa3) {
  for (int r = 0; r < 16; ++r) p1[r] = __builtin_amdgcn_exp2f(p1[r]);
  float ps = 0; for (int r = 0; r < 16; ++r) ps += p0[r]; for (int r = 0; r < 16; ++r) ps += p1[r];
  { auto rr = __builtin_amdgcn_permlane32_swap(__float_as_uint(ps), __float_as_uint(ps), false, false);
    ps = __uint_as_float(rr[0]) + __uint_as_float(rr[1]); }
  l_reg = l_reg * alpha + ps;
#define PK4(P, BASE, OUT) do { unsigned a0 = cvtpk(P[BASE + 0], P[BASE + 1]), a1 = cvtpk(P[BASE + 2], P[BASE + 3]);   \
    unsigned b0 = cvtpk(P[BASE + 4], P[BASE + 5]), b1 = cvtpk(P[BASE + 6], P[BASE + 7]);                              \
    auto r0 = __builtin_amdgcn_permlane32_swap(a0, b0, false, false); auto r1 = __builtin_amdgcn_permlane32_swap(a1, b1, false, false); \
    u32x4 w = {r0[0], r1[0], r0[1], r1[1]}; OUT = *reinterpret_cast<bf16x8*>(&w); } while (0)
  PK4(p0, 0, pa0); PK4(p0, 8, pa1); PK4(p1, 0, pa2); PK4(p1, 8, pa3);
#undef PK4
}
typedef int v8i_p __attribute__((ext_vector_type(8))); typedef int v4i_a __attribute__((ext_vector_type(4)));
__device__ __forceinline__ int pk4f8_(float a, float b, float c, float d) { int w = 0; w = __builtin_amdgcn_cvt_pk_fp8_f32(a, b, w, false); w = __builtin_amdgcn_cvt_pk_fp8_f32(c, d, w, true); return w; }
__device__ __forceinline__ void finishSM8(f32x16& p0, f32x16& p1, float alpha, float& l_reg, v8i_p& pa) {
  for (int r = 0; r < 16; ++r) p1[r] = __builtin_amdgcn_exp2f(p1[r]);
  float ps = 0; for (int r = 0; r < 16; ++r) ps += p0[r]; for (int r = 0; r < 16; ++r) ps += p1[r];
  { auto rr = __builtin_amdgcn_permlane32_swap(__float_as_uint(ps), __float_as_uint(ps), false, false);
    ps = __uint_as_float(rr[0]) + __uint_as_float(rr[1]); }
  l_reg = l_reg * alpha + ps;
  for (int i = 0; i < 4; ++i) { pa[i] = pk4f8_(p0[4 * i], p0[4 * i + 1], p0[4 * i + 2], p0[4 * i + 3]); pa[4 + i] = pk4f8_(p1[4 * i], p1[4 * i + 1], p1[4 * i + 2], p1[4 * i + 3]); }
}
__device__ __forceinline__ void finishSM8n(f32x16& p0, f32x16& p1, v8i_p& pa) {
#if defined(PROBE_NOEXP)
  for (int r = 0; r < 16; ++r) p1[r] = __builtin_fmaf(__builtin_fabsf(p1[r]), 0.01f, 1.f);
#else
  for (int r = 0; r < 16; ++r) p1[r] = __builtin_amdgcn_exp2f(p1[r]);
#endif
  for (int i = 0; i < 4; ++i) { int w = pa[i]; w = __builtin_amdgcn_cvt_pk_fp8_f32(p0[4 * i], p0[4 * i + 1], w, false); w = __builtin_amdgcn_cvt_pk_fp8_f32(p0[4 * i + 2], p0[4 * i + 3], w, true); pa[i] = w;
    int u = pa[4 + i]; u = __builtin_amdgcn_cvt_pk_fp8_f32(p1[4 * i], p1[4 * i + 1], u, false); u = __builtin_amdgcn_cvt_pk_fp8_f32(p1[4 * i + 2], p1[4 * i + 3], u, true); pa[4 + i] = u; }
}
__host__ __device__ __forceinline__ int vt_pos(int t) { const int c = t & 31; return 32 * ((c >> 2) & 1) + 16 * (t >> 5) + (c & 3) + 4 * (c >> 3); }
__device__ __forceinline__ void pv8(f32x16* o, const char* Vt, const v8i_p& pa, int r32, int hi) {
  const int sa = 0x78787878, sb = 0x7F7F7F7F;
#pragma unroll
  for (int g = 0; g < 2; ++g) { v8i_p b[2];
#pragma unroll
    for (int e = 0; e < 2; ++e) { const int d = 32 * (2 * g + e) + r32, sw = (d >> 2) & 3;
      const v4i_a lo = *reinterpret_cast<const v4i_a*>(Vt + d * 64 + (((2 * hi) ^ sw) << 4)), up = *reinterpret_cast<const v4i_a*>(Vt + d * 64 + (((2 * hi + 1) ^ sw) << 4));
      b[e] = __builtin_shufflevector(lo, up, 0, 1, 2, 3, 4, 5, 6, 7); }
    asm volatile("v_mfma_scale_f32_32x32x64_f8f6f4 %0, %2, %3, %0, %5, %6 op_sel_hi:[0,0,0]\n\t"
                 "v_mfma_scale_f32_32x32x64_f8f6f4 %1, %2, %4, %1, %5, %6 op_sel_hi:[0,0,0]"
                 : "+v"(o[2 * g]), "+v"(o[2 * g + 1]) : "v"(pa), "v"(b[0]), "v"(b[1]), "v"(sa), "v"(sb)); }
}
__device__ __forceinline__ void pv8n(f32x16* o, f32x16& lacc, const char* Vt, const v8i_p& pa, const v4i_a& ones4, int r32, int hi) {
  const int sa = 0x78787878, sb = 0x7F7F7F7F;
#pragma unroll
  for (int g = 0; g < 2; ++g) { v8i_p b[2];
#pragma unroll
    for (int e = 0; e < 2; ++e) { const int d = 32 * (2 * g + e) + r32, sw = (d >> 2) & 3;
      const v4i_a lo = *reinterpret_cast<const v4i_a*>(Vt + d * 64 + (((2 * hi) ^ sw) << 4)), up = *reinterpret_cast<const v4i_a*>(Vt + d * 64 + (((2 * hi + 1) ^ sw) << 4));
      b[e] = __builtin_shufflevector(lo, up, 0, 1, 2, 3, 4, 5, 6, 7); }
    if (g == 0) asm volatile("v_mfma_scale_f32_32x32x64_f8f6f4 %0, %2, %3, %0, %5, %6 op_sel_hi:[0,0,0]\n\t"
                 "v_mfma_scale_f32_32x32x64_f8f6f4 %1, %2, %4, %1, %5, %6 op_sel_hi:[0,0,0]"
                 : "+v"(o[0]), "+v"(o[1]) : "v"(pa), "v"(b[0]), "v"(b[1]), "v"(sa), "v"(sb));
    else        asm volatile("v_mfma_scale_f32_32x32x64_f8f6f4 %0, %3, %4, %0, %7, %8 op_sel_hi:[0,0,0]\n\t"
                 "v_mfma_scale_f32_32x32x64_f8f6f4 %1, %3, %5, %1, %7, %8 op_sel_hi:[0,0,0]\n\t"
                 "v_mfma_scale_f32_32x32x64_f8f6f4 %2, %3, %6, %2, %7, %8 op_sel_hi:[0,0,0] blgp:4"
                 : "+v"(o[2]), "+v"(o[3]), "+v"(lacc) : "v"(pa), "v"(b[0]), "v"(b[1]), "v"(ones4), "v"(sa), "v"(sb)); }
}
__device__ __forceinline__ void qkt(f32x16& p0, f32x16& p1, const bf16* Ks, const bf16x8* qr, int r32, int hi) {
  p0 = f32x16{}; p1 = f32x16{};
  for (int d0 = 0; d0 < 8; ++d0) { int cb = (d0 * 16 + hi * 8) * 2;
    bf16x8 b0 = *reinterpret_cast<const bf16x8*>((const char*)Ks + KSWZ(r32, cb));
    bf16x8 b1 = *reinterpret_cast<const bf16x8*>((const char*)Ks + KSWZ(32 + r32, cb));
    p0 = __builtin_amdgcn_mfma_f32_32x32x16_bf16(b0, qr[d0], p0, 0, 0, 0);
    p1 = __builtin_amdgcn_mfma_f32_32x32x16_bf16(b1, qr[d0], p1, 0, 0, 0); }
}
typedef int v4i_a __attribute__((ext_vector_type(4))); typedef int v8i_a __attribute__((ext_vector_type(8)));
__device__ __forceinline__ void qkt8(f32x16& p0, f32x16& p1, const char* Ks, const v8i_a (&q8)[2], int r32, int hi) {
  p0 = f32x16{}; p1 = f32x16{};
  const int sc = 0x7F7F7F7F;
#pragma unroll
  for (int s = 0; s < 2; ++s) { v8i_a a[2];
#pragma unroll
    for (int kh = 0; kh < 2; ++kh) { const int row = kh * 32 + r32, cb = 64 * s + 32 * hi, sw = (row & 7) << 4;
      const v4i_a lo = *reinterpret_cast<const v4i_a*>(Ks + row * 128 + (cb ^ sw)), up = *reinterpret_cast<const v4i_a*>(Ks + row * 128 + ((cb + 16) ^ sw));
      a[kh] = __builtin_shufflevector(lo, up, 0, 1, 2, 3, 4, 5, 6, 7); }
    if (s == 0) asm volatile("s_nop 3\n\t"
                 "v_mfma_scale_f32_32x32x64_f8f6f4 %0, %2, %4, %0, %5, %5 op_sel_hi:[0,0,0]\n\t"
                 "v_mfma_scale_f32_32x32x64_f8f6f4 %1, %3, %4, %1, %5, %5 op_sel_hi:[0,0,0]"
                 : "+v"(p0), "+v"(p1) : "v"(a[0]), "v"(a[1]), "v"(q8[0]), "v"(sc));
    else        asm volatile("v_mfma_scale_f32_32x32x64_f8f6f4 %0, %2, %4, %0, %5, %5 op_sel_hi:[0,0,0]\n\t"
                 "v_mfma_scale_f32_32x32x64_f8f6f4 %1, %3, %4, %1, %5, %5 op_sel_hi:[0,0,0]\n\t"
                 "s_nop 15\n\ts_nop 7"
                 : "+v"(p0), "+v"(p1) : "v"(a[0]), "v"(a[1]), "v"(q8[1]), "v"(sc)); }
}
__device__ __forceinline__ void qkt8n(f32x16& p0, f32x16& p1, const char* Ks, const v8i_a (&q8)[2], const f32x16& negm, int r32, int hi) {
  const int sk = 0x7F7F7F7F, sq = 0x7C7C7C7C;
#pragma unroll
  for (int s = 0; s < 2; ++s) { v8i_a a[2];
#pragma unroll
    for (int kh = 0; kh < 2; ++kh) { const int row = kh * 32 + r32, cb = 64 * s + 32 * hi, sw = (row & 7) << 4;
      const v4i_a lo = *reinterpret_cast<const v4i_a*>(Ks + row * 128 + (cb ^ sw)), up = *reinterpret_cast<const v4i_a*>(Ks + row * 128 + ((cb + 16) ^ sw));
      a[kh] = __builtin_shufflevector(lo, up, 0, 1, 2, 3, 4, 5, 6, 7); }
    if (s == 0) asm volatile("s_nop 3\n\t"
                 "v_mfma_scale_f32_32x32x64_f8f6f4 %0, %2, %4, %5, %6, %7 op_sel_hi:[0,0,0]\n\t"
                 "v_mfma_scale_f32_32x32x64_f8f6f4 %1, %3, %4, %5, %6, %7 op_sel_hi:[0,0,0]"
                 : "=&v"(p0), "=&v"(p1) : "v"(a[0]), "v"(a[1]), "v"(q8[0]), "v"(negm), "v"(sk), "v"(sq));
    else        asm volatile("v_mfma_scale_f32_32x32x64_f8f6f4 %0, %2, %4, %0, %5, %6 op_sel_hi:[0,0,0]\n\t"
                 "v_mfma_scale_f32_32x32x64_f8f6f4 %1, %3, %4, %1, %5, %6 op_sel_hi:[0,0,0]\n\t"
                 "s_nop 15\n\ts_nop 7"
                 : "+v"(p0), "+v"(p1) : "v"(a[0]), "v"(a[1]), "v"(q8[1]), "v"(sk), "v"(sq)); }
}
__device__ __forceinline__ void ldK8(v8i_a (&ka)[2][2], const char* Ks, int r32, int hi) {
#if defined(PROBE_LDSBCAST)
  r32 = 0; hi = 0;
#endif
#pragma unroll
  for (int s = 0; s < 2; ++s)
#pragma unroll
    for (int kh = 0; kh < 2; ++kh) { const int row = kh * 32 + r32, cb = 64 * s + 32 * hi, sw = ((row >> 1) & 7) << 4;
      const v4i_a lo = *reinterpret_cast<const v4i_a*>(Ks + row * 128 + (cb ^ sw)), up = *reinterpret_cast<const v4i_a*>(Ks + row * 128 + ((cb + 16) ^ sw));
      ka[s][kh] = __builtin_shufflevector(lo, up, 0, 1, 2, 3, 4, 5, 6, 7); }
}
__device__ __forceinline__ void ldV8one(v8i_p& b, const char* Vt, int blk, int r32, int hi) {
  const int d = 32 * blk + r32, sw = (d >> 2) & 3;
  const v4i_a lo = *reinterpret_cast<const v4i_a*>(Vt + d * 64 + (((2 * hi) ^ sw) << 4)), up = *reinterpret_cast<const v4i_a*>(Vt + d * 64 + (((2 * hi + 1) ^ sw) << 4));
  b = __builtin_shufflevector(lo, up, 0, 1, 2, 3, 4, 5, 6, 7);
}
__device__ __forceinline__ void ldV8(v8i_p (&b)[2], const char* Vt, int g, int r32, int hi) {
#if defined(PROBE_LDSBCAST)
  r32 = 0; hi = 0;
#endif
#pragma unroll
  for (int e = 0; e < 2; ++e) { const int d = 32 * (2 * g + e) + r32, sw = (d >> 2) & 3;
    const v4i_a lo = *reinterpret_cast<const v4i_a*>(Vt + d * 64 + (((2 * hi) ^ sw) << 4)), up = *reinterpret_cast<const v4i_a*>(Vt + d * 64 + (((2 * hi + 1) ^ sw) << 4));
    b[e] = __builtin_shufflevector(lo, up, 0, 1, 2, 3, 4, 5, 6, 7); }
}
template <bool TAILNOP> __device__ __forceinline__ void qk_mma(f32x16& p0, f32x16& p1, const v8i_a (&ka)[2][2], const v8i_a (&q8)[2], const f32x16& negm) {
  asm volatile("s_nop 3\n\t"
               "v_mfma_f32_32x32x64_f8f6f4 %0, %2, %4, %5\n\t"
               "v_mfma_f32_32x32x64_f8f6f4 %1, %3, %4, %5"
               : "=&v"(p0), "=&v"(p1) : "v"(ka[0][0]), "v"(ka[0][1]), "v"(q8[0]), "v"(negm));
#if defined(PROBE_DUPMFMA)
  for (int rep = 0; rep < 2; ++rep)
  asm volatile("v_mfma_f32_32x32x64_f8f6f4 %0, %2, %4, %5\n\t"
               "v_mfma_f32_32x32x64_f8f6f4 %1, %3, %4, %5"
               : "=&v"(p0), "=&v"(p1) : "v"(ka[0][0]), "v"(ka[0][1]), "v"(q8[0]), "v"(negm));
#endif
#if defined(PROBE_FEWMFMA)
  if (TAILNOP) asm volatile("s_nop 15\n\ts_nop 7" ::: "memory");
  return;
#endif
  if (TAILNOP) asm volatile("v_mfma_f32_32x32x64_f8f6f4 %0, %2, %4, %0\n\t"
               "v_mfma_f32_32x32x64_f8f6f4 %1, %3, %4, %1\n\t"
               "s_nop 15\n\ts_nop 7"
               : "+v"(p0), "+v"(p1) : "v"(ka[1][0]), "v"(ka[1][1]), "v"(q8[1]));
  else         asm volatile("v_mfma_f32_32x32x64_f8f6f4 %0, %2, %4, %0\n\t"
               "v_mfma_f32_32x32x64_f8f6f4 %1, %3, %4, %1"
               : "+v"(p0), "+v"(p1) : "v"(ka[1][0]), "v"(ka[1][1]), "v"(q8[1]));
}
__device__ __forceinline__ void pv_mma0(f32x16* o, const v8i_p& pa, const v8i_p (&b)[2]) {
  asm volatile("v_mfma_f32_32x32x64_f8f6f4 %0, %2, %3, %0\n\t"
               "v_mfma_f32_32x32x64_f8f6f4 %1, %2, %4, %1"
               : "+v"(o[0]), "+v"(o[1]) : "v"(pa), "v"(b[0]), "v"(b[1]));
}
__device__ __forceinline__ void pv_mma1(f32x16* o, f32x16& lacc, const v8i_p& pa, const v8i_p (&b)[2], const v4i_a& ones4) {
#if defined(PROBE_FEWMFMA)
  asm volatile("v_mfma_f32_32x32x64_f8f6f4 %2, %3, %6, %2 blgp:4"
               : "+v"(o[2]), "+v"(o[3]), "+v"(lacc) : "v"(pa), "v"(b[0]), "v"(b[1]), "v"(ones4));
  return;
#endif
  asm volatile("v_mfma_f32_32x32x64_f8f6f4 %0, %3, %4, %0\n\t"
               "v_mfma_f32_32x32x64_f8f6f4 %1, %3, %5, %1\n\t"
               "v_mfma_f32_32x32x64_f8f6f4 %2, %3, %6, %2 blgp:4"
               : "+v"(o[2]), "+v"(o[3]), "+v"(lacc) : "v"(pa), "v"(b[0]), "v"(b[1]), "v"(ones4));
}
__device__ __forceinline__ int v_st(int k, int c) { const int kk = (k & ~0xC) | ((k & 4) << 1) | ((k & 8) >> 1); return ((kk >> 3) * 4 + (c >> 5)) * 512 + ((kk & 7) * 32 + (c & 31)) * 2; }
__device__ __forceinline__ int v_rd_base(int lane) { return ((lane & 3) << 3) | (((lane >> 2) & 3) << 6) | (((lane >> 4) & 1) << 5) | (((lane >> 5) & 1) << 8); }
constexpr int v_rd_off(int d0, int ks, int half) { return d0 * 512 + ks * 4096 + half * 2048; }
template <int OFF> __device__ __forceinline__ s16x4 tr_read(int vb) {
  s16x4 r; asm volatile("ds_read_b64_tr_b16 %0, %1 offset:%2" : "=&v"(r) : "v"(vb), "i"(OFF) : "memory"); return r;
}
template <int D0> __device__ __forceinline__ void pv_one(f32x16& od, int vb, bf16x8 pa0, bf16x8 pa1, bf16x8 pa2, bf16x8 pa3) {
  const s16x4 l0 = tr_read<v_rd_off(D0, 0, 0)>(vb), h0 = tr_read<v_rd_off(D0, 0, 1)>(vb), l1 = tr_read<v_rd_off(D0, 1, 0)>(vb), h1 = tr_read<v_rd_off(D0, 1, 1)>(vb);
  const s16x4 l2 = tr_read<v_rd_off(D0, 2, 0)>(vb), h2 = tr_read<v_rd_off(D0, 2, 1)>(vb), l3 = tr_read<v_rd_off(D0, 3, 0)>(vb), h3 = tr_read<v_rd_off(D0, 3, 1)>(vb);
  asm volatile("s_waitcnt lgkmcnt(0)" ::: "memory"); SBAR();
#define PK(L, H) (bf16x8){L[0], L[1], L[2], L[3], H[0], H[1], H[2], H[3]}
  od = __builtin_amdgcn_mfma_f32_32x32x16_bf16(pa0, PK(l0, h0), od, 0, 0, 0);
  od = __builtin_amdgcn_mfma_f32_32x32x16_bf16(pa1, PK(l1, h1), od, 0, 0, 0);
  od = __builtin_amdgcn_mfma_f32_32x32x16_bf16(pa2, PK(l2, h2), od, 0, 0, 0);
  od = __builtin_amdgcn_mfma_f32_32x32x16_bf16(pa3, PK(l3, h3), od, 0, 0, 0);
#undef PK
}
__device__ __forceinline__ void pv_d0(f32x16* o, int vb, bf16x8 pa0, bf16x8 pa1, bf16x8 pa2, bf16x8 pa3) {
  pv_one<0>(o[0], vb, pa0, pa1, pa2, pa3); pv_one<1>(o[1], vb, pa0, pa1, pa2, pa3); pv_one<2>(o[2], vb, pa0, pa1, pa2, pa3); pv_one<3>(o[3], vb, pa0, pa1, pa2, pa3);
}

__device__ __forceinline__ void attn_dense_body(const bf16* __restrict__ Qb, const unsigned char* __restrict__ Kh, const unsigned char* __restrict__ Vh,
                                                unsigned char* __restrict__ Ob, int seq, char* lds) {
  using St = StageB; using SQ = StageB;
  int tid_ = threadIdx.x; asm volatile("v_mov_b32 %0, %0" : "+v"(tid_));
  const int tid = tid_, wid = tid >> 6, lane = tid & 63, r32 = lane & 31, hi = lane >> 5;
  bf16* V_lds = (bf16*)lds; bf16* K_lds = (bf16*)(lds + 8 * SHM_V);
  float* ws = (float*)(lds + 8 * SHM_V + 8 * SHM_K) + wid * 64; float* li_l = ws; float* al_l = ws + 32;
  f32x16 o[4] = {}, lacc = {}; v8i_a qr[2]; f32x16 negm; v8i_p pa = {}; v4i_a ones4;
  for (int i = 0; i < 4; ++i) ones4[i] = 0x22222222;
  { float seven; asm volatile("v_mov_b32 %0, 0x40e00000" : "=v"(seven)); for (int r = 0; r < 16; ++r) negm[r] = seven; }
  constexpr float QS = SCALE * 1.4426950408889634f;
#pragma unroll
  for (int s = 0; s < 2; ++s) { const bf16* qp = Qb + (long)(wid * QBLK + r32) * LDQ + 64 * s + 32 * hi; unsigned wq[16];
#pragma unroll
    for (int i = 0; i < 4; ++i) { const u32x4 w = *reinterpret_cast<const u32x4*>(qp + 8 * i); wq[4 * i] = w.x; wq[4 * i + 1] = w.y; wq[4 * i + 2] = w.z; wq[4 * i + 3] = w.w; }
#pragma unroll
    for (int i = 0; i < 8; ++i) { int d = 0; d = __builtin_amdgcn_cvt_pk_fp8_f32(QS * __uint_as_float(wq[2 * i] << 16), QS * __uint_as_float(wq[2 * i] & 0xffff0000u), d, false);
      d = __builtin_amdgcn_cvt_pk_fp8_f32(QS * __uint_as_float(wq[2 * i + 1] << 16), QS * __uint_as_float(wq[2 * i + 1] & 0xffff0000u), d, true); qr[s][i] = d; } }
  const int vst = (tid >> 2) * 64 + ((((tid & 3) ^ ((tid >> 4) & 3))) << 4);
  const int krow = tid >> 3, kch = tid & 7, kst = krow * 128 + ((kch * 16) ^ (((krow >> 1) & 7) << 4));
  const int widu = __builtin_amdgcn_readfirstlane(wid);
  PG8_LAS unsigned char* ldsA = (PG8_LAS unsigned char*)lds;
#define SDMA(b, k0) do { \
    __builtin_amdgcn_global_load_lds((const unsigned*)(Vh + (long)(k0) * 128 + vst), (PG8_LAS unsigned*)(ldsA + (b) * SHM_V + widu * 1024), 16, 0, 0); \
    __builtin_amdgcn_global_load_lds((const unsigned*)(Kh + (long)(k0) * 128 + kst), (PG8_LAS unsigned*)(ldsA + 8 * SHM_V + (b) * SHM_K + widu * 1024), 16, 0, 0); } while (0)
#define SWAIT() asm volatile("s_waitcnt vmcnt(0)" ::: "memory")
#define RESC(a) do { if (__any((a) < 1.f)) { if (hi == 0) al_l[r32] = (a); asm volatile("s_nop 15\n\ts_nop 15\n\ts_waitcnt lgkmcnt(0)" ::: "memory"); \
    for (int r = 0; r < 16; ++r) { const float a_ = al_l[crow(r, hi)]; for (int d = 0; d < 4; ++d) o[d][r] *= a_; lacc[r] *= a_; } } } while (0)
  f32x16 p0, p1; float al; const int NT = seq / KVBLK;
  const bool halfB = widu >= 4;
#define KB(i) ((const char*)K_lds + (i) * SHM_K)
#define VB(i) ((const char*)V_lds + (i) * SHM_V)
#define BAR() __builtin_amdgcn_s_barrier()
  SDMA(0, 0); SDMA(1, KVBLK); SDMA(2, 2 * KVBLK); SDMA(3, 3 * KVBLK); SWAIT(); BAR();
  if (halfB) BAR();
  v8i_a ka[2][2]; v8i_p vb[2];
  ldK8(ka, KB(0), r32, hi);
  qk_mma<true>(p0, p1, ka, qr, negm);
  BAR();
  SDMA(4, 4 * KVBLK);
  ldK8(ka, KB(1), r32, hi); ldV8(vb, VB(0), 0, r32, hi); SBAR();
  partialSM2<true>(p0, p1, negm, al, hi); finishSM8n(p0, p1, pa); SBAR(); BAR();
#pragma unroll 1
  for (int tau = 1; tau < NT; ++tau) {
    { v8i_p vc[2];
      qk_mma<false>(p0, p1, ka, qr, negm); SBAR();
      ldV8(vc, VB((tau - 1) & 7), 1, r32, hi); SBAR();
      pv_mma0(o, pa, vb); pv_mma1(o, lacc, pa, vc, ones4); SBAR(); }
    if (tau + 3 < NT) asm volatile("s_waitcnt vmcnt(2)" ::: "memory"); else asm volatile("s_waitcnt vmcnt(0)" ::: "memory");
    BAR();
    if (tau + 4 < NT) SDMA((tau + 4) & 7, (tau + 4) * KVBLK);
    if (tau + 1 < NT) ldK8(ka, KB((tau + 1) & 7), r32, hi);
    ldV8(vb, VB(tau & 7), 0, r32, hi); SBAR();
    partialSM2<false>(p0, p1, negm, al, hi);
    RESC(al);
    finishSM8n(p0, p1, pa); SBAR();
    BAR();
  }
  { v8i_p vc[2]; ldV8(vc, VB((NT - 1) & 7), 1, r32, hi); pv_mma0(o, pa, vb); pv_mma1(o, lacc, pa, vc, ones4); }
  if (!halfB) BAR();
#undef BAR
#undef KB
#undef VB
  asm volatile("s_nop 15\n\ts_nop 15\n\ts_nop 15\n\ts_nop 15" ::: "memory");
  float rli[16];
#pragma unroll
  for (int r = 0; r < 16; ++r) rli[r] = __builtin_amdgcn_rcpf(lacc[r]);
  unsigned char* Ow = Ob + (long)(wid * QBLK) * LDO;
#pragma unroll
  for (int r = 0; r < 16; ++r) { int orow = crow(r, hi);
    for (int d0 = 0; d0 < 4; ++d0) { const int pk = __builtin_amdgcn_cvt_pk_fp8_f32(o[d0][r] * rli[r], 0.f, 0, false); Ow[(long)orow * LDO + d0 * 32 + r32] = (unsigned char)(pk & 0xff); } }
  __syncthreads();
#undef SDMA
#undef SWAIT
#undef RESC
}

}
#define GAS __attribute__((address_space(1)))
#define LAS __attribute__((address_space(3)))
typedef unsigned short bf16;
typedef unsigned v4u __attribute__((ext_vector_type(4)));
typedef float f32x4 __attribute__((ext_vector_type(4)));
typedef short bf16x8 __attribute__((ext_vector_type(8)));
typedef GAS unsigned gu32;
typedef GAS unsigned long long gu64;
#define RLX_AGENT __ATOMIC_RELAXED, __HIP_MEMORY_SCOPE_AGENT
#define LDS_WAIT() asm volatile("s_waitcnt lgkmcnt(0)" ::: "memory")
#define VM_WAIT() asm volatile("s_waitcnt vmcnt(0)" ::: "memory")
__device__ __forceinline__ unsigned long long rt() { return __builtin_amdgcn_s_memrealtime(); }
__device__ __forceinline__ unsigned f2bf(float f) { unsigned u = __builtin_bit_cast(unsigned, f); return (u + 0x7fffu + ((u >> 16) & 1u)) >> 16; }
__device__ __forceinline__ unsigned pk2(float lo, float hi) { unsigned r; asm volatile("v_cvt_pk_bf16_f32 %0, %1, %2" : "=v"(r) : "v"(lo), "v"(hi)); return r; }

#define XB_TMO      128
#define XB_XCNT(j)  (256  + 64 * (j))
#define XB_XSUB(j)  (1280 + 64 * (j))
#define XB_XGEN(j)  (2304 + 64 * (j))
#define XB_TOP      3328
#define XB_TOPGEN   3392
#define XCD_BAR_WORDS 3456
#define XB_SPIN_CAP (1u << 18)

__device__ __forceinline__ unsigned xb_ld(unsigned* p)              { return __hip_atomic_load(p, __ATOMIC_RELAXED, __HIP_MEMORY_SCOPE_AGENT); }
__device__ __forceinline__ unsigned xb_add(unsigned* p, unsigned v) { return __hip_atomic_fetch_add(p, v, __ATOMIC_RELAXED, __HIP_MEMORY_SCOPE_AGENT); }
__device__ __forceinline__ unsigned xb_xcc_id() { return (unsigned)__builtin_amdgcn_s_getreg((3 << 11) | 20) & 0xFu; }
#define XB_SPIN(cond, bar) do { unsigned _sp = 0; while (cond) { __builtin_amdgcn_s_sleep(1); \
    if ((++_sp & 255u) == 0u) { if (xb_ld(&(bar)[XB_TMO])) break; if (_sp > XB_SPIN_CAP) { atomicAdd(&(bar)[XB_TMO], 1u); break; } } } } while (0)

struct XcdBarrier {
    unsigned* bar; unsigned x;
    volatile LAS unsigned* st;
};

__device__ __forceinline__ XcdBarrier xcd_barrier_post(unsigned* bar, volatile LAS unsigned* st) {
    XcdBarrier b; b.bar = bar; b.x = xb_xcc_id(); b.st = st;
    if (threadIdx.x == 0) (void)xb_add(&bar[XB_XCNT(b.x)], 1u);
    return b;
}
__device__ __forceinline__ void xcd_barrier_complete(unsigned* bar, unsigned x, unsigned& nloc, unsigned& nx) {
    const unsigned G = gridDim.x * gridDim.y * gridDim.z;
    unsigned sum, cnt, mine, sp = 0u;
    for (;;) {
        sum = 0u; cnt = 0u; mine = 0u;
#pragma unroll
        for (unsigned j = 0; j < 16; ++j) { const unsigned c = xb_ld(&bar[XB_XCNT(j)]); sum += c; cnt += (c > 0u) ? 1u : 0u; mine = (j == x) ? c : mine; }
        if (sum == G) break;
        __builtin_amdgcn_s_sleep(1);
        if ((++sp & 255u) == 0u) { if (xb_ld(&bar[XB_TMO])) break; if (sp > XB_SPIN_CAP) { atomicAdd(&bar[XB_TMO], 1u); break; } }
    }
    nloc = mine > 0u ? mine : 1u; nx = cnt > 0u ? cnt : 1u;
}

__device__ __forceinline__ void xcd_barrier(const XcdBarrier& b) {
    asm volatile("s_waitcnt vmcnt(0)" ::: "memory");
    __syncthreads();
    if (threadIdx.x == 0) {
        unsigned* bar = b.bar;
        __builtin_amdgcn_s_waitcnt(0);
        unsigned nloc = b.st[0], nx = b.st[1];
        if (nloc == 0u) { xcd_barrier_complete(bar, b.x, nloc, nx); b.st[0] = nloc; b.st[1] = nx; }
        const unsigned old = xb_add(&bar[XB_XSUB(b.x)], 1u);
        const unsigned gen = old / nloc;
        if (old + 1u == (gen + 1u) * nloc) {
            __builtin_amdgcn_fence(__ATOMIC_RELEASE, "agent");
            asm volatile("s_waitcnt vmcnt(0)" ::: "memory");
            const unsigned og = xb_add(&bar[XB_TOP], 1u);
            const unsigned tg = og / nx;
            if (og + 1u == (tg + 1u) * nx) xb_add(&bar[XB_TOPGEN], 1u);
            else XB_SPIN(xb_ld(&bar[XB_TOPGEN]) == tg, bar);
            __builtin_amdgcn_fence(__ATOMIC_ACQUIRE, "agent");
            xb_add(&bar[XB_XGEN(b.x)], 1u);
            asm volatile("s_waitcnt vmcnt(0)" ::: "memory");
        } else {
            XB_SPIN(xb_ld(&bar[XB_XGEN(b.x)]) == gen, bar);
            __builtin_amdgcn_fence(__ATOMIC_ACQUIRE, "agent");
            asm volatile("s_waitcnt vmcnt(0)" ::: "memory");
        }
    }
    __syncthreads();
}
constexpr int NWAVES = 8;
constexpr int BATCH = 2, SEQ = 8192, DM = 2048, NTOK = BATCH * SEQ;
constexpr int INW = 8704, COL_Q = 0, COL_K = 1024, COL_V = 1280, COL_HY = 1536, COL_G = 4608;
constexpr int HW = 1024;
constexpr int NEXP = 32, DEXP = 1024;
constexpr int FHID = 64;
constexpr float LN_EPS = 1e-5f, QK_EPS = 1e-6f, FILTER_EPS = 1e-6f;
constexpr float ALPHA = 1.189207115002721f;
constexpr int MAXROWS = 2 * NTOK + NEXP * 256;
constexpr int ELIST = NTOK;

constexpr size_t MiB = 1u << 20;
constexpr size_t WS_CTL = 0, CTL_ZERO_BYTES = 1 * MiB;
constexpr size_t WS_STATS = 1 * MiB;
constexpr size_t WS_ROPEC = 2 * MiB, WS_ROPES = 4 * MiB;
constexpr size_t WS_H2 = 6 * MiB;
constexpr size_t WS_WRT = 8 * MiB;
constexpr size_t WS_ETOK = 9 * MiB;
constexpr size_t WS_EW = 11 * MiB;
constexpr size_t WS_META = 13 * MiB;
constexpr size_t WS_WIN = 16 * MiB;
constexpr size_t WS_WIN8 = 34 * MiB;
constexpr size_t WS_XN8 = 514 * MiB;
constexpr size_t WS_WCAT = 50 * MiB;
constexpr size_t WS_WOUT = 58 * MiB;
constexpr size_t WS_WGU = 66 * MiB;
constexpr size_t WS_WD = 322 * MiB;
constexpr size_t WS_XN = 450 * MiB;
constexpr size_t WS_ACAT = 450 * MiB;
constexpr size_t WS_KR = 514 * MiB;
constexpr size_t WS_MRG = 514 * MiB;
constexpr size_t WS_X0C = 546 * MiB;
constexpr size_t WS_Y = 450 * MiB;
constexpr size_t WS_ZT = 578 * MiB;
constexpr size_t WS_KT = 642 * MiB;
constexpr size_t WS_PROJ = 706 * MiB;
constexpr size_t WS_PRE1 = 706 * MiB;
constexpr size_t WS_H1B = 834 * MiB;
constexpr size_t WS_HB = 898 * MiB;
constexpr size_t WS_KC = 978 * MiB;
constexpr size_t WS_VC = 986 * MiB;
constexpr size_t WS_END = 994 * MiB;
constexpr int CW_TMO = 0, CW_CODE = 1;
constexpr int CW_BAR = 4096;
constexpr int CW_ECNT = 16384;

constexpr int LDS_BYTES = 147456;
constexpr int LDSCTL_OFF = 145408;
constexpr int L_MISC = LDSCTL_OFF;
constexpr int L_CNT = LDSCTL_OFF + 128;
constexpr int L_OFF = LDSCTL_OFF + 256;
constexpr int L_RBX = LDSCTL_OFF + 512;
constexpr int L_LB = LDSCTL_OFF + 1280;

struct Args { const float* in[31]; float* out; unsigned char* ws; int ph_lo, ph_hi; };
typedef unsigned long long u64;
typedef float f32x2 __attribute__((ext_vector_type(2)));
typedef unsigned u32x2 __attribute__((ext_vector_type(2)));

__device__ __forceinline__ float wave_sum(float v) {
#define WS_DPP(x, ctrl) __int_as_float(__builtin_amdgcn_update_dpp(0, __float_as_int(x), ctrl, 0xF, 0xF, true))
    v += WS_DPP(v, 0xB1);
    v += WS_DPP(v, 0x4E);
    v += WS_DPP(v, 0x141);
    v += WS_DPP(v, 0x140);
#undef WS_DPP
    { auto r = __builtin_amdgcn_permlane16_swap(__float_as_uint(v), __float_as_uint(v), false, false); v = __uint_as_float(r[0]) + __uint_as_float(r[1]); }
    { auto r = __builtin_amdgcn_permlane32_swap(__float_as_uint(v), __float_as_uint(v), false, false); v = __uint_as_float(r[0]) + __uint_as_float(r[1]); }
    return v;
}
__device__ __forceinline__ float bf_lo(unsigned w) { return __uint_as_float(w << 16); }
__device__ __forceinline__ float bf_hi(unsigned w) { return __uint_as_float(w & 0xffff0000u); }
__device__ __forceinline__ float bf_1(bf16 b) { return __uint_as_float((unsigned)b << 16); }

constexpr int W_IN = 32 * 12, W_AO = 16 * 8, W_HY = 16 * 8, W_OUT = 32 * 8, W_GU = 32 * 32 * 8, W_D = 32 * 16 * 8;
constexpr int NWITEMS = W_IN + W_HY + W_OUT;
constexpr int W8_GU = 32 * 16 * 8, W8_D = 32 * 8 * 8, NW8 = W8_GU + W8_D, W8_IN = 22 * 16, W8_AO = 8 * 8;
struct ConvItem { const float* srcL; const float* srcR; bf16* dst; int N; long hi_off; };
__device__ __forceinline__ bf16* tile_ptr(bf16* base, int K, int rt, int kb) { return base + ((size_t)rt * (K >> 6) + kb) * 16384; }
__device__ __forceinline__ ConvItem conv_decode(const Args& a, int it) {
    unsigned char* ws = a.ws; ConvItem c; int r = it;
    if (r < W_IN) { const int kb = r / 12, nt = r % 12; c.N = INW; c.srcL = a.in[3] + (size_t)(kb * 64) * INW + COL_HY + nt * 256; c.srcR = c.srcL + 128; c.dst = tile_ptr((bf16*)(ws + WS_WIN), 2048, nt, kb); return c; } r -= W_IN;
    if (r < W_HY) { const int kb = r >> 3, nt = r & 7; c.N = 2048; c.srcL = a.in[18] + (size_t)(kb * 64) * 2048 + nt * 256; c.srcR = c.srcL + 128; c.dst = (bf16*)(ws + WS_WCAT + ((size_t)nt * 24 + 8 + kb) * 32768); return c; } r -= W_HY;
    { const int kb = r >> 3, nt = r & 7; c.N = 2048; c.srcL = a.in[19] + (size_t)(kb * 64) * 2048 + nt * 256; c.srcR = c.srcL + 128; c.dst = tile_ptr((bf16*)(ws + WS_WOUT), 2048, nt, kb); return c; }
}
__device__ __forceinline__ ConvItem conv_decode8(const Args& a, int it) {
    unsigned char* ws = a.ws; ConvItem c;
    c.hi_off = 0;
    if (it < W8_GU) {
        const int e = it >> 7, q = it & 127, kb = q >> 3, u = q & 7, which = u & 1, pr = u >> 1; c.N = 1024; const size_t off = (size_t)e * 2048 * 1024 + (size_t)(kb * 128) * 1024 + pr * 256;
        c.srcL = a.in[26 + which] + off; c.srcR = c.srcL + 128;
        c.dst = (bf16*)(ws + WS_WGU + ((size_t)(e * 8 + 2 * pr) * 16 + kb) * 32768 + which * 16384);
        c.hi_off = (long)16 * 32768 - 16384;
        return c; }
    if (it >= NW8 + W8_IN) { const int r = it - NW8 - W8_IN, kb = r >> 3, nt = r & 7; c.N = 2048; c.srcL = a.in[17] + (size_t)(kb * 128) * 2048 + nt * 256; c.srcR = c.srcL + 128;
        c.dst = (bf16*)(ws + WS_WCAT + ((size_t)nt * 24 + kb) * 32768); return c; }
    if (it >= NW8) { const int r = it - NW8, kb = r / 22, nt = r % 22; c.N = INW; c.srcL = a.in[3] + (size_t)(kb * 128) * INW + (nt < 6 ? nt * 256 : COL_G + (nt - 6) * 256); c.srcR = c.srcL + 128;
        c.dst = (bf16*)(ws + WS_WIN8 + ((size_t)nt * 16 + kb) * 32768); return c; }
    const int r = it - W8_GU, e = r >> 6, q = r & 63, kb = q >> 3, nt = q & 7; c.N = 2048;
    c.srcL = a.in[28] + (size_t)e * 1024 * 2048 + (size_t)(kb * 128) * 2048 + nt * 256; c.srcR = c.srcL + 128; c.dst = (bf16*)(ws + WS_WD + ((size_t)(e * 8 + nt) * 8 + kb) * 32768); return c;
}
__device__ __forceinline__ unsigned pk4_fp8(float a, float b, float c, float d) { int w = 0; w = __builtin_amdgcn_cvt_pk_fp8_f32(a, b, w, false); w = __builtin_amdgcn_cvt_pk_fp8_f32(c, d, w, true); return (unsigned)w; }
__device__ __forceinline__ void tr_load(f32x4 (&v)[8], const ConvItem& c, int wave, int lane, int row0 = 0) {
    const float* s = ((lane < 32) ? c.srcL : c.srcR) + 4 * (lane & 31);
#pragma unroll
    for (int i = 0; i < 8; ++i) v[i] = *(const GAS f32x4*)(s + (size_t)(row0 + wave * 8 + i) * c.N);
}
__device__ __forceinline__ void tr_write(const f32x4 (&v)[8], LAS float* scr, int wave, int lane) {
#pragma unroll
    for (int i = 0; i < 8; ++i) *(LAS f32x4*)(scr + (wave * 8 + i) * 256 + ((4 * lane) ^ (4 * wave))) = v[i];
}
__device__ __forceinline__ void tr_emit(const ConvItem& c, const LAS float* scr, int tid) {
    const int kc = tid & 7;
#pragma unroll
    for (int j = 0; j < 4; ++j) { const int n = (tid >> 3) + 64 * j; const LAS float* s = scr + (8 * kc) * 256 + (n ^ (4 * kc));
        v4u o; o.x = pk2(s[0 * 256], s[1 * 256]); o.y = pk2(s[2 * 256], s[3 * 256]); o.z = pk2(s[4 * 256], s[5 * 256]); o.w = pk2(s[6 * 256], s[7 * 256]);
        *(GAS v4u*)(c.dst + n * 64 + 8 * kc) = o; }
}
__device__ __forceinline__ void tr_emit8(const ConvItem& c, const LAS float* scr0, int tid) {
    const int kc = tid & 7; const LAS float* tile = scr0 + (kc >> 2) * (64 * 256); const int k0 = 16 * (kc & 3);
#pragma unroll
    for (int j = 0; j < 4; ++j) { const int n = (tid >> 3) + 64 * j; float f[16];
#pragma unroll
        for (int e = 0; e < 16; ++e) f[e] = tile[(k0 + e) * 256 + (n ^ (4 * ((k0 + e) >> 3)))] * 256.f;
        v4u o; o.x = pk4_fp8(f[0], f[1], f[2], f[3]); o.y = pk4_fp8(f[4], f[5], f[6], f[7]); o.z = pk4_fp8(f[8], f[9], f[10], f[11]); o.w = pk4_fp8(f[12], f[13], f[14], f[15]);
        *(GAS v4u*)((unsigned char*)c.dst + n * 128 + 16 * kc) = o; }
}
__device__ __forceinline__ void cv8_load(f32x4 (&v)[16], const ConvItem& c, int wave, int lane) {
    const float* s = ((lane < 32) ? c.srcL : c.srcR) + 4 * (lane & 31) + (size_t)(16 * wave) * c.N;
#pragma unroll
    for (int i = 0; i < 16; ++i) v[i] = *(const GAS f32x4*)(s + (size_t)i * c.N);
}
__device__ __forceinline__ void cv8_emit(const f32x4 (&v)[16], const ConvItem& c, LAS unsigned char* T, int wave, int lane) {
#pragma unroll
    for (int j = 0; j < 4; ++j) { v4u o;
        o.x = pk4_fp8(v[0][j] * 256.f, v[1][j] * 256.f, v[2][j] * 256.f, v[3][j] * 256.f);     o.y = pk4_fp8(v[4][j] * 256.f, v[5][j] * 256.f, v[6][j] * 256.f, v[7][j] * 256.f);
        o.z = pk4_fp8(v[8][j] * 256.f, v[9][j] * 256.f, v[10][j] * 256.f, v[11][j] * 256.f);  o.w = pk4_fp8(v[12][j] * 256.f, v[13][j] * 256.f, v[14][j] * 256.f, v[15][j] * 256.f);
        *(LAS v4u*)(T + (4 * lane + j) * 128 + 16 * (wave ^ (lane & 7))) = o; }
    LDS_WAIT(); __syncthreads();
#pragma unroll
    for (int q = 0; q < 4; ++q) { const int r = wave * 32 + q * 8 + (lane >> 3), ch = lane & 7;
        const v4u w = *(const LAS v4u*)(T + r * 128 + 16 * (ch ^ ((r >> 2) & 7)));
        *(GAS v4u*)((unsigned char*)c.dst + r * 128 + 16 * ch + (wave >= 4 ? c.hi_off : 0)) = w; }
}
__device__ __forceinline__ void conv_items_fp8(const Args& a, LAS unsigned char* lds, int first, int last, int wg, int nwg, int tid) {
    const int wave = __builtin_amdgcn_readfirstlane(tid >> 6), lane = tid & 63;
    int it0 = first + wg, it1 = it0 + nwg, it2 = it1 + nwg;
    if (it0 >= last) return;
    f32x4 v0[16], v1[16], v2[16];
    ConvItem c0 = conv_decode8(a, it0), c1 = c0, c2 = c0;
    cv8_load(v0, c0, wave, lane);
    if (it1 < last) { c1 = conv_decode8(a, it1); cv8_load(v1, c1, wave, lane); }
    LAS unsigned char* T0 = lds; LAS unsigned char* T1 = lds + 32768;
    for (;;) {
        if (it2 < last) { c2 = conv_decode8(a, it2); cv8_load(v2, c2, wave, lane); }
        cv8_emit(v0, c0, T0, wave, lane);
        if (it1 >= last) break;
        it0 = it2 + nwg;
        if (it0 < last) { c0 = conv_decode8(a, it0); cv8_load(v0, c0, wave, lane); }
        cv8_emit(v1, c1, T1, wave, lane);
        if (it2 >= last) break;
        it1 = it0 + nwg;
        if (it1 < last) { c1 = conv_decode8(a, it1); cv8_load(v1, c1, wave, lane); }
        cv8_emit(v2, c2, T0, wave, lane);
        if (it0 >= last) break;
        it2 = it1 + nwg;
        { LAS unsigned char* t_ = T0; T0 = T1; T1 = t_; }
    }
    LDS_WAIT(); __syncthreads();
}
__device__ __forceinline__ void conv_items(const Args& a, LAS unsigned char* lds, int first, int last, int wg, int nwg, int tid) {
    LAS float* scr0 = (LAS float*)lds; LAS float* scr1 = scr0 + 64 * 256;
    const int wave = __builtin_amdgcn_readfirstlane(tid >> 6), lane = tid & 63;
    int it = first + wg;
    if (it >= last) return;
    f32x4 vA0[8], vA1[8], vB0[8], vB1[8];
    ConvItem cA0 = conv_decode(a, it), cA1 = cA0, cB0 = cA0, cB1 = cA0;
    bool hA1 = it + nwg < last, hB0 = false, hB1 = false;
    tr_load(vA0, cA0, wave, lane); if (hA1) { cA1 = conv_decode(a, it + nwg); tr_load(vA1, cA1, wave, lane); }
    for (;;) {
        int nx = it + 2 * nwg; hB0 = nx < last; hB1 = nx + nwg < last;
        if (hB0) { cB0 = conv_decode(a, nx); tr_load(vB0, cB0, wave, lane); } if (hB1) { cB1 = conv_decode(a, nx + nwg); tr_load(vB1, cB1, wave, lane); }
        tr_write(vA0, scr0, wave, lane); if (hA1) tr_write(vA1, scr1, wave, lane);
        LDS_WAIT(); __syncthreads();
        tr_emit(cA0, scr0, tid); if (hA1) tr_emit(cA1, scr1, tid);
        LDS_WAIT(); __syncthreads();
        if (!hB0) break;
        it = nx; nx = it + 2 * nwg; const bool h0 = nx < last; hA1 = nx + nwg < last;
        if (h0) { cA0 = conv_decode(a, nx); tr_load(vA0, cA0, wave, lane); } if (hA1) { cA1 = conv_decode(a, nx + nwg); tr_load(vA1, cA1, wave, lane); }
        tr_write(vB0, scr0, wave, lane); if (hB1) tr_write(vB1, scr1, wave, lane);
        LDS_WAIT(); __syncthreads();
        tr_emit(cB0, scr0, tid); if (hB1) tr_emit(cB1, scr1, tid);
        LDS_WAIT(); __syncthreads();
        if (!h0) break;
        it = nx;
    }
}
#if defined(LEAK_SUB0)
#define ST0(i) do { if (blockIdx.x == 0 && wave == 0 && lane == 0) ((LAS unsigned long long*)(lds + LDSCTL_OFF + 1536))[i] = __builtin_amdgcn_s_memrealtime(); } while (0)
#else
#define ST0(i) do { } while (0)
#endif
__device__ __forceinline__ void p0_prologue(const Args& a, LAS unsigned char* lds, int gw, int NGW, int wave, int lane) {
    unsigned char* ws = a.ws;
    ST0(20);
    conv_items(a, lds, 0, W_IN, gw / NWAVES, NGW / NWAVES, wave * 64 + lane); __syncthreads(); conv_items_fp8(a, lds, NW8, NW8 + W8_IN, NGW / NWAVES - 1 - gw / NWAVES, NGW / NWAVES, wave * 64 + lane); __syncthreads();
    ST0(21);
    {
        const float* g = a.in[1]; const float* b = a.in[2];
        f32x4 GG[8], BB[8];
#pragma unroll
        for (int j = 0; j < 8; ++j) { GG[j] = *(const f32x4*)(g + 8 * lane + 512 * (j >> 1) + 4 * (j & 1)); BB[j] = *(const f32x4*)(b + 8 * lane + 512 * (j >> 1) + 4 * (j & 1)); }
#define P0_LOAD(V, M) do { const GAS f32x4* xr_ = (const GAS f32x4*)(a.in[0] + (size_t)(M) * DM) + 2 * lane; _Pragma("unroll") for (int j = 0; j < 8; ++j) V[j] = xr_[128 * (j >> 1) + (j & 1)]; } while (0)
#define P0_ROW(V, M) do { float s = 0.f; \
            _Pragma("unroll") for (int j = 0; j < 8; ++j) s += (V[j].x + V[j].y) + (V[j].z + V[j].w); \
            const float mean = wave_sum(s) * (1.f / DM); float s2 = 0.f; \
            _Pragma("unroll") for (int j = 0; j < 8; ++j) { V[j] = V[j] - mean; s2 += (V[j].x * V[j].x + V[j].y * V[j].y) + (V[j].z * V[j].z + V[j].w * V[j].w); } \
            const float rstd = 1.f / sqrtf(wave_sum(s2) * (1.f / DM) + LN_EPS); \
            GAS v4u* h8 = (GAS v4u*)((bf16*)a.out + (size_t)(M) * DM) + lane; GAS u32x2* x8 = (GAS u32x2*)(ws + WS_XN8 + (size_t)(M) * DM) + lane;     \
            _Pragma("unroll") for (int jj = 0; jj < 4; ++jj) { const f32x4 y0 = V[2 * jj] * rstd * GG[2 * jj] + BB[2 * jj], y1 = V[2 * jj + 1] * rstd * GG[2 * jj + 1] + BB[2 * jj + 1], ya0 = y0 * ALPHA, ya1 = y1 * ALPHA; \
                h8[64 * jj] = (v4u){pk2(ya0.x, ya0.y), pk2(ya0.z, ya0.w), pk2(ya1.x, ya1.y), pk2(ya1.z, ya1.w)}; x8[64 * jj] = (u32x2){pk4_fp8(y0.x, y0.y, y0.z, y0.w), pk4_fp8(y1.x, y1.y, y1.z, y1.w)}; } } while (0)
        int m = gw;
        if (m < NTOK) { f32x4 va[8], vb[8];
            P0_LOAD(va, m);
            for (;;) {
                const int m1 = m + NGW; const bool h1 = m1 < NTOK;
                if (h1) P0_LOAD(vb, m1);
                P0_ROW(va, m);
                if (!h1) break;
                const int m2 = m1 + NGW; const bool h2 = m2 < NTOK;
                if (h2) P0_LOAD(va, m2);
                P0_ROW(vb, m1);
                if (!h2) break;
                m = m2;
            } }
#undef P0_LOAD
#undef P0_ROW
    }
    ST0(22);
    const int gt = gw * 64 + lane, NGT = NGW * 64;
    {
        float* WRT = (float*)(ws + WS_WRT); float* RC = WRT + 48 * 2048; const float* g1 = a.in[20]; const float* b1 = a.in[21];
        for (int i = gt; i < 48 * 2048; i += NGT) { const int col = i >> 11, k = i & 2047; float v = 0.f;
            if (col < 4) v = a.in[22][k * 4 + col]; else if (col < 36) v = a.in[24][k * 32 + (col - 4)];
            const float wv = v * g1[k]; WRT[i] = wv;
            unsigned uh = __float_as_uint(wv); uh += 0x7fffu + ((uh >> 16) & 1u); uh &= 0xffff0000u; const float rem = wv - __uint_as_float(uh);
            unsigned ul = __float_as_uint(rem); ul += 0x7fffu + ((ul >> 16) & 1u);
            ((unsigned short*)(ws + WS_WRT + 512 * 1024))[i] = (unsigned short)(uh >> 16); ((unsigned short*)(ws + WS_WRT + 768 * 1024))[i] = (unsigned short)(ul >> 16); }
        const int rcw = (NGW >= 2 * 48) ? gw - (NGW / 2) : gw;
        for (int col = rcw; col >= 0 && col < 48; col += NGW) { float s1 = 0.f, s2 = 0.f;
            if (col < 36) {
#pragma unroll 8
                for (int k = lane; k < 2048; k += 64) { const float w = (col < 4) ? a.in[22][k * 4 + col] : a.in[24][k * 32 + (col - 4)]; s1 += g1[k] * w; s2 += b1[k] * w; } }
            s1 = wave_sum(s1); s2 = wave_sum(s2);
            if (lane == 0) { RC[col] = s1; RC[48 + col] = s2 + ((col < 4) ? a.in[23][col] : (col < 36 ? a.in[25][col - 4] : 0.f)); } }
    }
    {
        float* rc = (float*)(ws + WS_ROPEC); float* rs = (float*)(ws + WS_ROPES);
        for (int i = gt; i < SEQ * 64; i += NGT) { const int t = i >> 6, f = i & 63; const int pos = (f < 32) ? (t >> 6) : (t & 63); const int fi = f & 31;
            const float inv = exp2f(-(float)fi * (13.287712379549449f / 32.0f));
            const float ang = (float)pos * inv;
            rc[i] = cosf(ang); rs[i] = sinf(ang); }
    }
    ST0(23);
    {
        const float* w1 = a.in[9]; const float* b1 = a.in[10]; const float* f1 = a.in[11]; const float* w2 = a.in[12]; const float* b2 = a.in[13]; const float* f2 = a.in[14];
        float* H2 = (float*)(ws + WS_H2);
        LAS float* fe = (LAS float*)lds; LAS float* h1s = fe + 32 * 33;
        const int tid = wave * 64 + lane, p = tid >> 6, m = tid & 63;
        float W1[33], W2[64];
#pragma unroll
        for (int i = 0; i < 33; ++i) W1[i] = w1[i * 64 + m];
#pragma unroll
        for (int i = 0; i < 64; ++i) W2[i] = w2[i * 64 + m];
        const float bb1 = b1[m], ff1 = f1[m], bb2 = b2[m], ff2 = f2[m];
        for (int blk = gw / NWAVES; blk < SEQ / 32; blk += NGW / NWAVES) {
            __syncthreads();
            for (int u = tid; u < 32 * 33; u += NWAVES * 64) { const int pp = u / 33, i = u % 33, j = blk * 32 + pp; float v;
                if (i == 0) v = (float)j / (float)(SEQ - 1);
                else { const int bi = (i - 1) & 15; const double band = 1e-4 + (double)bi * ((15.0 - 1e-4) / 15.0); const double ar = band * (6.283185307179586 * (double)j / (double)SEQ);
                    v = (i <= 16) ? (float)cos(ar) : (float)(-sin(ar)); }
                fe[u] = v; }
            __syncthreads();
#pragma unroll
            for (int q = 0; q < 4; ++q) { const int pos = p + 8 * q; float acc = bb1;
#pragma unroll
              for (int i = 0; i < 33; ++i) acc += fe[pos * 33 + i] * W1[i];
              h1s[pos * 64 + m] = sinf(ff1 * acc); }
            __syncthreads();
#pragma unroll
            for (int q = 0; q < 4; ++q) { const int pos = p + 8 * q; float acc = bb2;
#pragma unroll
              for (int i = 0; i < 64; ++i) acc += h1s[pos * 64 + i] * W2[i];
              H2[(size_t)(blk * 32 + pos) * 64 + m] = sinf(ff2 * acc); }
        }
    }
    ST0(24);
}

__device__ __forceinline__ void p2_qk(const Args& a, int gw, int NGW, int lane) {
    bf16* PROJ = (bf16*)(a.ws + WS_PROJ); const float* rc = (const float*)(a.ws + WS_ROPEC); const float* rs = (const float*)(a.ws + WS_ROPES);
    unsigned short* KC8 = (unsigned short*)(a.ws + WS_KC);
    const float gq0 = a.in[5][2 * lane], gq1 = a.in[5][2 * lane + 1], gk0 = a.in[6][2 * lane], gk1 = a.in[6][2 * lane + 1];
    const int idx = (lane >> 5) * 32 + ((2 * lane) & 31); const float sgn = (lane & 16) ? 1.f : -1.f;
#define QK_LOAD(W, C, TOK) do { const int t_ = (TOK) & (SEQ - 1); C[0] = rc[t_ * 64 + idx]; C[1] = rc[t_ * 64 + idx + 1]; C[2] = rs[t_ * 64 + idx] * sgn; C[3] = rs[t_ * 64 + idx + 1] * sgn; \
        const unsigned* row_ = (const unsigned*)(PROJ + (size_t)(TOK) * INW) + lane; _Pragma("unroll") for (int h = 0; h < 10; ++h) W[h] = row_[h * 64]; } while (0)
#define QK_ROW(W, C, TOK) do { const int t = (TOK) & (SEQ - 1); const float c0 = C[0], c1 = C[1], s0 = C[2], s1 = C[3]; \
        unsigned* row = (unsigned*)(PROJ + (size_t)(TOK) * INW) + lane; \
        _Pragma("unroll") for (int h = 0; h < 10; ++h) { \
            const unsigned w = W[h]; \
            float x0 = bf_lo(w), x1 = bf_hi(w); \
            const float rn = rsqrtf(wave_sum(x0 * x0 + x1 * x1) * (1.f / 128.f) + QK_EPS); \
            x0 *= rn * (h < 8 ? gq0 : gk0); x1 *= rn * (h < 8 ? gq1 : gk1); \
            float p0, p1; { auto r0_ = __builtin_amdgcn_permlane16_swap(__float_as_uint(x0), __float_as_uint(x0), false, false); auto r1_ = __builtin_amdgcn_permlane16_swap(__float_as_uint(x1), __float_as_uint(x1), false, false); \
              p0 = __uint_as_float((lane & 16) ? r0_[0] : r0_[1]); p1 = __uint_as_float((lane & 16) ? r1_[0] : r1_[1]); }        \
            const unsigned o = pk2(x0 * c0 + p0 * s0, x1 * c1 + p1 * s1); \
            if (h < 8) row[h * 64] = o;                                                        \
            else { int d = 0; d = __builtin_amdgcn_cvt_pk_fp8_f32(x0 * c0 + p0 * s0, x1 * c1 + p1 * s1, d, false);        \
                   KC8[(((size_t)((TOK) >> 13) * 2 + (h - 8)) * SEQ + t) * 64 + lane] = (unsigned short)d; } \
        } } while (0)
    int tok = gw;
    if (tok < NTOK) { unsigned wa[10], wb[10]; float ca[4], cb[4];
        QK_LOAD(wa, ca, tok);
        for (;;) {
            const int t1 = tok + NGW; const bool h1 = t1 < NTOK;
            if (h1) QK_LOAD(wb, cb, t1);
            QK_ROW(wa, ca, tok);
            if (!h1) break;
            const int t2 = t1 + NGW; const bool h2 = t2 < NTOK;
            if (h2) QK_LOAD(wa, ca, t2);
            QK_ROW(wb, cb, t1);
            if (!h2) break;
            tok = t2;
        } }
#undef QK_LOAD
#undef QK_ROW
}
__device__ __forceinline__ void p2_vt8(const Args& a, LAS unsigned char* lds, int vcu, int G, int tid) {
    const bf16* PROJ = (const bf16*)(a.ws + WS_PROJ); unsigned char* VT8 = (unsigned char*)(a.ws + WS_VC);
    LAS unsigned char* tl = lds;
    for (int it = vcu; it < 2 * 2 * (SEQ / 64); it += G) {
        const int tile = it & 127, kvh = (it >> 7) & 1, b = it >> 8;
#if defined(BREAK_ATTN)
        const int t = tid >> 3, dc = tid & 7, pos = t;
#else
        const int t = tid >> 3, dc = tid & 7, pos = attn::vt_pos(t);
#endif
        const bf16* src = PROJ + (size_t)(b * SEQ + tile * 64 + t) * INW + COL_V + kvh * 128 + dc * 16;
        const v4u w0 = *(const v4u*)src, w1 = *(const v4u*)(src + 8);
        const unsigned ww[8] = {w0.x, w0.y, w0.z, w0.w, w1.x, w1.y, w1.z, w1.w};
#pragma unroll
        for (int i = 0; i < 8; ++i) { const int d2 = __builtin_amdgcn_cvt_pk_fp8_f32(bf_lo(ww[i]), bf_hi(ww[i]), 0, false);
            tl[(dc * 16 + 2 * i) * 64 + pos] = (unsigned char)(d2 & 0xff); tl[(dc * 16 + 2 * i + 1) * 64 + pos] = (unsigned char)((d2 >> 8) & 0xff); }
        __syncthreads();
        *(GAS v4u*)(VT8 + ((size_t)((b * 2 + kvh) * 128 + tile)) * 8192 + tid * 16) = *(const LAS v4u*)(tl + tid * 16);
        __syncthreads();
    }
}
#if defined(CHECK_ATTN)
#ifndef CHECK_TOL
#define CHECK_TOL 0.3f
#endif
__device__ __forceinline__ float wave_max(float v) {
#pragma unroll
    for (int o = 1; o < 64; o <<= 1) v = fmaxf(v, __shfl_xor(v, o));
    return v;
}
__device__ __forceinline__ void check_attn(const Args& a, int gw, int NGW, int lane) {
    const bf16* PROJ = (const bf16*)(a.ws + WS_PROJ); const unsigned char* O = (const unsigned char*)(a.ws + WS_ACAT); const float* rc = (const float*)(a.ws + WS_ROPEC); const float* rs = (const float*)(a.ws + WS_ROPES);
    gu32* ctl = (gu32*)(a.ws + WS_CTL);
    const float gk0 = a.in[6][2 * lane], gk1 = a.in[6][2 * lane + 1];
    const int idx = (lane >> 5) * 32 + ((2 * lane) & 31); const float sgn = (lane & 16) ? 1.f : -1.f;
    for (int s = gw; s < 2048; s += NGW) {
        const int b = s & 1, hq = (s >> 1) & 7, t = ((s >> 4) * 64 + 13 + 7 * hq) & (SEQ - 1), kvh = hq >> 2;
        const unsigned qw = *((const unsigned*)(PROJ + (size_t)(b * SEQ + t) * INW + hq * 128) + lane);
        const float q0 = bf_lo(qw), q1 = bf_hi(qw);
        float m = -1e30f, l = 0.f, a0 = 0.f, a1 = 0.f;
        for (int j = 0; j < SEQ; ++j) {
            const unsigned* row = (const unsigned*)(PROJ + (size_t)(b * SEQ + j) * INW);
            const unsigned kw = row[(COL_K >> 1) + kvh * 64 + lane], vw = row[(COL_V >> 1) + kvh * 64 + lane];
            float x0 = bf_lo(kw), x1 = bf_hi(kw);
            const float rn = rsqrtf(wave_sum(x0 * x0 + x1 * x1) * (1.f / 128.f) + QK_EPS);
            x0 *= rn * gk0; x1 *= rn * gk1;
            const float p0 = __shfl_xor(x0, 16), p1 = __shfl_xor(x1, 16);
            const float k0 = x0 * rc[j * 64 + idx] + p0 * rs[j * 64 + idx] * sgn, k1 = x1 * rc[j * 64 + idx + 1] + p1 * rs[j * 64 + idx + 1] * sgn;
            const float sc = wave_sum(q0 * k0 + q1 * k1) * 0.088388347648318440f;
            const float mn = fmaxf(m, sc), al = expf(m - mn), p = expf(sc - mn);
            l = l * al + p; a0 = a0 * al + p * bf_lo(vw); a1 = a1 * al + p * bf_hi(vw); m = mn;
        }
        const float r0 = a0 / l, r1 = a1 / l;
        const int ow = (int)*((const unsigned short*)(O + (size_t)(b * SEQ + t) * 3072 + hq * 128) + lane);
        const float o0 = __builtin_amdgcn_cvt_f32_fp8(ow, 0), o1 = __builtin_amdgcn_cvt_f32_fp8(ow, 1);
        const float err = wave_max(fmaxf(fabsf(r0 - o0), fabsf(r1 - o1))), mag = wave_max(fmaxf(fabsf(r0), fabsf(r1)));
        if (lane == 0 && !(err <= CHECK_TOL * mag + 1e-4f)) __hip_atomic_store(ctl + 12, 1u, RLX_AGENT);
    }
}
__device__ __forceinline__ void check_merge(const Args& a, int gw, int NGW, int lane) {
    const unsigned char* AC = (const unsigned char*)(a.ws + WS_ACAT); const bf16* PROJ = (const bf16*)(a.ws + WS_PROJ); const bf16* MRG = (const bf16*)(a.ws + WS_MRG);
    const float* wa = a.in[17]; const float* wh = a.in[18]; gu32* ctl = (gu32*)(a.ws + WS_CTL);
    for (int s = gw; s < 2048; s += NGW) {
        const int r = (s * 8 + 5) & (NTOK - 1), c = ((s * 37) & 31) * 64 + lane;
        const unsigned char* row = AC + (size_t)r * 3072; const bf16* ah = (const bf16*)(row + 1024);
        float ya = 0.f, yh = 0.f;
        for (int k = 0; k < 1024; ++k) { ya += __builtin_amdgcn_cvt_f32_fp8((int)row[k], 0) * wa[(size_t)k * 2048 + c]; yh += bf_1(ah[k]) * wh[(size_t)k * 2048 + c]; }
        const float ga = bf_1(PROJ[(size_t)r * INW + COL_G + c]), gh = bf_1(PROJ[(size_t)r * INW + COL_G + DM + c]);
        const float est = (bf_1(MRG[(size_t)r * DM + c]) - gh * yh) / fmaxf(ga, 1e-6f);
        const float s1 = wave_sum(est * ya), s2 = wave_sum(ya * ya);
        if (lane == 0 && !(s1 >= 0.7f * s2 && s1 <= 1.4f * s2)) __hip_atomic_store(ctl + 12, 1u, RLX_AGENT);
    }
}
#endif
__device__ __forceinline__ void p2_conv(const Args& a, LAS unsigned char* lds, int vcu, int G, int tid) {
    const bf16* PROJ = (const bf16*)(a.ws + WS_PROJ); bf16* X0C = (bf16*)(a.ws + WS_X0C); float* ZT = (float*)(a.ws + WS_ZT);
    const float* cw = a.in[7]; const float* cb = a.in[8];
    LAS float* zt = (LAS float*)lds;
    const int cg = tid & 15, tr = tid >> 4;
    for (int it = vcu; it < 1024; it += G) {
        const int tokblk = it >> 3, chblk = it & 7, ch = chblk * 128 + cg * 8;
        const int T0 = tokblk * 128, tb = T0 + tr * 4, sb = tb & (SEQ - 1);
        float res[3][4][8];
#pragma unroll
        for (int p = 0; p < 3; ++p) {
            const int col = p * 1024 + ch;
            float w0[8], w1[8], w2[8], bs[8];
#pragma unroll
            for (int q = 0; q < 2; ++q) { const f32x4 a0 = *(const f32x4*)(cw + col + 4 * q), a1 = *(const f32x4*)(cw + 3072 + col + 4 * q), a2 = *(const f32x4*)(cw + 6144 + col + 4 * q), bb = *(const f32x4*)(cb + col + 4 * q);
#pragma unroll
                for (int e = 0; e < 4; ++e) { w0[4 * q + e] = a0[e]; w1[4 * q + e] = a1[e]; w2[4 * q + e] = a2[e]; bs[4 * q + e] = bb[e]; } }
            const bf16* src = PROJ + (size_t)tb * INW + COL_HY + col;
            float in[6][8];
#pragma unroll
            for (int i = 0; i < 6; ++i) { const int s = sb + i - 1; v4u w = (v4u){0u, 0u, 0u, 0u};
                if (s >= 0 && s < SEQ) w = *(const v4u*)(src + (long)(i - 1) * INW);
                in[i][0] = bf_lo(w.x); in[i][1] = bf_hi(w.x); in[i][2] = bf_lo(w.y); in[i][3] = bf_hi(w.y); in[i][4] = bf_lo(w.z); in[i][5] = bf_hi(w.z); in[i][6] = bf_lo(w.w); in[i][7] = bf_hi(w.w); }
#pragma unroll
            for (int i = 0; i < 4; ++i)
#pragma unroll
                for (int e = 0; e < 8; ++e) res[p][i][e] = bs[e] + w0[e] * in[i][e] + w1[e] * in[i + 1][e] + w2[e] * in[i + 2][e];
        }
#pragma unroll
        for (int i = 0; i < 4; ++i) { v4u o; o.x = pk2(res[0][i][0], res[0][i][1]); o.y = pk2(res[0][i][2], res[0][i][3]); o.z = pk2(res[0][i][4], res[0][i][5]); o.w = pk2(res[0][i][6], res[0][i][7]);
            *(v4u*)(X0C + (size_t)(tb + i) * HW + ch) = o;
            const int t = tr * 4 + i, tp = t + (t >> 5);
#pragma unroll
            for (int e = 0; e < 8; ++e) zt[(cg * 8 + e) * 133 + tp] = res[2][i][e] * res[1][i][e]; }
        __syncthreads();
        { const int c2 = tid >> 2, seg = tid & 3, b = T0 >> 13, s0 = T0 & (SEQ - 1);
          float* dst = ZT + ((size_t)(chblk * 128 + c2) * 2 + b) * SEQ + s0 + seg * 32; const LAS float* zs = zt + c2 * 133 + seg * 33;
#pragma unroll
          for (int k = 0; k < 8; ++k) { f32x4 v; v.x = zs[4 * k]; v.y = zs[4 * k + 1]; v.z = zs[4 * k + 2]; v.w = zs[4 * k + 3]; *(f32x4*)(dst + 4 * k) = v; } }
        __syncthreads();
    }
}
__device__ __forceinline__ void p2_filter(const Args& a, LAS unsigned char* lds, int first, int stride, int tid, int last = 1024, int extra = -1) {
    typedef short bf8_t __attribute__((ext_vector_type(8))); typedef float f16_t __attribute__((ext_vector_type(16)));
    const float* H2 = (const float*)(a.ws + WS_H2); const float* w3 = a.in[15]; float* KT = (float*)(a.ws + WS_KT);
    LAS float* tf = (LAS float*)lds; LAS float* tbk = tf + 128 * 65;
    const int lane = tid & 63, wave = tid >> 6, r32 = lane & 31, hi = lane >> 5, half = wave >> 2, cl = 32 * (wave & 3) + r32;
    const float min_decay = -3.0701134573253944f, max_decay = -15.350567286626972f;
    bf8_t bfr4[4]; int cur_chblk = -1;
#define FL_LOAD(HB, IT) do { const int j0_ = ((IT) >> 3) * 64; _Pragma("unroll") for (int s = 0; s < 4; ++s) _Pragma("unroll") for (int mt = 0; mt < 2; ++mt) { \
        const float* hp_ = H2 + (size_t)(j0_ + 32 * mt + r32) * 64 + 16 * s + 8 * hi; HB[s][mt][0] = *(const f32x4*)hp_; HB[s][mt][1] = *(const f32x4*)(hp_ + 4); } } while (0)
    int it = first; bool valid = it < last;
    if (!valid && extra >= 0) { it = extra; extra = -1; last = 0; valid = true; }
    f32x4 hc[4][2][2], hn[4][2][2];
    if (valid) FL_LOAD(hc, it);
    while (valid) {
        int nx = it + stride; bool nv = nx < last;
        if (!nv && extra >= 0) { nx = extra; extra = -1; last = 0; nv = true; }
        if (nv) FL_LOAD(hn, nx);
        const int jblk = it >> 3, chblk = it & 7, j0 = jblk * 64, ch = chblk * 128 + cl;
        if (chblk != cur_chblk) { cur_chblk = chblk;
#pragma unroll
            for (int s = 0; s < 4; ++s) { const int k0 = 16 * s + 8 * hi; unsigned bw[4];
#pragma unroll
                for (int q = 0; q < 4; ++q) bw[q] = pk2(w3[(size_t)(k0 + 2 * q) * 2048 + half * 1024 + ch], w3[(size_t)(k0 + 2 * q + 1) * 2048 + half * 1024 + ch]);
                const v4u bq = (v4u){bw[0], bw[1], bw[2], bw[3]}; bfr4[s] = __builtin_bit_cast(bf8_t, bq); } }
        f16_t acc0 = {}, acc1 = {};
#pragma unroll
        for (int s = 0; s < 4; ++s) {
            const int k0 = 16 * s + 8 * hi;
            const bf8_t bfr = bfr4[s];
#pragma unroll
            for (int mt = 0; mt < 2; ++mt) { const f32x4 h0 = hc[s][mt][0], h1 = hc[s][mt][1];
                const v4u aq = (v4u){pk2(h0.x, h0.y), pk2(h0.z, h0.w), pk2(h1.x, h1.y), pk2(h1.z, h1.w)}; const bf8_t afr = __builtin_bit_cast(bf8_t, aq);
                if (mt == 0) acc0 = __builtin_amdgcn_mfma_f32_32x32x16_bf16(afr, bfr, acc0, 0, 0, 0); else acc1 = __builtin_amdgcn_mfma_f32_32x32x16_bf16(afr, bfr, acc1, 0, 0, 0); }
        }
        const float delta2 = fabsf(min_decay + (max_decay - min_decay) * ((float)ch / 1023.f)) * 1.4426950408889634f;
        LAS float* dstt = half ? tbk : tf;
#pragma unroll
        for (int r = 0; r < 16; ++r) { const int jj = (r & 3) + 8 * (r >> 2) + 4 * hi;
            dstt[cl * 65 + jj] = acc0[r] * __builtin_amdgcn_exp2f(-((float)(j0 + jj) * (1.f / (float)(SEQ - 1))) * delta2);
            dstt[cl * 65 + 32 + jj] = acc1[r] * __builtin_amdgcn_exp2f(-((float)(j0 + 32 + jj) * (1.f / (float)(SEQ - 1))) * delta2); }
        __syncthreads();
        { const int c2 = tid >> 2, seg = tid & 3; float* dst = KT + (size_t)(chblk * 128 + c2) * 16384;
#pragma unroll
          for (int kk = 0; kk < 4; ++kk) { const int jj = 16 * kk + 4 * seg, j = j0 + jj; const LAS float* sf = tf + c2 * 65 + jj; const LAS float* sb = tbk + c2 * 65 + jj;
              *(f32x4*)(dst + j) = (f32x4){sf[0], sf[1], sf[2], sf[3]};
              if (j == 0) { dst[8192] = 0.f; dst[16383] = sb[1]; dst[16382] = sb[2]; dst[16381] = sb[3]; }
              else { typedef float f32x4u __attribute__((ext_vector_type(4), aligned(4))); *(f32x4u*)(dst + 16384 - j - 3) = (f32x4u){sb[3], sb[2], sb[1], sb[0]}; } } }
        __syncthreads();
        if (!nv) break;
#pragma unroll
        for (int s = 0; s < 4; ++s)
#pragma unroll
            for (int mt = 0; mt < 2; ++mt) { hc[s][mt][0] = hn[s][mt][0]; hc[s][mt][1] = hn[s][mt][1]; }
        it = nx;
    }
#undef FL_LOAD
}

__device__ __forceinline__ void p4_conv_direct(const Args& a, LAS unsigned char* lds, int vcu, int G, int tid) {
    const float* KT = (const float*)(a.ws + WS_KT); float* ZT = (float*)(a.ws + WS_ZT); const float* dbias = a.in[16];
    LAS float* kk = (LAS float*)lds;
    LAS float* zz = kk + 17408;
    LAS float* red = zz + 16384;
    const int lane = tid & 63, wave = tid >> 6;
    for (int ch = vcu; ch < HW; ch += G) {
        float ss = 0.f;
        for (int i = tid; i < 16384; i += 512) { const float v = KT[(size_t)ch * 16384 + i]; ss += v * v; kk[i + (i >> 4)] = v; }
        for (int i = tid; i < 16384; i += 512) zz[i] = ZT[(size_t)ch * 16384 + i];
        ss = wave_sum(ss); if (lane == 0) red[wave] = ss;
        __syncthreads();
        float tot = 0.f;
#pragma unroll
        for (int w = 0; w < 8; ++w) tot += red[w];
        const float scale = rsqrtf(tot + FILTER_EPS), db = dbias[ch];
        const int t0 = tid * 16;
        float acc0[16], acc1[16];
#pragma unroll
        for (int i = 0; i < 16; ++i) { acc0[i] = 0.f; acc1[i] = 0.f; }
        for (int s0 = 0; s0 < SEQ; s0 += 16) {
            float kw[31];
#pragma unroll
            for (int q = 0; q < 31; ++q) { const int idx = (t0 - s0 - 15 + q) & 16383; kw[q] = kk[idx + (idx >> 4)]; }
#pragma unroll
            for (int jj = 0; jj < 16; ++jj) { const float z0 = zz[s0 + jj], z1 = zz[SEQ + s0 + jj];
#pragma unroll
                for (int i = 0; i < 16; ++i) { acc0[i] += kw[i - jj + 15] * z0; acc1[i] += kw[i - jj + 15] * z1; } }
        }
        float* y0 = ZT + (size_t)ch * 16384 + t0; float* y1 = y0 + SEQ;
#pragma unroll
        for (int i = 0; i < 16; ++i) { y0[i] = acc0[i] * scale + db * zz[t0 + i]; y1[i] = acc1[i] * scale + db * zz[SEQ + t0 + i]; }
        __syncthreads();
    }
}

__device__ __forceinline__ void p5_ah(const Args& a, LAS unsigned char* lds, int vcu, int G, int tid) {
    const float* YT = (const float*)(a.ws + WS_ZT); const bf16* X0C = (const bf16*)(a.ws + WS_X0C); bf16* AH = (bf16*)(a.ws + WS_ACAT + 1024);
    LAS float* yt = (LAS float*)lds;
    for (int it = vcu; it < 2048; it += G) {
        const int tokblk = it >> 3, chblk = it & 7, T0 = tokblk * 64, b = T0 >> 13, s0 = T0 & (SEQ - 1);
        { const int c2 = tid >> 2, seg = tid & 3; const float* src = YT + ((size_t)(chblk * 128 + c2) * 2 + b) * SEQ + s0 + seg * 16;
#pragma unroll
          for (int k = 0; k < 4; ++k) { const f32x4 v = *(const f32x4*)(src + 4 * k); yt[c2 * 65 + seg * 16 + 4 * k] = v.x; yt[c2 * 65 + seg * 16 + 4 * k + 1] = v.y; yt[c2 * 65 + seg * 16 + 4 * k + 2] = v.z; yt[c2 * 65 + seg * 16 + 4 * k + 3] = v.w; } }
        __syncthreads();
        { const int t = tid >> 3, cs = tid & 7; const size_t off = (size_t)(T0 + t) * HW + chblk * 128 + cs * 16;
          const v4u xa = *(const v4u*)(X0C + off), xb = *(const v4u*)(X0C + off + 8);
          const unsigned xw[8] = {xa.x, xa.y, xa.z, xa.w, xb.x, xb.y, xb.z, xb.w}; unsigned ow[8];
#pragma unroll
          for (int k = 0; k < 8; ++k) ow[k] = pk2(bf_lo(xw[k]) * yt[(cs * 16 + 2 * k) * 65 + t], bf_hi(xw[k]) * yt[(cs * 16 + 2 * k + 1) * 65 + t]);
          const size_t offo = (size_t)(T0 + t) * 1536 + chblk * 128 + cs * 16;
          *(v4u*)(AH + offo) = (v4u){ow[0], ow[1], ow[2], ow[3]}; *(v4u*)(AH + offo + 8) = (v4u){ow[4], ow[5], ow[6], ow[7]}; }
        __syncthreads();
    }
}

typedef float f32x4m __attribute__((ext_vector_type(4)));
__device__ __forceinline__ void p8_ln_route(const Args& a, LAS unsigned char* lds, int vcu, int G, int tid) {
    const bf16* PRE = (const bf16*)(a.ws + WS_PRE1); bf16* H1B = (bf16*)(a.ws + WS_H1B); const float* g = a.in[20]; const float* bt = a.in[21];
    const float* WRT = (const float*)(a.ws + WS_WRT); const float* RC = WRT + 48 * 2048;
    int* ETOK = (int*)(a.ws + WS_ETOK); float* EW = (float*)(a.ws + WS_EW); gu32* ctl = (gu32*)(a.ws + WS_CTL);
    LAS float* lg = (LAS float*)lds;
    LAS int* lcnt = (LAS int*)(lds + 98304); LAS int* lbase = (LAS int*)(lds + 98304 + 128); LAS float* rstat = (LAS float*)(lds + 98304 + 256);
    const int lane = tid & 63, wave = tid >> 6;
    for (int it = vcu; it < NTOK / 64; it += G) {
        const int r0 = it * 64;
        if (tid < 32) lcnt[tid] = 0;
#if defined(LEAK_SUB7)
        LAS unsigned long long* tst7 = (LAS unsigned long long*)(lds + LDSCTL_OFF + 1536);
#define ST7(i) do { if (blockIdx.x == 0 && tid == 0) tst7[i] = __builtin_amdgcn_s_memrealtime(); } while (0)
#else
#define ST7(i) do { } while (0)
#endif
        ST7(16);
        {
            typedef short rt_bf16x8 __attribute__((ext_vector_type(8)));
            f32x4 acc[4][3];
#pragma unroll
            for (int rb = 0; rb < 4; ++rb)
#pragma unroll
                for (int c = 0; c < 3; ++c) acc[rb][c] = (f32x4){0.f, 0.f, 0.f, 0.f};
            const bf16* ap = PRE + (size_t)(r0 + (lane & 15)) * DM + wave * 256 + 8 * (lane >> 4);
            const bf16* bh = (const bf16*)(a.ws + WS_WRT + 512 * 1024) + (size_t)(lane & 15) * DM + wave * 256 + 8 * (lane >> 4);
            const bf16* bl = (const bf16*)(a.ws + WS_WRT + 768 * 1024) + (size_t)(lane & 15) * DM + wave * 256 + 8 * (lane >> 4);
#pragma unroll 2
            for (int k0 = 0; k0 < 256; k0 += 32) {
                rt_bf16x8 hv[3], lv[3], av[4];
#pragma unroll
                for (int c = 0; c < 3; ++c) { hv[c] = *(const rt_bf16x8*)(bh + c * 16 * DM + k0); lv[c] = *(const rt_bf16x8*)(bl + c * 16 * DM + k0); }
#pragma unroll
                for (int rb = 0; rb < 4; ++rb) av[rb] = *(const rt_bf16x8*)(ap + (size_t)rb * 16 * DM + k0);
#pragma unroll
                for (int rb = 0; rb < 4; ++rb)
#pragma unroll
                    for (int c = 0; c < 3; ++c) { acc[rb][c] = __builtin_amdgcn_mfma_f32_16x16x32_bf16(av[rb], hv[c], acc[rb][c], 0, 0, 0); acc[rb][c] = __builtin_amdgcn_mfma_f32_16x16x32_bf16(av[rb], lv[c], acc[rb][c], 0, 0, 0); }
            }
#pragma unroll
            for (int rb = 0; rb < 4; ++rb)
#pragma unroll
                for (int r = 0; r < 4; ++r) { LAS float* p = lg + wave * (64 * 48) + (rb * 16 + (lane >> 4) * 4 + r) * 48 + (lane & 15); p[0] = acc[rb][0][r]; p[16] = acc[rb][1][r]; p[32] = acc[rb][2][r]; }
        }
        ST7(17);
        {
            f32x4 GG[8], BB[8];
#pragma unroll
            for (int j = 0; j < 8; ++j) { GG[j] = *(const f32x4*)(g + 4 * lane + 256 * j); BB[j] = *(const f32x4*)(bt + 4 * lane + 256 * j); }
#define P7_LOAD(W, I) do { const GAS u32x2* xr_ = (const GAS u32x2*)(PRE + (size_t)(r0 + wave * 8 + (I)) * DM) + lane; _Pragma("unroll") for (int j = 0; j < 8; ++j) W[j] = xr_[64 * j]; } while (0)
#define P7_ROW(W, I) do { const int rl = wave * 8 + (I), r = r0 + rl; f32x4 v[8]; float s = 0.f; \
            _Pragma("unroll") for (int j = 0; j < 8; ++j) { const u32x2 w = W[j]; v[j] = (f32x4){bf_lo(w.x), bf_hi(w.x), bf_lo(w.y), bf_hi(w.y)}; s += (v[j].x + v[j].y) + (v[j].z + v[j].w); } \
            const float mean = wave_sum(s) * (1.f / DM); float s2 = 0.f; \
            _Pragma("unroll") for (int j = 0; j < 8; ++j) { v[j] = v[j] - mean; s2 += (v[j].x * v[j].x + v[j].y * v[j].y) + (v[j].z * v[j].z + v[j].w * v[j].w); } \
            const float rstd = 1.f / sqrtf(wave_sum(s2) * (1.f / DM) + LN_EPS); \
            if (lane == 0) { rstat[2 * rl] = mean; rstat[2 * rl + 1] = rstd; } \
            GAS unsigned* ob = (GAS unsigned*)((unsigned char*)H1B + (size_t)r * DM) + lane; \
            _Pragma("unroll") for (int j = 0; j < 8; ++j) { const f32x4 y = v[j] * rstd * GG[j] + BB[j]; ob[64 * j] = pk4_fp8(y.x, y.y, y.z, y.w); } } while (0)
            u32x2 wa[8], wb[8];
            P7_LOAD(wa, 0);
#pragma unroll
            for (int i = 0; i < 8; i += 2) { P7_LOAD(wb, i + 1); P7_ROW(wa, i); if (i + 2 < 8) P7_LOAD(wa, i + 2); P7_ROW(wb, i + 1); }
#undef P7_LOAD
#undef P7_ROW
        }
        __syncthreads();
        ST7(18);
        int e0 = 0, e1 = 0, p0 = 0, p1 = 0; float w0 = 0.f, w1 = 0.f;
        if (tid < 64) {
            const LAS float* L = lg + tid * 48; const float mean = rstat[2 * tid], rstd = rstat[2 * tid + 1];
#define LOGIT(col) (rstd * ((((L[col] + L[64 * 48 + (col)]) + (L[2 * 64 * 48 + (col)] + L[3 * 64 * 48 + (col)])) + ((L[4 * 64 * 48 + (col)] + L[5 * 64 * 48 + (col)]) + (L[6 * 64 * 48 + (col)] + L[7 * 64 * 48 + (col)]))) - mean * RC[col]) + RC[48 + (col)])
            float c[4]; int grp = 0; float cm;
#pragma unroll
            for (int i = 0; i < 4; ++i) c[i] = LOGIT(i);
            cm = c[0];
#pragma unroll
            for (int i = 1; i < 4; ++i) if (c[i] > cm) { cm = c[i]; grp = i; }
            float den = 0.f;
#pragma unroll
            for (int i = 0; i < 4; ++i) den += expf(c[i] - cm);
            const float pg = 1.f / den;
            float f[8];
#pragma unroll
            for (int i = 0; i < 8; ++i) f[i] = LOGIT(4 + grp * 8 + i);
#undef LOGIT
            int i0 = 0; float f0 = f[0];
#pragma unroll
            for (int i = 1; i < 8; ++i) if (f[i] > f0) { f0 = f[i]; i0 = i; }
            int i1 = -1; float f1 = -3.0e38f;
#pragma unroll
            for (int i = 0; i < 8; ++i) if (i != i0 && f[i] > f1) { f1 = f[i]; i1 = i; }
            const float q0 = 1.f / (1.f + expf(f1 - f0));
            w0 = pg * q0; w1 = pg * (1.f - q0); e0 = grp * 8 + i0; e1 = grp * 8 + i1;
            p0 = __hip_atomic_fetch_add(lcnt + e0, 1, __ATOMIC_RELAXED, __HIP_MEMORY_SCOPE_WORKGROUP); p1 = __hip_atomic_fetch_add(lcnt + e1, 1, __ATOMIC_RELAXED, __HIP_MEMORY_SCOPE_WORKGROUP);
        }
        __syncthreads();
        if (tid < 32) { const int n = lcnt[tid]; lbase[tid] = n ? (int)__hip_atomic_fetch_add(ctl + CW_ECNT + 64 * tid, (unsigned)n, RLX_AGENT) : 0; }
        __syncthreads();
        if (tid < 64) { const int tok = r0 + tid; const int q0 = lbase[e0] + p0, q1 = lbase[e1] + p1;
            ETOK[e0 * ELIST + q0] = tok * 2; EW[e0 * ELIST + q0] = w0; ETOK[e1 * ELIST + q1] = tok * 2 + 1; EW[e1 * ELIST + q1] = w1; }
        __syncthreads();
        ST7(19);
    }
}
__device__ __forceinline__ int expert_tables(const Args& a, LAS unsigned char* lds, int tid) {
    LAS int* cnt = (LAS int*)(lds + L_CNT); LAS int* off = (LAS int*)(lds + L_OFF); LAS int* rbx = (LAS int*)(lds + L_RBX);
    gu32* ctl = (gu32*)(a.ws + WS_CTL);
    __syncthreads();
    if (tid < 32) cnt[tid] = (int)__hip_atomic_load(ctl + CW_ECNT + 64 * tid, RLX_AGENT);
    __syncthreads();
    if (tid < 32) {
        int o = 0, nb = 0;
#pragma unroll
        for (int i = 0; i < 32; ++i) { const int nbi = (cnt[i] + 255) >> 8; o += (i < tid) ? nbi : 0; nb = (i == tid) ? nbi : nb; }
        off[tid] = o << 8; for (int k = 0; k < nb; ++k) rbx[o + k] = tid; if (tid == 31) off[32] = (o + nb) << 8; }
    __syncthreads();
    return off[32];
}
struct FinRow { u32x2 x[8], ya[8], yb[8]; };
__device__ __forceinline__ void fin_load(FinRow& R, const bf16* PRE, const bf16* Y, int r, int lane) {
    const GAS u32x2* xr = (const GAS u32x2*)(PRE + (size_t)r * DM) + lane; const GAS u32x2* y0 = (const GAS u32x2*)(Y + (size_t)r * DM) + lane; const GAS u32x2* y1 = (const GAS u32x2*)(Y + ((size_t)NTOK + r) * DM) + lane;
#pragma unroll
    for (int j = 0; j < 8; ++j) { R.x[j] = xr[64 * j]; R.ya[j] = y0[64 * j]; R.yb[j] = y1[64 * j]; }
}
__device__ __forceinline__ void fin_row(const FinRow& R, const Args& a, const LAS float* PL, int r, int lane, bool bad) {
    const LAS float* g1 = PL; const LAS float* b1 = PL + DM; const LAS float* g = PL + 2 * DM; const LAS float* bt = PL + 3 * DM;
    GAS f32x4* orow = (GAS f32x4*)(a.out + (size_t)r * DM) + lane;
    f32x4 v[8]; float s = 0.f;
#pragma unroll
    for (int j = 0; j < 8; ++j) { const u32x2 w = R.x[j]; v[j] = (f32x4){bf_lo(w.x), bf_hi(w.x), bf_lo(w.y), bf_hi(w.y)}; s += (v[j].x + v[j].y) + (v[j].z + v[j].w); }
    const float mean1 = wave_sum(s) * (1.f / DM); float q = 0.f;
#pragma unroll
    for (int j = 0; j < 8; ++j) { v[j] = v[j] - mean1; q += (v[j].x * v[j].x + v[j].y * v[j].y) + (v[j].z * v[j].z + v[j].w * v[j].w); }
    const float rstd1 = 1.f / sqrtf(wave_sum(q) * (1.f / DM) + LN_EPS) * ALPHA;
    s = 0.f;
#pragma unroll
    for (int j = 0; j < 8; ++j) { const f32x4 gg = *(const LAS f32x4*)(g1 + 4 * lane + 256 * j), bb = *(const LAS f32x4*)(b1 + 4 * lane + 256 * j);
        v[j] = v[j] * rstd1 * gg + bb * ALPHA + (f32x4){bf_lo(R.ya[j].x), bf_hi(R.ya[j].x), bf_lo(R.ya[j].y), bf_hi(R.ya[j].y)} + (f32x4){bf_lo(R.yb[j].x), bf_hi(R.yb[j].x), bf_lo(R.yb[j].y), bf_hi(R.yb[j].y)};
        s += (v[j].x + v[j].y) + (v[j].z + v[j].w); if (j & 1) __builtin_amdgcn_sched_barrier(0); }
    const float mean = wave_sum(s) * (1.f / DM); float s2 = 0.f;
#pragma unroll
    for (int j = 0; j < 8; ++j) { v[j] = v[j] - mean; s2 += (v[j].x * v[j].x + v[j].y * v[j].y) + (v[j].z * v[j].z + v[j].w * v[j].w); }
    const float rstd = 1.f / sqrtf(wave_sum(s2) * (1.f / DM) + LN_EPS);
#pragma unroll
    for (int j = 0; j < 8; ++j) { const f32x4 gg = *(const LAS f32x4*)(g + 4 * lane + 256 * j), bb = *(const LAS f32x4*)(bt + 4 * lane + 256 * j); f32x4 ov = v[j] * rstd * gg + bb;
        if (bad) ov = (f32x4){__builtin_nanf(""), __builtin_nanf(""), __builtin_nanf(""), __builtin_nanf("")};
        orow[64 * j] = ov; if (j & 1) __builtin_amdgcn_sched_barrier(0); }
}
__device__ __forceinline__ void p12_final(const Args& a, LAS unsigned char* lds, int tid, int gw, int NGW, int lane) {
    const bf16* PRE = (const bf16*)(a.ws + WS_PRE1); const bf16* Y = (const bf16*)(a.ws + WS_Y);
    LAS float* PL = (LAS float*)lds;
    for (int i = tid; i < DM; i += NWAVES * 64) { PL[i] = a.in[20][i]; PL[DM + i] = a.in[21][i]; PL[2 * DM + i] = a.in[29][i]; PL[3 * DM + i] = a.in[30][i]; }
    __syncthreads();
#if defined(CHECK_ATTN)
    const bool bad = __hip_atomic_load((gu32*)(a.ws + WS_CTL) + 12, RLX_AGENT) != 0u;
#else
    const bool bad = false;
#endif
    int r = gw;
    if (r >= NTOK) return;
    FinRow A, B;
    fin_load(A, PRE, Y, r, lane);
    for (;;) {
        const int r1 = r + NGW; const bool h1 = r1 < NTOK;
        if (h1) fin_load(B, PRE, Y, r1, lane);
        fin_row(A, a, PL, r, lane, bad);
        if (!h1) break;
        const int r2 = r1 + NGW; const bool h2 = r2 < NTOK;
        if (h2) fin_load(A, PRE, Y, r2, lane);
        fin_row(B, a, PL, r1, lane, bad);
        if (!h2) break;
        r = r2;
    }
}
__device__ __forceinline__ f32x2 cmul(const f32x2 a, const f32x2 b) { return (f32x2){a.x * b.x - a.y * b.y, a.x * b.y + a.y * b.x}; }
template <int DIR> __device__ __forceinline__ void dft4(f32x2& a0, f32x2& a1, f32x2& a2, f32x2& a3) {
    const f32x2 t0 = a0 + a2, t1 = a0 - a2, t2 = a1 + a3, t3 = a1 - a3;
    a0 = t0 + t2; a2 = t0 - t2;
    if (DIR < 0) { a1 = (f32x2){t1.x + t3.y, t1.y - t3.x}; a3 = (f32x2){t1.x - t3.y, t1.y + t3.x}; }
    else         { a1 = (f32x2){t1.x - t3.y, t1.y + t3.x}; a3 = (f32x2){t1.x + t3.y, t1.y - t3.x}; }
}
template <int DIR> __device__ __forceinline__ void fft16(f32x2 (&v)[16], f32x2 (&o)[16]) {
    constexpr float C[10] = {1.f, 0.92387953251128674f, 0.70710678118654752f, 0.38268343236508977f, 0.f, -0.38268343236508977f, -0.70710678118654752f, -0.92387953251128674f, -1.f, -0.92387953251128674f};
    constexpr float S[10] = {0.f, 0.38268343236508977f, 0.70710678118654752f, 0.92387953251128674f, 1.f, 0.92387953251128674f, 0.70710678118654752f, 0.38268343236508977f, 0.f, -0.38268343236508977f};
#pragma unroll
    for (int j0 = 0; j0 < 4; ++j0) dft4<DIR>(v[j0], v[j0 + 4], v[j0 + 8], v[j0 + 12]);
#pragma unroll
    for (int j0 = 1; j0 < 4; ++j0)
#pragma unroll
        for (int k1 = 1; k1 < 4; ++k1) { const int m = j0 * k1; v[j0 + 4 * k1] = cmul(v[j0 + 4 * k1], (f32x2){C[m], (float)DIR * S[m]}); }
#pragma unroll
    for (int k1 = 0; k1 < 4; ++k1) dft4<DIR>(v[4 * k1], v[4 * k1 + 1], v[4 * k1 + 2], v[4 * k1 + 3]);
#pragma unroll
    for (int k1 = 0; k1 < 4; ++k1)
#pragma unroll
        for (int k2 = 0; k2 < 4; ++k2) o[k1 + 4 * k2] = v[4 * k1 + k2];
}
template <int DIR> __device__ __forceinline__ void tw_apply(f32x2 (&v)[16], float frac2) {
    const float s = __builtin_amdgcn_sinf(frac2 * 0.5f), c = __builtin_amdgcn_cosf(frac2 * 0.5f);
    const f32x2 w1 = (f32x2){c, (float)DIR * s};
    const f32x2 w2 = cmul(w1, w1), w3 = cmul(w2, w1), w4 = cmul(w2, w2);
    v[1] = cmul(v[1], w1); v[2] = cmul(v[2], w2); v[3] = cmul(v[3], w3); v[4] = cmul(v[4], w4);
    const f32x2 w5 = cmul(w4, w1), w6 = cmul(w3, w3), w7 = cmul(w4, w3), w8 = cmul(w4, w4);
    v[5] = cmul(v[5], w5); v[6] = cmul(v[6], w6); v[7] = cmul(v[7], w7); v[8] = cmul(v[8], w8);
    v[9] = cmul(v[9], cmul(w8, w1)); v[10] = cmul(v[10], cmul(w5, w5)); v[11] = cmul(v[11], cmul(w8, w3)); v[12] = cmul(v[12], cmul(w6, w6));
    v[13] = cmul(v[13], cmul(w8, w5)); v[14] = cmul(v[14], cmul(w7, w7)); v[15] = cmul(v[15], cmul(w8, w7));
}
__device__ __forceinline__ float dpp_x1(float v) { return __int_as_float(__builtin_amdgcn_update_dpp(0, __float_as_int(v), 0xB1, 0xF, 0xF, true)); }
__device__ __forceinline__ float dpp_x2(float v) { return __int_as_float(__builtin_amdgcn_update_dpp(0, __float_as_int(v), 0x4E, 0xF, 0xF, true)); }
__device__ __forceinline__ void quad_fwd(f32x2& v, int b) {
    const bool hi = (b & 2) != 0, odd = (b & 1) != 0; const float s2 = hi ? -1.f : 1.f, sg = odd ? -1.f : 1.f;
    const f32x2 p = (f32x2){dpp_x2(v.x), dpp_x2(v.y)};
    const f32x2 t = (f32x2){p.x + s2 * v.x, p.y + s2 * v.y};
    const f32x2 q = (f32x2){dpp_x1(t.x), dpp_x1(t.y)};
    const f32x2 base = odd ? q : t, oth = odd ? t : q;
    const float ax = sg * (hi ? oth.y : oth.x), ay = (hi ? -sg : sg) * (hi ? oth.x : oth.y);
    v = (f32x2){base.x + ax, base.y + ay};
}
__device__ __forceinline__ void quad_inv(f32x2& v, int b) {
    const bool hi = (b & 2) != 0, odd = (b & 1) != 0; const float s2 = hi ? -1.f : 1.f;
    const f32x2 q = (f32x2){dpp_x1(v.x), dpp_x1(v.y)};
    const f32x2 sm = v + q, d = q - v;
    const f32x2 o = odd ? (hi ? (f32x2){-d.y, d.x} : d) : sm;
    const f32x2 p = (f32x2){dpp_x2(o.x), dpp_x2(o.y)};
    v = (f32x2){p.x + s2 * o.x, p.y + s2 * o.y};
}
__device__ __forceinline__ int padi(int i) { return i + ((i >> 6) << 2); }
__device__ __forceinline__ void fft_fwd_tail(LAS f32x2* L, int tid, f32x2 (&R)[2][16]) {
    asm volatile("v_mov_b32 %0, %1" : "=v"(tid) : "v"(tid));
#pragma unroll 1
    for (int h = 0; h < 2; ++h) { const int beta = tid + 512 * h, k1 = beta >> 6, b = beta & 63; f32x2 v[16], o[16];
#pragma unroll
        for (int j = 0; j < 16; ++j) v[j] = L[padi(k1 * 1024 + b + 64 * j)];
        fft16<-1>(v, o); tw_apply<-1>(o, (float)b * (1.f / 512.f));
#pragma unroll
        for (int k = 0; k < 16; ++k) L[padi(k1 * 1024 + b + 64 * k)] = o[k]; }
    __syncthreads();
#pragma unroll
    for (int h = 0; h < 2; ++h) { const int beta = tid + 512 * h, q = beta >> 2, b = beta & 3; f32x2 v[16];
#pragma unroll
        for (int j = 0; j < 16; ++j) v[j] = L[padi(64 * q + b + 4 * j)];
        fft16<-1>(v, R[h]); tw_apply<-1>(R[h], (float)b * (1.f / 32.f));
#pragma unroll
        for (int k = 0; k < 16; ++k) quad_fwd(R[h][k], b);
        __builtin_amdgcn_sched_barrier(0); }
}
__device__ __forceinline__ void p4_conv_fft(const Args& a, LAS unsigned char* lds, int vcu, int G, int tid_) {
    const float* KT = (const float*)(a.ws + WS_KT); float* ZT = (float*)(a.ws + WS_ZT); const float* dbias = a.in[16];
    LAS f32x2* L = (LAS f32x2*)lds;
    LAS float* red = (LAS float*)(lds + 139264);
    f32x2* KRa = (f32x2*)(a.ws + WS_KR) + (size_t)blockIdx.x * 16384;
    f32x2* KRb = (f32x2*)(a.ws + WS_WIN) + (size_t)blockIdx.x * 16384;
    const int lane = tid_ & 63, wave = tid_ >> 6;
    for (int pc = vcu; pc < HW; pc += 2 * G) {
        const int chA = pc, chB = pc + G; const bool hasB = chB < HW;
        const float* kpa = KT + (size_t)chA * 16384; const float* kpb = KT + (size_t)(hasB ? chB : chA) * 16384;
        int tid; asm volatile("v_mov_b32 %0, %1" : "=v"(tid) : "v"(tid_));
        f32x2 R[2][16];
        float ssa = 0.f, ssb = 0.f;
#pragma unroll 1
        for (int h = 0; h < 2; ++h) { const int beta = tid + 512 * h; f32x2 v[16], o[16];
#pragma unroll
            for (int j = 0; j < 16; ++j) { const float xa = kpa[beta + 1024 * j]; float xb = kpb[beta + 1024 * j]; xb = hasB ? xb : 0.f; ssa += xa * xa; ssb += xb * xb; v[j] = (f32x2){xa, xb}; }
            fft16<-1>(v, o); tw_apply<-1>(o, (float)beta * (1.f / 8192.f));
#pragma unroll
            for (int k = 0; k < 16; ++k) L[padi(beta + 1024 * k)] = o[k]; }
        ssa = wave_sum(ssa); ssb = wave_sum(ssb); if (lane == 0) { red[wave] = ssa; red[8 + wave] = ssb; }
        __syncthreads();
        fft_fwd_tail(L, tid, R);
        __syncthreads();
        asm volatile("v_mov_b32 %0, %1" : "=v"(tid) : "v"(tid_));
#pragma unroll
        for (int h = 0; h < 2; ++h) { const int beta = tid + 512 * h, q = beta >> 2, bp = beta & 3, rev = ((bp & 1) << 1) | (bp >> 1), s0 = rev + 4 * (q & 15) + 64 * (q >> 4);
#pragma unroll
            for (int k = 0; k < 16; ++k) L[s0 + 1024 * k] = R[h][k]; }
        __syncthreads();
        { float ta = 0.f, tb = 0.f;
#pragma unroll
          for (int w = 0; w < 8; ++w) { ta += red[w]; tb += red[8 + w]; }
          const float sA = rsqrtf(ta + FILTER_EPS) * (0.5f / 16384.f), dA = dbias[chA] * (1.f / 16384.f);
          const float sB = rsqrtf(tb + FILTER_EPS) * (0.5f / 16384.f), dB = dbias[hasB ? chB : chA] * (1.f / 16384.f);
#pragma unroll
          for (int h = 0; h < 2; ++h) { const int beta = tid + 512 * h, q = beta >> 2, bp = beta & 3, rev = ((bp & 1) << 1) | (bp >> 1), f0 = (q >> 4) + 16 * (q & 15) + 4096 * rev;
#pragma unroll
              for (int k = 0; k < 16; ++k) { const int g = (16384 - (f0 + 256 * k)) & 16383, sg = ((g >> 12) & 3) | (((g >> 4) & 15) << 2) | ((g & 15) << 6) | (((g >> 8) & 15) << 10);
                  const f32x2 Q = L[sg], P = R[h][k];
                  KRa[(h * 16 + k) * 512 + tid] = (f32x2){(P.x + Q.x) * sA + dA, (P.y - Q.y) * sA};
                  KRb[(h * 16 + k) * 512 + tid] = (f32x2){(P.y + Q.y) * sB + dB, (Q.x - P.x) * sB}; } } }
        __syncthreads();
#pragma unroll 1
        for (int sel = 0; sel < (hasB ? 2 : 1); ++sel) {
        const int ch = sel ? chB : chA; const f32x2* KRg = sel ? KRb : KRa;
        float* z0 = ZT + (size_t)ch * 16384; float* z1 = z0 + SEQ;
        asm volatile("v_mov_b32 %0, %1" : "=v"(tid) : "v"(tid_));
#pragma unroll 1
        for (int h = 0; h < 2; ++h) { const int beta = tid + 512 * h; f32x2 v[16], o[16];
#pragma unroll
            for (int j = 0; j < 8; ++j) v[j] = (f32x2){z0[beta + 1024 * j], z1[beta + 1024 * j]};
#pragma unroll
            for (int j = 8; j < 16; ++j) v[j] = (f32x2){0.f, 0.f};
            fft16<-1>(v, o); tw_apply<-1>(o, (float)beta * (1.f / 8192.f));
#pragma unroll
            for (int k = 0; k < 16; ++k) L[padi(beta + 1024 * k)] = o[k]; }
        __syncthreads();
        fft_fwd_tail(L, tid, R);
        asm volatile("v_mov_b32 %0, %1" : "=v"(tid) : "v"(tid_));
#pragma unroll
        for (int h = 0; h < 2; ++h) { const int beta = tid + 512 * h, q = beta >> 2, b = beta & 3; f32x2 o[16];
#pragma unroll
            for (int k = 0; k < 16; ++k) { R[h][k] = cmul(R[h][k], KRg[(h * 16 + k) * 512 + tid]); quad_inv(R[h][k], b); }
            tw_apply<1>(R[h], (float)b * (1.f / 32.f)); fft16<1>(R[h], o);
#pragma unroll
            for (int j = 0; j < 16; ++j) L[padi(64 * q + b + 4 * j)] = o[j];
            __builtin_amdgcn_sched_barrier(0); }
        __syncthreads();
        asm volatile("v_mov_b32 %0, %1" : "=v"(tid) : "v"(tid_));
#pragma unroll 1
        for (int h = 0; h < 2; ++h) { const int beta = tid + 512 * h, k1 = beta >> 6, b = beta & 63; f32x2 v[16], o[16];
#pragma unroll
            for (int k = 0; k < 16; ++k) v[k] = L[padi(k1 * 1024 + b + 64 * k)];
            tw_apply<1>(v, (float)b * (1.f / 512.f)); fft16<1>(v, o);
#pragma unroll
            for (int j = 0; j < 16; ++j) L[padi(k1 * 1024 + b + 64 * j)] = o[j]; }
        __syncthreads();
        asm volatile("v_mov_b32 %0, %1" : "=v"(tid) : "v"(tid_));
#pragma unroll 1
        for (int h = 0; h < 2; ++h) { const int beta = tid + 512 * h; f32x2 v[16], o[16];
#pragma unroll
            for (int k = 0; k < 16; ++k) v[k] = L[padi(beta + 1024 * k)];
            tw_apply<1>(v, (float)beta * (1.f / 8192.f)); fft16<1>(v, o);
#pragma unroll
            for (int j = 0; j < 8; ++j) { z0[beta + 1024 * j] = o[j].x; z1[beta + 1024 * j] = o[j].y; } }
        __syncthreads();
        }
    }
}
#ifndef MK_ONE_LAUNCH
#define MK_ONE_LAUNCH 1
#endif
constexpr int N_PHASES = 11;
#if defined(BREAK_MERGE)
constexpr float MERGE_MSCALE = 1.f / 64.f;
#else
constexpr float MERGE_MSCALE = 1.f / 256.f;
#endif
__global__ void __launch_bounds__(NWAVES * 64, 2) fwd(Args args) {
    extern __shared__ __attribute__((aligned(16))) unsigned char lds_raw[];
    LAS unsigned char* lds = (LAS unsigned char*)lds_raw;
    const int tid = threadIdx.x, lane = tid & 63, wave = __builtin_amdgcn_readfirstlane(tid >> 6);
    const int G = gridDim.x, bx = blockIdx.x, vcu = (G % 8 == 0) ? (bx % 8) * (G / 8) + bx / 8 : bx;
    const int gw = vcu * NWAVES + wave, NGW = G * NWAVES;
    unsigned char* ws = args.ws;
    gu32* ctl = (gu32*)(ws + WS_CTL);
    for (int u = tid; u < (LDS_BYTES - LDSCTL_OFF) / 4; u += NWAVES * 64) ((LAS unsigned*)(lds + LDSCTL_OFF))[u] = 0u;
    __syncthreads();
    XcdBarrier bar; bar.bar = (unsigned*)(ctl + CW_BAR); bar.x = 0; bar.st = nullptr;
    if (MK_ONE_LAUNCH) bar = xcd_barrier_post((unsigned*)(ctl + CW_BAR), (volatile LAS unsigned*)(lds + L_MISC) + 8);
    const int lo = args.ph_lo, hi = args.ph_hi;
#ifndef PHMASK
#define PHMASK 0xFFFF
#endif
#define IN(k) (((PHMASK >> (k)) & 1) && lo <= (k) && (k) < hi)
#ifndef PROBE_DUP
#define PROBE_DUP -1
#endif
#ifndef PROBE_MASK
#define PROBE_MASK 0
#endif
#define REP(k) for (int rep_ = 0; rep_ < ((PROBE_DUP == (k) || ((PROBE_MASK >> (k)) & 1)) ? 2 : 1); ++rep_)
#define SEAM(k) do { if (MK_ONE_LAUNCH && IN(k) && IN((k) + 1)) xcd_barrier(bar); } while (0)

    bf16* PROJ = (bf16*)(ws + WS_PROJ);
#if defined(LEAK_A)
    LAS unsigned long long* tst = (LAS unsigned long long*)(lds + LDSCTL_OFF + 1536);
    int n_st = 0;
#define STAMP() do { if (bx == 0 && tid == 0) tst[n_st] = __builtin_amdgcn_s_memrealtime(); ++n_st; } while (0)
    STAMP();
#else
#define STAMP() do { } while (0)
#endif
    if (IN(0)) REP(0) { p0_prologue(args, lds, gw, NGW, wave, lane); __syncthreads(); }
    SEAM(0); STAMP();
    if (IN(1)) {
        {
            pg8::Gemm g{(const bf16*)args.out, (const bf16*)(ws + WS_WIN), NTOK, 3 * HW, DM};        pg8::StaticOrder S; S.init(NTOK, 3 * HW, G, bx);
            pg8::EpiProj E{PROJ + COL_HY, INW, args.in[4], 1 << 30, 1.f / ALPHA};
            pg8::gemm_phase<pg8::EpiProj, pg8::StaticOrder, true, true>(lds, g, S, E);
        }
        {
            pg8::Gemm g{(const bf16*)(ws + WS_XN8), (const bf16*)(ws + WS_WIN8), NTOK, 22 * 256, DM / 2};
            pg8::GateOrder S; S.base.init(NTOK, 22 * 256, G, bx); S.G = G; S.c = bx; S.split = 0;
            pg8::EpiGate8 E{PROJ, INW, args.in[4], COL_G};
            pg8::gemm_phase<pg8::EpiGate8, pg8::GateOrder, true, true, false, false, true>(lds, g, S, E);
        }
        __syncthreads();
        if (G == 256) { if (bx < 128) p2_filter(args, lds, bx, 256, tid, 768); else p2_filter(args, lds, bx, 256, tid, 1024, bx - 128 + 768); }
        else p2_filter(args, lds, bx, G, tid);
    }
    SEAM(1); STAMP();
#if defined(LEAK_A) && defined(LEAK_SUB)
    if (IN(2)) { if (bx == 0 && tid == 0) tst[12] = __builtin_amdgcn_s_memrealtime(); p2_qk(args, gw, NGW, lane); __syncthreads(); if (bx == 0 && tid == 0) tst[13] = __builtin_amdgcn_s_memrealtime();
                 p2_vt8(args, lds, vcu, G, tid); if (bx == 0 && tid == 0) tst[14] = __builtin_amdgcn_s_memrealtime(); p2_conv(args, lds, vcu, G, tid); if (bx == 0 && tid == 0) tst[15] = __builtin_amdgcn_s_memrealtime(); }
#else
    if (IN(2)) { p2_qk(args, gw, NGW, lane); p2_vt8(args, lds, vcu, G, tid); REP(2) { p2_conv(args, lds, vcu, G, tid); } }
#endif
    SEAM(2); STAMP();
    if (IN(3)) {
        const int grp = bx % 3;
#define CONV_SLOT(s) do { if (grp == (s)) { for (int rp_ = 0; rp_ < ((PROBE_DUP == 33) ? 2 : 1); ++rp_) { conv_items(args, lds, W_IN, NWITEMS, vcu, G, threadIdx.x); __syncthreads(); conv_items_fp8(args, lds, 0, NW8, vcu, G, threadIdx.x); __syncthreads(); conv_items_fp8(args, lds, NW8 + W8_IN, NW8 + W8_IN + W8_AO, vcu, G, threadIdx.x); __syncthreads(); } } } while (0)
#define ATTN_UNIT(uu) do { const int u = (uu); if (u < BATCH * 8 * 32) { \
            int b = u >> 8, x = u & 255, kvh = (x & 7) >> 2, within = (x & 3) + 4 * (x >> 3); \
            if (G == 256) { const int c_ = x & 7, j_ = (x >> 3) + 32 * (u >> 8);     \
                b = c_ >> 2; kvh = (c_ >> 1) & 1; within = j_ + 64 * (c_ & 1); } \
            const int hq = kvh * 4 + (within >> 5), qb = within & 31; \
            const bf16* Qb = PROJ + (size_t)(b * SEQ + qb * 256) * INW + COL_Q + hq * 128; \
            const unsigned char* Kh = (const unsigned char*)(ws + WS_KC) + (size_t)(b * 2 + kvh) * SEQ * 128; \
            const unsigned char* Vh = (const unsigned char*)(ws + WS_VC) + (size_t)(b * 2 + kvh) * SEQ * 128; \
            unsigned char* Ob = (unsigned char*)(ws + WS_ACAT) + (size_t)(b * SEQ + qb * 256) * 3072 + hq * 128; \
            attn::attn_dense_body(Qb, Kh, Vh, Ob, SEQ, (char*)lds_raw); } } while (0)
#if PROBE_DUP == 34
        CONV_SLOT(0); ATTN_UNIT(bx); ATTN_UNIT(bx); CONV_SLOT(1); ATTN_UNIT(bx + G); ATTN_UNIT(bx + G); CONV_SLOT(2);
#else
        CONV_SLOT(0); ATTN_UNIT(bx); CONV_SLOT(1); ATTN_UNIT(bx + G); CONV_SLOT(2);
#endif
        for (int u2 = bx + 2 * G; u2 < BATCH * 8 * 32; u2 += G) ATTN_UNIT(u2);
#undef CONV_SLOT
#undef ATTN_UNIT
        p4_conv_fft(args, lds, vcu, G, tid);
    }
    SEAM(3); STAMP();
    if (IN(4)) {
#if defined(CHECK_ATTN)
        check_attn(args, gw, NGW, lane);
#endif
        REP(4) { p5_ah(args, lds, vcu, G, tid); } }
    SEAM(4); STAMP();
    if (IN(5)) {
        pg8::Gemm g{(const bf16*)(ws + WS_ACAT), (const bf16*)(ws + WS_WCAT), NTOK, DM, 1536}; pg8::StaticOrder S; S.init(NTOK, DM, G, bx);
        pg8::EpiMerge E{PROJ + COL_G, PROJ + COL_G + DM, INW, (bf16*)(ws + WS_MRG), DM, MERGE_MSCALE};
        pg8::gemm_phase<pg8::EpiMerge, pg8::StaticOrder, true, true, false, true, false, 8>(lds, g, S, E);
    }
    SEAM(5); STAMP();
    if (IN(6)) REP(6) {
#if defined(CHECK_ATTN)
        check_merge(args, gw, NGW, lane);
#endif
        pg8::Gemm g{(const bf16*)(ws + WS_MRG), (const bf16*)(ws + WS_WOUT), NTOK, DM, DM}; pg8::StaticOrder S; S.init(NTOK, DM, G, bx);
        pg8::EpiPre1 E{(const bf16*)args.out, (bf16*)(ws + WS_PRE1), DM};
        pg8::gemm_phase<pg8::EpiPre1, pg8::StaticOrder, true, true>(lds, g, S, E);
    }
    SEAM(6); STAMP();
    if (IN(7)) { p8_ln_route(args, lds, vcu, G, tid); }
    SEAM(7); STAMP();
    if (IN(8)) {
        const int total = expert_tables(args, lds, tid);
        pg8::Gemm g{(const bf16*)(ws + WS_H1B), (const bf16*)(ws + WS_WGU), total, NEXP * 2048, DM / 2, (const int*)(ws + WS_ETOK), (const LAS int*)(lds + L_CNT), (const LAS int*)(lds + L_OFF), ELIST};
        pg8::ExpertOrder S{(const LAS int*)(lds + L_RBX), total >> 8, G, bx, (PROBE_DUP == 8) ? 2 : 1};
        pg8::EpiSwiglu E{(unsigned char*)(ws + WS_HB), DEXP};
        pg8::gemm_phase<pg8::EpiSwiglu, pg8::ExpertOrder, true, true, true, false, true>(lds, g, S, E);
    }
    SEAM(8); STAMP();
    if (IN(9)) {
        __syncthreads(); const int total = (IN(8)) ? ((const LAS int*)(lds + L_OFF))[32] : expert_tables(args, lds, tid);
        pg8::Gemm g{(const bf16*)(ws + WS_HB), (const bf16*)(ws + WS_WD), total, NEXP * 2048, DEXP / 2};
        pg8::ExpertOrder S{(const LAS int*)(lds + L_RBX), total >> 8, G, bx, (PROBE_DUP == 9) ? 2 : 1};
        pg8::EpiDown E{(const int*)(ws + WS_ETOK), (const float*)(ws + WS_EW), (const LAS int*)(lds + L_CNT), (const LAS int*)(lds + L_OFF), ELIST, (bf16*)(ws + WS_Y), DM, NTOK};
        pg8::gemm_phase<pg8::EpiDown, pg8::ExpertOrder, true, true, false, false, true>(lds, g, S, E);
    }
    SEAM(9); STAMP();
    if (IN(10)) REP(10) { p12_final(args, lds, tid, gw, NGW, lane); }
#if defined(LEAK_A)
    __syncthreads(); STAMP();
    if (bx == 0) { const unsigned long long d_ = tst[LEAK_A + 1] - tst[LEAK_A], t0_ = __builtin_amdgcn_s_memrealtime(); while (__builtin_amdgcn_s_memrealtime() - t0_ < (unsigned long long)(LEAK_AMP) * d_) { } }
#endif
#undef IN
#undef SEAM
}

extern "C" void kernel_launch(void* const* d_in, const int* in_sizes, int n_in, void* d_out, int out_size, void* d_ws, size_t ws_size, hipStream_t stream) {
    static int grid = 0;
    if (grid == 0) {
        if (n_in != 31 || out_size != NTOK * DM || ws_size < WS_END) { fprintf(stderr, "kernel_launch: unexpected shapes: n_in %d out %d ws %zu (need >= %zu)\n", n_in, out_size, ws_size, (size_t)WS_END); grid = -1; return; }
        int dev = 0, cus = 0, per_cu = 0;
        if (hipGetDevice(&dev) != hipSuccess || hipDeviceGetAttribute(&cus, hipDeviceAttributeMultiprocessorCount, dev) != hipSuccess) { grid = -1; return; }
        if (hipFuncSetAttribute((const void*)fwd, hipFuncAttributeMaxDynamicSharedMemorySize, LDS_BYTES) != hipSuccess) { fprintf(stderr, "kernel_launch: hipFuncSetAttribute failed\n"); grid = -1; return; }
        if (hipOccupancyMaxActiveBlocksPerMultiprocessor(&per_cu, (const void*)fwd, NWAVES * 64, LDS_BYTES) != hipSuccess || per_cu < 1) fprintf(stderr, "kernel_launch: occupancy query reports %d\n", per_cu);
        (void)hipGetLastError();
        grid = cus;
    }
    if (grid < 0) return;
    if (hipMemsetAsync((char*)d_ws + WS_CTL, 0, CTL_ZERO_BYTES, stream) != hipSuccess) return;
    Args a{};
    for (int i = 0; i < 31; ++i) a.in[i] = (const float*)d_in[i];
    a.out = (float*)d_out; a.ws = (unsigned char*)d_ws;
#if MK_ONE_LAUNCH
    a.ph_lo = 0; a.ph_hi = N_PHASES;
    hipLaunchKernelGGL(fwd, dim3(grid), dim3(NWAVES * 64), LDS_BYTES, stream, a);
#else
    for (int p = 0; p < N_PHASES; ++p) { a.ph_lo = p; a.ph_hi = p + 1; hipLaunchKernelGGL(fwd, dim3(grid), dim3(NWAVES * 64), LDS_BYTES, stream, a); }
#endif
    const hipError_t le = hipPeekAtLastError();
    if (le != hipSuccess) fprintf(stderr, "kernel_launch: launch failed: %s\n", hipGetErrorName(le));
}
```
